# Optimizing an MI355X kernel written in HIP

```python
import math
import jax, jax.numpy as jnp
from jax import lax
import numpy as np

D_MODEL = 2048
BATCH = 8
SEQ = 2048
DEPTH = 1

D_MIX = D_MODEL
HEAD_DIM = 64
D_ATTN = D_MIX // 2
N_Q_HEADS = D_ATTN // HEAD_DIM
N_KV_HEADS = 4
Q_PER_KV = N_Q_HEADS // N_KV_HEADS
D_KV = N_KV_HEADS * HEAD_DIM
WINDOW = 128
BLOCK = 128
ROPE_THETA = 10000.0
D_SSM = D_MIX - D_ATTN
SSM_GROUP = 16
N_SSM_GROUPS = D_SSM // SSM_GROUP
SSM_STATE = 64
D_IN = D_ATTN + 2 * D_KV + D_SSM
D_FF = ((8 * D_MODEL // 3 + 255) // 256) * 256
RMS_EPS = 1e-6

kernel_name = 'hymba_swa_sink_s5_sandwich_block'


def rms_norm(x, g):
    xf = x.astype(jnp.float32)
    y = xf * lax.rsqrt(jnp.mean(xf * xf, axis=-1, keepdims=True) + RMS_EPS)
    return (y * g.astype(jnp.float32)).astype(x.dtype)


def rotary(t, positions):
    half = HEAD_DIM // 2
    inv_freq = ROPE_THETA ** (-jnp.arange(half, dtype=jnp.float32) / half)
    ang = positions.astype(jnp.float32)[:, :, None] * inv_freq
    cos = jnp.cos(ang)[:, :, None, :]
    sin = jnp.sin(ang)[:, :, None, :]
    tf = t.astype(jnp.float32)
    t1, t2 = tf[..., :half], tf[..., half:]
    return jnp.concatenate([t1 * cos - t2 * sin, t2 * cos + t1 * sin], axis=-1).astype(t.dtype)


def sliding_window_attention(q, k, v, sinks):
    B, L = q.shape[0], q.shape[1]
    nb = L // BLOCK
    qb = q.reshape(B, nb, BLOCK, N_KV_HEADS, Q_PER_KV, HEAD_DIM)
    kb = k.reshape(B, nb, BLOCK, N_KV_HEADS, HEAD_DIM)
    vb = v.reshape(B, nb, BLOCK, N_KV_HEADS, HEAD_DIM)
    pad = ((0, 0), (1, 0), (0, 0), (0, 0), (0, 0))
    kk = jnp.concatenate([jnp.pad(kb, pad)[:, :-1], kb], axis=2)
    vv = jnp.concatenate([jnp.pad(vb, pad)[:, :-1], vb], axis=2)
    scale = 1.0 / math.sqrt(HEAD_DIM)
    scores = jnp.einsum('bnqkgd,bnskd->bnkgqs', qb, kk).astype(jnp.float32) * scale
    blk = jnp.arange(nb, dtype=jnp.int32)[:, None] * BLOCK
    q_pos = blk + jnp.arange(BLOCK, dtype=jnp.int32)[None, :]
    k_pos = blk - BLOCK + jnp.arange(2 * BLOCK, dtype=jnp.int32)[None, :]
    diff = q_pos[:, :, None] - k_pos[:, None, :]
    mask = (diff >= 0) & (diff < WINDOW) & (k_pos[:, None, :] >= 0)
    scores = jnp.where(mask[None, :, None, None], scores, -jnp.inf)
    sink = sinks.astype(jnp.float32).reshape(N_KV_HEADS, Q_PER_KV)[None, None, :, :, None, None]
    m = jnp.maximum(jnp.max(scores, axis=-1, keepdims=True), sink)
    p = jnp.exp(scores - m)
    probs = p / (jnp.sum(p, axis=-1, keepdims=True) + jnp.exp(sink - m))
    out = jnp.einsum('bnkgqs,bnskd->bnqkgd', probs.astype(v.dtype), vv)
    return out.reshape(B, L, N_Q_HEADS * HEAD_DIM)


def s5_ssm(u, a_re, a_im, log_dt, b_re, b_im, c_re, c_im, d_skip):
    L = u.shape[1]
    uf = u.astype(jnp.float32)
    dt = jnp.exp(log_dt.astype(jnp.float32))[:, None]
    ar = a_re.astype(jnp.float32)
    ai = a_im.astype(jnp.float32)
    mag = jnp.exp(ar * dt)
    lam_re = mag * jnp.cos(ai * dt)
    lam_im = mag * jnp.sin(ai * dt)
    den = ar * ar + ai * ai
    nr = lam_re - 1.0
    ni = lam_im
    f_re = (nr * ar + ni * ai) / den
    f_im = (ni * ar - nr * ai) / den
    br = b_re.astype(jnp.float32)
    bi = b_im.astype(jnp.float32)
    bbar_re = f_re[..., None] * br - f_im[..., None] * bi
    bbar_im = f_re[..., None] * bi + f_im[..., None] * br
    bu_re = jnp.einsum('blgp,gnp->blgn', uf, bbar_re)
    bu_im = jnp.einsum('blgp,gnp->blgn', uf, bbar_im)
    shp = (1, L) + lam_re.shape
    a_seq_re = jnp.broadcast_to(lam_re[None, None], shp)
    a_seq_im = jnp.broadcast_to(lam_im[None, None], shp)

    def combine(earlier, later):
        a1r, a1i, b1r, b1i = earlier
        a2r, a2i, b2r, b2i = later
        return (a2r * a1r - a2i * a1i,
                a2r * a1i + a2i * a1r,
                a2r * b1r - a2i * b1i + b2r,
                a2r * b1i + a2i * b1r + b2i)

    _, _, s_re, s_im = lax.associative_scan(combine, (a_seq_re, a_seq_im, bu_re, bu_im), axis=1)
    y = (jnp.einsum('blgn,gpn->blgp', s_re, c_re.astype(jnp.float32))
         - jnp.einsum('blgn,gpn->blgp', s_im, c_im.astype(jnp.float32))
         + d_skip.astype(jnp.float32) * uf)
    return y.astype(u.dtype)


def hybrid_mixer(xn, positions, w_in, sinks, a_re, a_im, log_dt, b_re, b_im, c_re, c_im,
                 d_skip, w_glu, b_glu, g_attn_out, g_ssm_out, w_o):
    B, L = xn.shape[0], xn.shape[1]
    proj = jnp.einsum('bld,de->ble', xn, w_in)
    q, k, v, u = jnp.split(proj, [D_ATTN, D_ATTN + D_KV, D_ATTN + 2 * D_KV], axis=-1)
    q = rotary(q.reshape(B, L, N_Q_HEADS, HEAD_DIM), positions)
    k = rotary(k.reshape(B, L, N_KV_HEADS, HEAD_DIM), positions)
    v = v.reshape(B, L, N_KV_HEADS, HEAD_DIM)
    attn = sliding_window_attention(q, k, v, sinks)
    y = s5_ssm(u.reshape(B, L, N_SSM_GROUPS, SSM_GROUP), a_re, a_im, log_dt,
               b_re, b_im, c_re, c_im, d_skip).reshape(B, L, D_SSM)
    z = jax.nn.gelu(y)
    ssm = z * jax.nn.sigmoid(jnp.einsum('blc,ce->ble', z, w_glu) + b_glu)
    mixed = jnp.concatenate([rms_norm(attn, g_attn_out), rms_norm(ssm, g_ssm_out)], axis=-1)
    return jnp.einsum('blc,cd->bld', mixed, w_o)


def swiglu(xn, w_gate, w_up, w_down):
    hid = jax.nn.silu(jnp.einsum('bld,df->blf', xn, w_gate)) * jnp.einsum('bld,df->blf', xn, w_up)
    return jnp.einsum('blf,fd->bld', hid, w_down)


def setup_inputs(seed: int = 0) -> dict:
    key = jax.random.key(seed)
    ks = jax.random.split(key, 24)
    f32 = jnp.float32

    def nrm(k, shape, scale):
        return jax.random.normal(k, shape, f32) * scale

    def gain(k, width):
        return 1.0 + nrm(k, (DEPTH, width), 0.05)

    G, N, P = N_SSM_GROUPS, SSM_STATE, SSM_GROUP
    x = nrm(ks[0], (BATCH, SEQ, D_MODEL), 1.0)
    positions = jnp.tile(jnp.arange(SEQ, dtype=jnp.int32)[None, :], (BATCH, 1))
    return {
        'x': x,
        'positions': positions,
        'g_pre_mix': gain(ks[1], D_MODEL),
        'w_in': nrm(ks[2], (DEPTH, D_MODEL, D_IN), D_MODEL ** -0.5),
        'sinks': nrm(ks[3], (DEPTH, N_Q_HEADS), 1.0),
        'a_re': -0.5 + nrm(ks[4], (DEPTH, G, N), 0.01),
        'a_im': math.pi * jnp.arange(N, dtype=f32)[None, None, :] + nrm(ks[5], (DEPTH, G, N), 0.01),
        'log_dt': jax.random.uniform(ks[6], (DEPTH, G), f32, math.log(1e-3), math.log(1e-1)),
        'b_re': nrm(ks[7], (DEPTH, G, N, P), (2 * P) ** -0.5),
        'b_im': nrm(ks[8], (DEPTH, G, N, P), (2 * P) ** -0.5),
        'c_re': nrm(ks[9], (DEPTH, G, P, N), (2 * N) ** -0.5),
        'c_im': nrm(ks[10], (DEPTH, G, P, N), (2 * N) ** -0.5),
        'd_skip': nrm(ks[11], (DEPTH, G, P), 1.0),
        'w_glu': nrm(ks[12], (DEPTH, D_SSM, D_SSM), D_SSM ** -0.5),
        'b_glu': nrm(ks[13], (DEPTH, D_SSM), 0.01),
        'g_attn_out': gain(ks[14], D_ATTN),
        'g_ssm_out': gain(ks[15], D_SSM),
        'w_o': nrm(ks[16], (DEPTH, D_MIX, D_MODEL), D_MIX ** -0.5),
        'g_post_mix': gain(ks[17], D_MODEL),
        'g_pre_ffn': gain(ks[18], D_MODEL),
        'w_gate': nrm(ks[19], (DEPTH, D_MODEL, D_FF), D_MODEL ** -0.5),
        'w_up': nrm(ks[20], (DEPTH, D_MODEL, D_FF), D_MODEL ** -0.5),
        'w_down': nrm(ks[21], (DEPTH, D_FF, D_MODEL), D_FF ** -0.5),
        'g_post_ffn': gain(ks[22], D_MODEL),
    }


def reference(x, positions, g_pre_mix, w_in, sinks, a_re, a_im, log_dt, b_re, b_im, c_re, c_im,
              d_skip, w_glu, b_glu, g_attn_out, g_ssm_out, w_o, g_post_mix, g_pre_ffn,
              w_gate, w_up, w_down, g_post_ffn):
    h = x
    for i in range(DEPTH):
        mix = hybrid_mixer(rms_norm(h, g_pre_mix[i]), positions, w_in[i], sinks[i], a_re[i], a_im[i],
                           log_dt[i], b_re[i], b_im[i], c_re[i], c_im[i], d_skip[i], w_glu[i],
                           b_glu[i], g_attn_out[i], g_ssm_out[i], w_o[i])
        h = h + rms_norm(mix, g_post_mix[i])
        ff = swiglu(rms_norm(h, g_pre_ffn[i]), w_gate[i], w_up[i], w_down[i])
        h = h + rms_norm(ff, g_post_ffn[i])
    return h
```

```cpp
#include <hip/hip_runtime.h>
#include <cstdio>
#include <cstdint>

namespace pg8 {
#define PG8_LAS __attribute__((address_space(3)))
typedef unsigned short bf16_t;
typedef short bf16x8 __attribute__((ext_vector_type(8)));
typedef float f32x4 __attribute__((ext_vector_type(4)));
typedef unsigned u32x4 __attribute__((ext_vector_type(4)));
constexpr int BM = 256, BK = 64, HALF = 128, HTB = HALF * BK * 2, STAGE_BYTES = 8 * HTB, NXCD = 8, WGM = 8;

__host__ __device__ __forceinline__ int lds_byte(int r, int c) { const int st = (r >> 4) * 2 + (c >> 5), rr = r & 15, cc = c & 31, ob = rr * 64 + cc * 2; return st * 1024 + (ob ^ (((ob >> 9) & 1) << 5)); }
__host__ __device__ __forceinline__ void stage_rc(int b, int& R, int& C) { const int st = b / 1024, sb = b % 1024, swz = sb ^ (((sb >> 9) & 1) << 5); R = (st >> 1) * 16 + swz / 64; C = (st & 1) * 32 + (swz % 64) / 2; }
__host__ __device__ __forceinline__ int perm32(int rho) { const int n = rho >> 4, i = rho & 15; return 8 * (i >> 2) + 4 * n + (i & 3); }

struct Unit { int pm, pn; };
struct Gemm { const bf16_t* A; const bf16_t* Bt; int lda, ldb, K; };

struct StaticOrder {
    int nM, nN, nwg, G, c;
    __host__ __device__ void init(int M, int N, int G_, int c_) { nM = M / BM; nN = N / BM; nwg = nM * nN; G = G_; c = c_; }
    __host__ __device__ bool next(int i, Unit& u) const {
        const long L = (long)i * G + c; if (L >= nwg) return false;
        int wgid = (int)L; { const int q = nwg / NXCD, r = nwg % NXCD, xcd = wgid % NXCD, off = wgid / NXCD; wgid = (xcd < r ? xcd * (q + 1) : r * (q + 1) + (xcd - r) * q) + off; }
        const int nig = WGM * nN, gid = wgid / nig, fm = gid * WGM, gsz = (nM - fm) < WGM ? (nM - fm) : WGM;
        u.pm = fm + ((wgid % nig) % gsz); u.pn = (wgid % nig) / gsz; return true;
    }
};
struct DiagOrder {
    int G, c, n;
    __host__ __device__ bool next(int i, Unit& u) const { const int L = i * G + c; if (L >= n) return false; u.pm = L; u.pn = L >> 2; return true; }
};

__device__ __forceinline__ unsigned cvt_pk_bf16(float lo, float hi) { unsigned r; asm volatile("v_cvt_pk_bf16_f32 %0, %1, %2" : "=v"(r) : "v"(lo), "v"(hi)); return r; }
__device__ __forceinline__ float bf_lo(unsigned w) { return __uint_as_float(w << 16); }
__device__ __forceinline__ float bf_hi(unsigned w) { return __uint_as_float(w & 0xffff0000u); }
__device__ __forceinline__ float sigmoidf_(float x) { return __builtin_amdgcn_rcpf(1.0f + __builtin_amdgcn_exp2f(-1.4426950408889634f * x)); }
__device__ __forceinline__ float gelu_tanh(float x) { const float u = 1.5957691216057308f * (x + 0.044715f * x * x * x); return x * sigmoidf_(u); }

constexpr float ATT_C2 = 0.125f * 1.4426950408889634f;

struct EpiBf16P {
    static constexpr bool PERM = true, MIDK = false;
    bf16_t* O; int ldc;
    __device__ __forceinline__ void operator()(const f32x4 (&acc)[2][2][4][2], const Unit& u, int wr, int wc, int fr, int fq) const {
        const int row0 = u.pm * BM + wr * 64 + fr, col0 = u.pn * BM + wc * 32 + 8 * fq;
#pragma unroll
        for (int ai = 0; ai < 2; ++ai)
#pragma unroll
            for (int m = 0; m < 4; ++m) { bf16_t* rowp = O + (size_t)(row0 + ai * HALF + m * 16) * ldc + col0;
#pragma unroll
                for (int bj = 0; bj < 2; ++bj) { const f32x4 v0 = acc[ai][bj][m][0], v1 = acc[ai][bj][m][1];
                    u32x4 w; w.x = cvt_pk_bf16(v0[0], v0[1]); w.y = cvt_pk_bf16(v0[2], v0[3]); w.z = cvt_pk_bf16(v1[0], v1[1]); w.w = cvt_pk_bf16(v1[2], v1[3]);
                    *(u32x4*)(rowp + bj * HALF) = w; } }
    }
};
struct EpiMix {
    static constexpr bool PERM = true, MIDK = true;
    bf16_t* O; int ldc; const PG8_LAS float* ratio; const PG8_LAS float* rsl;
    __device__ __forceinline__ void midk(f32x4 (&acc)[2][2][4][2], const Unit& u, int wr, int fr) const {
#pragma unroll
        for (int ai = 0; ai < 2; ++ai)
#pragma unroll
            for (int m = 0; m < 4; ++m) { const float rt = ratio[wr * 64 + fr + ai * HALF + m * 16];
#pragma unroll
                for (int bj = 0; bj < 2; ++bj)
#pragma unroll
                    for (int n = 0; n < 2; ++n) acc[ai][bj][m][n] *= rt; }
    }
    __device__ __forceinline__ void operator()(const f32x4 (&acc)[2][2][4][2], const Unit& u, int wr, int wc, int fr, int fq) const {
        const int row0 = u.pm * BM + wr * 64 + fr, col0 = u.pn * BM + wc * 32 + 8 * fq;
#pragma unroll
        for (int ai = 0; ai < 2; ++ai)
#pragma unroll
            for (int m = 0; m < 4; ++m) { const int row = row0 + ai * HALF + m * 16; bf16_t* rowp = O + (size_t)row * ldc + col0;
                const float rs = rsl[wr * 64 + fr + ai * HALF + m * 16];
#pragma unroll
                for (int bj = 0; bj < 2; ++bj) { const f32x4 v0 = acc[ai][bj][m][0] * rs, v1 = acc[ai][bj][m][1] * rs;
                    u32x4 w; w.x = cvt_pk_bf16(v0[0], v0[1]); w.y = cvt_pk_bf16(v0[2], v0[3]); w.z = cvt_pk_bf16(v1[0], v1[1]); w.w = cvt_pk_bf16(v1[2], v1[3]);
                    *(u32x4*)(rowp + bj * HALF) = w; } }
    }
};
struct EpiQKU {
    static constexpr bool PERM = true, MIDK = false;
    bf16_t* Q; bf16_t* Kp; bf16_t* A2; const PG8_LAS int* posl;
    __device__ __forceinline__ void operator()(const f32x4 (&acc)[2][2][4][2], const Unit& u, int wr, int wc, int fr, int fq) const {
        const int row0 = u.pm * BM + wr * 64 + fr, cw = wc * 32 + 8 * fq;
        if (u.pn < 5) {
            const bool isq = u.pn < 4; const float sc = isq ? ATT_C2 : 1.0f;
            const int i0 = (cw & 63) >> 1;
            float invf[4];
#pragma unroll
            for (int t = 0; t < 4; ++t) invf[t] = __builtin_amdgcn_exp2f(-(float)(i0 + t) * (13.287712379549449f / 32.0f));
            bf16_t* base = isq ? (Q + u.pn * 256) : Kp; const int ld = isq ? 1024 : 256;
#pragma unroll
            for (int ai = 0; ai < 2; ++ai)
#pragma unroll
                for (int m = 0; m < 4; ++m) { const int row = row0 + ai * HALF + m * 16; const float p = (float)posl[wr * 64 + fr + ai * HALF + m * 16];
                    float cs[4], sn[4];
#pragma unroll
                    for (int t = 0; t < 4; ++t) { const float ang = p * invf[t]; const float fr_ = __builtin_amdgcn_fractf(ang * 0.15915494309189535f); sn[t] = __builtin_amdgcn_sinf(fr_) * sc; cs[t] = __builtin_amdgcn_cosf(fr_) * sc; }
#pragma unroll
                    for (int bj = 0; bj < 2; ++bj) { const f32x4 v0 = acc[ai][bj][m][0], v1 = acc[ai][bj][m][1];
                        u32x4 w;
                        w.x = cvt_pk_bf16(v0[0] * cs[0] - v0[1] * sn[0], v0[1] * cs[0] + v0[0] * sn[0]);
                        w.y = cvt_pk_bf16(v0[2] * cs[1] - v0[3] * sn[1], v0[3] * cs[1] + v0[2] * sn[1]);
                        w.z = cvt_pk_bf16(v1[0] * cs[2] - v1[1] * sn[2], v1[1] * cs[2] + v1[0] * sn[2]);
                        w.w = cvt_pk_bf16(v1[2] * cs[3] - v1[3] * sn[3], v1[3] * cs[3] + v1[2] * sn[3]);
                        *(u32x4*)(base + (size_t)row * ld + bj * HALF + cw) = w; } }
        } else {
#pragma unroll
            for (int ai = 0; ai < 2; ++ai)
#pragma unroll
                for (int m = 0; m < 4; ++m) { const int row = row0 + ai * HALF + m * 16;
#pragma unroll
                    for (int bj = 0; bj < 2; ++bj) { const f32x4 v0 = acc[ai][bj][m][0], v1 = acc[ai][bj][m][1];
                        const int gcol = (u.pn - 5) * 256 + bj * HALF + cw, g = gcol >> 4, q0 = gcol & 15;
                        u32x4 w; w.x = cvt_pk_bf16(v0[0], v0[1]); w.y = cvt_pk_bf16(v0[2], v0[3]); w.z = cvt_pk_bf16(v1[0], v1[1]); w.w = cvt_pk_bf16(v1[2], v1[3]);
                        *(u32x4*)(A2 + (size_t)g * (1024 * 384) + (size_t)(row >> 4) * 384 + (row & 15) * 16 + q0) = w; } }
        }
    }
};
struct EpiZ {
    static constexpr bool PERM = false, MIDK = false;
    float* Z;
    __device__ __forceinline__ void operator()(const f32x4 (&acc)[2][2][4][2], const Unit& u, int wr, int wc, int fr, int fq) const {
        const int row0 = u.pm * BM + wr * 64 + fr, col0 = wc * 32 + 4 * fq;
#pragma unroll
        for (int ai = 0; ai < 2; ++ai)
#pragma unroll
            for (int m = 0; m < 4; ++m) { float* rowp = Z + (size_t)(row0 + ai * HALF + m * 16) * 128 + col0;
#pragma unroll
                for (int n = 0; n < 2; ++n) *(f32x4*)(rowp + n * 16) = acc[ai][0][m][n]; }
    }
};
struct EpiY {
    static constexpr bool PERM = true, MIDK = false;
    bf16_t* Zb;
    __device__ __forceinline__ void operator()(const f32x4 (&acc)[2][2][4][2], const Unit& u, int wr, int wc, int fr, int fq) const {
        const int row0 = u.pm * BM + wr * 64 + fr, g = u.pn;
#pragma unroll
        for (int ai = 0; ai < 2; ++ai)
#pragma unroll
            for (int m = 0; m < 4; ++m) { const int bc = (row0 + ai * HALF + m * 16) & 1023;
#pragma unroll
                for (int bj = 0; bj < 2; ++bj) { const f32x4 v0 = acc[ai][bj][m][0], v1 = acc[ai][bj][m][1];
                    const int j = 8 * bj + 2 * wc + (fq >> 1), p0 = 8 * (fq & 1);
                    u32x4 w; w.x = cvt_pk_bf16(gelu_tanh(v0[0]), gelu_tanh(v0[1])); w.y = cvt_pk_bf16(gelu_tanh(v0[2]), gelu_tanh(v0[3]));
                    w.z = cvt_pk_bf16(gelu_tanh(v1[0]), gelu_tanh(v1[1])); w.w = cvt_pk_bf16(gelu_tanh(v1[2]), gelu_tanh(v1[3]));
                    *(u32x4*)(Zb + (size_t)(bc * 16 + j) * 1024 + g * 16 + p0) = w; asm volatile("" ::: "memory"); } }
    }
};
struct EpiGlu {
    static constexpr bool PERM = true, MIDK = false;
    const bf16_t* Zb; const float* bias; bf16_t* O; int ldo; float* st;
    __device__ __forceinline__ void operator()(const f32x4 (&acc)[2][2][4][2], const Unit& u, int wr, int wc, int fr, int fq) const {
        const int row0 = u.pm * BM + wr * 64 + fr, col0 = u.pn * BM + wc * 32 + 8 * fq;
        float part[2][4];
#pragma unroll
        for (int ai = 0; ai < 2; ++ai)
#pragma unroll
            for (int m = 0; m < 4; ++m) part[ai][m] = 0.f;
#pragma unroll
        for (int bj = 0; bj < 2; ++bj) { const f32x4 b0 = *(const f32x4*)(bias + col0 + bj * HALF), b1 = *(const f32x4*)(bias + col0 + bj * HALF + 4);
#pragma unroll
            for (int ai = 0; ai < 2; ++ai)
#pragma unroll
                for (int m = 0; m < 4; ++m) { const int row = row0 + ai * HALF + m * 16;
                    const u32x4 zi = *(const u32x4*)(Zb + (size_t)row * 1024 + col0 + bj * HALF); const f32x4 v0 = acc[ai][bj][m][0] + b0, v1 = acc[ai][bj][m][1] + b1;
                    float e[8];
                    e[0] = bf_lo(zi.x) * sigmoidf_(v0[0]); e[1] = bf_hi(zi.x) * sigmoidf_(v0[1]); e[2] = bf_lo(zi.y) * sigmoidf_(v0[2]); e[3] = bf_hi(zi.y) * sigmoidf_(v0[3]);
                    e[4] = bf_lo(zi.z) * sigmoidf_(v1[0]); e[5] = bf_hi(zi.z) * sigmoidf_(v1[1]); e[6] = bf_lo(zi.w) * sigmoidf_(v1[2]); e[7] = bf_hi(zi.w) * sigmoidf_(v1[3]);
                    part[ai][m] += (e[0] * e[0] + e[1] * e[1]) + (e[2] * e[2] + e[3] * e[3]) + (e[4] * e[4] + e[5] * e[5]) + (e[6] * e[6] + e[7] * e[7]);
                    u32x4 w; w.x = cvt_pk_bf16(e[0], e[1]); w.y = cvt_pk_bf16(e[2], e[3]); w.z = cvt_pk_bf16(e[4], e[5]); w.w = cvt_pk_bf16(e[6], e[7]);
                    *(u32x4*)(O + (size_t)row * ldo + col0 + bj * HALF) = w; } }
#pragma unroll
        for (int ai = 0; ai < 2; ++ai)
#pragma unroll
            for (int m = 0; m < 4; ++m) { float p = part[ai][m]; p += __shfl_xor(p, 16); p += __shfl_xor(p, 32);
                if (fq == 0) (void)__hip_atomic_fetch_add(st + row0 + ai * HALF + m * 16, p, __ATOMIC_RELAXED, __HIP_MEMORY_SCOPE_AGENT); }
    }
};
struct EpiSwiGLU {
    static constexpr bool PERM = true, MIDK = false;
    bf16_t* O; int ldc; const float* rs;
    __device__ __forceinline__ void operator()(const f32x4 (&acc)[2][2][4][2], const Unit& u, int wr, int wc, int fr, int fq) const {
        const int row0 = u.pm * BM + wr * 64 + fr, col0 = u.pn * HALF + wc * 32 + 8 * fq;
#pragma unroll
        for (int ai = 0; ai < 2; ++ai)
#pragma unroll
            for (int m = 0; m < 4; ++m) {
                const f32x4 g0 = acc[ai][0][m][0], g1 = acc[ai][0][m][1], u0 = acc[ai][1][m][0], u1 = acc[ai][1][m][1];
                u32x4 w;
                w.x = cvt_pk_bf16(g0[0] * sigmoidf_(g0[0]) * u0[0], g0[1] * sigmoidf_(g0[1]) * u0[1]); w.y = cvt_pk_bf16(g0[2] * sigmoidf_(g0[2]) * u0[2], g0[3] * sigmoidf_(g0[3]) * u0[3]);
                w.z = cvt_pk_bf16(g1[0] * sigmoidf_(g1[0]) * u1[0], g1[1] * sigmoidf_(g1[1]) * u1[1]); w.w = cvt_pk_bf16(g1[2] * sigmoidf_(g1[2]) * u1[2], g1[3] * sigmoidf_(g1[3]) * u1[3]);
                *(u32x4*)(O + (size_t)(row0 + ai * HALF + m * 16) * ldc + col0) = w; }
    }
};

template <class Epi, class Sched, bool ALIGN_EPI>
__device__ __forceinline__ void gemm_phase(PG8_LAS unsigned char* lds, const Gemm g, const Sched& S, const Epi& E) {
    int tid_ = threadIdx.x; asm volatile("" : "+v"(tid_));
    const int tid = tid_, wid = __builtin_amdgcn_readfirstlane(tid >> 6), lane = tid & 63, wr = wid >> 2, wc = wid & 3, fr = lane & 15, fq = lane >> 4;
    const int nt = g.K / BK;
    unsigned voffA[2], voffB[2];
#pragma unroll
    for (int i = 0; i < 2; ++i) { int R, C; stage_rc(tid * 16 + i * 8192, R, C); const int Rb = Epi::PERM ? ((R & ~31) + perm32(R & 31)) : R;
        voffA[i] = (unsigned)(R * g.lda + C) * 2u; voffB[i] = (unsigned)(Rb * g.ldb + C) * 2u; }
    const size_t kstep = (size_t)(BK * 2);
    const size_t hstepA = (size_t)HALF * g.lda * 2, hstepB = (size_t)HALF * g.ldb * 2;
    const size_t tstepA = 2 * hstepA, tstepB = 2 * hstepB;
    const unsigned ldsw = (unsigned)wid * 1024u;
    const size_t tailoff = (size_t)(nt - 2) * (size_t)(BK * 2);
    const int aoff = lds_byte(wr * 64 + fr, fq * 8), boff = lds_byte(wc * 32 + fr, fq * 8);
#define PG8_SA(b, h) (((b) * 2 + (h)) * HTB)
#define PG8_SB(b, h) ((4 + (b) * 2 + (h)) * HTB)
#define PG8_STAGE(bufoff, gbase, voff) do { _Pragma("unroll") for (int _i = 0; _i < 2; ++_i) \
        __builtin_amdgcn_global_load_lds((const unsigned*)((const char*)(gbase) + (voff)[_i]), (PG8_LAS unsigned*)(lds + (bufoff) + ldsw + _i * 8192), 16, 0, 0); } while (0)
#define PG8_LDA(dst, b, h) do { _Pragma("unroll") for (int m = 0; m < 4; ++m) _Pragma("unroll") for (int k = 0; k < 2; ++k) dst[m][k] = *(const PG8_LAS bf16x8*)(lds + PG8_SA(b, h) + aoff + m * 2048 + k * 1024); } while (0)
#define PG8_LDB(dst, b, h) do { _Pragma("unroll") for (int n = 0; n < 2; ++n) _Pragma("unroll") for (int k = 0; k < 2; ++k) dst[n][k] = *(const PG8_LAS bf16x8*)(lds + PG8_SB(b, h) + boff + n * 2048 + k * 1024); } while (0)
#define PG8_MMA(ai, bj, At, Bt) do { __builtin_amdgcn_s_setprio(1); _Pragma("unroll") for (int m = 0; m < 4; ++m) _Pragma("unroll") for (int n = 0; n < 2; ++n) _Pragma("unroll") for (int k = 0; k < 2; ++k) \
        acc[ai][bj][m][n] = __builtin_amdgcn_mfma_f32_16x16x32_bf16(Bt[n][k], At[m][k], acc[ai][bj][m][n], 0, 0, 0); __builtin_amdgcn_s_setprio(0); } while (0)
#define PG8_WAIT_V(n) asm volatile("s_waitcnt vmcnt(" #n ")" ::: "memory")
#define PG8_WAIT_L(n) asm volatile("s_waitcnt lgkmcnt(" #n ")" ::: "memory")
#define PG8_BAR __builtin_amdgcn_s_barrier()
#define PG8_SCHED __builtin_amdgcn_sched_barrier(0)
    Unit cur, nxt; int ui = 0;
    if (!S.next(0, cur)) return;
    f32x4 acc[2][2][4][2];
#pragma unroll
    for (int a = 0; a < 2; ++a)
#pragma unroll
        for (int b = 0; b < 2; ++b)
#pragma unroll
            for (int m = 0; m < 4; ++m)
#pragma unroll
                for (int n = 0; n < 2; ++n) acc[a][b][m][n] = (f32x4){0.f, 0.f, 0.f, 0.f};
    bf16x8 At[4][2], B0[2][2], B1[2][2];
    const char* cA = (const char*)g.A + (size_t)cur.pm * tstepA; const char* cB = (const char*)g.Bt + (size_t)cur.pn * tstepB;
    PG8_STAGE(PG8_SB(0, 0), cB, voffB); PG8_STAGE(PG8_SB(0, 1), cB + hstepB, voffB); PG8_STAGE(PG8_SA(0, 0), cA, voffA); PG8_STAGE(PG8_SA(0, 1), cA + hstepA, voffA);
    if (wr == 1) PG8_BAR;
    PG8_WAIT_V(2); PG8_BAR;
    PG8_STAGE(PG8_SB(1, 0), cB + kstep, voffB); PG8_STAGE(PG8_SA(1, 0), cA + kstep, voffA); PG8_STAGE(PG8_SB(1, 1), cB + hstepB + kstep, voffB);
    PG8_WAIT_V(6); PG8_BAR;
    for (;;) {
        const bool has_next = S.next(ui + 1, nxt);
        const size_t tail_ = has_next ? 0 : tailoff; const char* nA = (has_next ? (const char*)g.A + (size_t)nxt.pm * tstepA : cA) + tail_; const char* nB = (has_next ? (const char*)g.Bt + (size_t)nxt.pn * tstepB : cB) + tail_;
        for (int t = 0; t < nt; t += 2) {
            if constexpr (Epi::MIDK) { if (t == (nt >> 1)) E.midk(acc, cur, wr, fr); }
            const bool last = (t == nt - 2);
            const char* a1 = cA + (size_t)(t + 1) * kstep;
            const char* a2 = last ? nA : cA + (size_t)(t + 2) * kstep; const char* b2 = last ? nB : cB + (size_t)(t + 2) * kstep;
            const char* a3 = a2 + kstep; const char* b3 = b2 + kstep;
            PG8_LDB(B0, 0, 0); PG8_LDB(B1, 0, 1); PG8_SCHED; PG8_LDA(At, 0, 0); PG8_STAGE(PG8_SA(1, 1), a1 + hstepA, voffA);
            PG8_WAIT_V(8); PG8_WAIT_L(0); PG8_BAR; PG8_MMA(0, 0, At, B0); PG8_MMA(0, 1, At, B1); PG8_BAR; PG8_SCHED;
            PG8_LDA(At, 0, 1); PG8_STAGE(PG8_SB(0, 0), b2, voffB); PG8_STAGE(PG8_SB(0, 1), b2 + hstepB, voffB); PG8_STAGE(PG8_SA(0, 0), a2, voffA);
            PG8_WAIT_V(8); PG8_WAIT_L(0); PG8_BAR; PG8_MMA(1, 0, At, B0); PG8_MMA(1, 1, At, B1); PG8_BAR; PG8_SCHED;
            PG8_LDB(B0, 1, 0); PG8_LDB(B1, 1, 1); PG8_SCHED; PG8_LDA(At, 1, 0); PG8_STAGE(PG8_SA(0, 1), a2 + hstepA, voffA);
            PG8_WAIT_V(8); PG8_WAIT_L(0); PG8_BAR; PG8_MMA(0, 0, At, B0); PG8_MMA(0, 1, At, B1); PG8_BAR; PG8_SCHED;
            PG8_LDA(At, 1, 1); PG8_STAGE(PG8_SB(1, 0), b3, voffB); PG8_STAGE(PG8_SB(1, 1), b3 + hstepB, voffB); PG8_STAGE(PG8_SA(1, 0), a3, voffA);
            PG8_WAIT_V(8); PG8_WAIT_L(0); PG8_BAR; PG8_MMA(1, 0, At, B0); PG8_MMA(1, 1, At, B1); PG8_BAR; PG8_SCHED;
        }
        if constexpr (ALIGN_EPI) { if (wr == 0) PG8_BAR; }
        E(acc, cur, wr, wc, fr, fq);
        if (!has_next) break;
#pragma unroll
        for (int a = 0; a < 2; ++a)
#pragma unroll
            for (int b = 0; b < 2; ++b)
#pragma unroll
                for (int m = 0; m < 4; ++m)
#pragma unroll
                    for (int n = 0; n < 2; ++n) acc[a][b][m][n] = (f32x4){0.f, 0.f, 0.f, 0.f};
        cur = nxt; cA = nA; cB = nB; ++ui;
        if constexpr (ALIGN_EPI) { if (wr == 1) PG8_BAR; }
    }
    PG8_WAIT_V(0);
    if constexpr (!ALIGN_EPI) { if (wr == 0) PG8_BAR; }
    PG8_BAR;
#undef PG8_SA
#undef PG8_SB
#undef PG8_STAGE
#undef PG8_LDA
#undef PG8_LDB
#undef PG8_MMA
#undef PG8_WAIT_V
#undef PG8_WAIT_L
#undef PG8_BAR
#undef PG8_SCHED
}
}

constexpr int NWAVES = 8;
constexpr int BATCH = 8, SEQ = 2048, DM = 2048, M = BATCH * SEQ;
constexpr int D_ATTN = 1024, D_KV = 256, D_SSM = 1024, D_IN = 2560, D_FF = 5632, NQH = 16, NKVH = 4, HD = 64;
constexpr int NG = 64, NST = 64, PCH = 16, CH = 16, NCH = SEQ / CH;
constexpr int A2LD = 384;
constexpr float RMS_EPS = 1e-6f;

constexpr size_t MiB = 1u << 20;
constexpr size_t WS_CTL = 0, CTL_ZERO_BYTES = 1 * MiB;
constexpr size_t WS_WIN = 2 * MiB, WS_WGLU = 12 * MiB, WS_WO = 14 * MiB, WS_WGU = 22 * MiB, WS_WD = 66 * MiB;
constexpr size_t WS_TC = 88 * MiB, WS_BZ = 100 * MiB, WS_LAM = 108 * MiB, WS_RH = 109 * MiB, WS_RX = 110 * MiB;
constexpr size_t WS_R1 = 112 * MiB;
constexpr size_t WS_R2 = 176 * MiB;
constexpr size_t WS_Q = WS_R2, WS_K = WS_R2 + 32 * MiB, WS_VT = WS_R2 + 40 * MiB;
constexpr size_t WS_A3 = 240 * MiB, WS_Z = 304 * MiB;
constexpr size_t WS_A2 = 336 * MiB;
constexpr size_t WS_ZS = 384 * MiB;
constexpr size_t WS_HID = 336 * MiB;
constexpr size_t WS_END = 512 * MiB;
constexpr int CW_BAR = 4096, CW_TEAM = 16384, CW_STAT_A = 65536, CW_STAT_S = 81920;

constexpr int RING_BYTES = 131072, LDSCTL_OFF = RING_BYTES, MISC_OFF = LDSCTL_OFF + 320, LDS_BYTES = 147456;

#define GAS __attribute__((address_space(1)))
#define LAS __attribute__((address_space(3)))
typedef unsigned short bf16;
typedef unsigned v4u __attribute__((ext_vector_type(4)));
typedef unsigned v2u __attribute__((ext_vector_type(2)));
typedef float f32x4 __attribute__((ext_vector_type(4)));
typedef float f32x16 __attribute__((ext_vector_type(16)));
typedef short bf16x8 __attribute__((ext_vector_type(8)));
#define LDS_WAIT() asm volatile("s_waitcnt lgkmcnt(0)" ::: "memory")
using pg8::cvt_pk_bf16; using pg8::bf_lo; using pg8::bf_hi;

#define XB_TMO      128
#define XB_XCNT(j)  (256  + 64 * (j))
#define XB_XSUB(j)  (1280 + 64 * (j))
#define XB_XGEN(j)  (2304 + 64 * (j))
#define XB_TOP      3328
#define XB_TOPGEN   3392
#define XCD_BAR_WORDS 3456
#define XB_SPIN_CAP (1u << 18)
__device__ __forceinline__ unsigned xb_ld(unsigned* p)              { return __hip_atomic_load(p, __ATOMIC_RELAXED, __HIP_MEMORY_SCOPE_AGENT); }
__device__ __forceinline__ unsigned xb_add(unsigned* p, unsigned v) { return __hip_atomic_fetch_add(p, v, __ATOMIC_RELAXED, __HIP_MEMORY_SCOPE_AGENT); }
__device__ __forceinline__ unsigned xb_xcc_id() { return (unsigned)__builtin_amdgcn_s_getreg((3 << 11) | 20) & 0xFu; }
#define XB_SPIN(cond, bar) do { unsigned _sp = 0; while (cond) { __builtin_amdgcn_s_sleep(1); \
    if ((++_sp & 255u) == 0u) { if (xb_ld(&(bar)[XB_TMO])) break; if (_sp > XB_SPIN_CAP) { atomicAdd(&(bar)[XB_TMO], 1u); break; } } } } while (0)
struct XcdBarrier { unsigned* bar; unsigned x; volatile LAS unsigned* st; };
__device__ __forceinline__ XcdBarrier xcd_barrier_post(unsigned* bar, volatile LAS unsigned* st) {
    XcdBarrier b; b.bar = bar; b.x = xb_xcc_id(); b.st = st;
    if (threadIdx.x == 0) (void)xb_add(&bar[XB_XCNT(b.x)], 1u);
    return b;
}
__device__ __forceinline__ void xcd_barrier_complete(unsigned* bar, unsigned x, unsigned& nloc, unsigned& nx) {
    const unsigned G = gridDim.x * gridDim.y * gridDim.z;
    unsigned sum, cnt, mine, sp = 0u;
    for (;;) {
        sum = 0u; cnt = 0u; mine = 0u;
#pragma unroll
        for (unsigned j = 0; j < 16; ++j) { const unsigned c = xb_ld(&bar[XB_XCNT(j)]); sum += c; cnt += (c > 0u) ? 1u : 0u; mine = (j == x) ? c : mine; }
        if (sum == G) break;
        __builtin_amdgcn_s_sleep(1);
        if ((++sp & 255u) == 0u) { if (xb_ld(&bar[XB_TMO])) break; if (sp > XB_SPIN_CAP) { atomicAdd(&bar[XB_TMO], 1u); break; } }
    }
    nloc = mine > 0u ? mine : 1u; nx = cnt > 0u ? cnt : 1u;
}
__device__ __forceinline__ void xcd_barrier(const XcdBarrier& b) {
    asm volatile("s_waitcnt vmcnt(0)" ::: "memory");
    __syncthreads();
    if (threadIdx.x == 0) {
        unsigned* bar = b.bar;
        __builtin_amdgcn_s_waitcnt(0);
        unsigned nloc = b.st[0], nx = b.st[1];
        if (nloc == 0u) { xcd_barrier_complete(bar, b.x, nloc, nx); b.st[0] = nloc; b.st[1] = nx; }
        const unsigned old = xb_add(&bar[XB_XSUB(b.x)], 1u);
        const unsigned gen = old / nloc;
        if (old + 1u == (gen + 1u) * nloc) {
            __builtin_amdgcn_fence(__ATOMIC_RELEASE, "agent");
            asm volatile("s_waitcnt vmcnt(0)" ::: "memory");
            const unsigned og = xb_add(&bar[XB_TOP], 1u);
            const unsigned tg = og / nx;
            if (og + 1u == (tg + 1u) * nx) xb_add(&bar[XB_TOPGEN], 1u);
            else XB_SPIN(xb_ld(&bar[XB_TOPGEN]) == tg, bar);
            __builtin_amdgcn_fence(__ATOMIC_ACQUIRE, "agent");
            xb_add(&bar[XB_XGEN(b.x)], 1u);
            asm volatile("s_waitcnt vmcnt(0)" ::: "memory");
        } else {
            XB_SPIN(xb_ld(&bar[XB_XGEN(b.x)]) == gen, bar);
            __builtin_amdgcn_fence(__ATOMIC_ACQUIRE, "agent");
            asm volatile("s_waitcnt vmcnt(0)" ::: "memory");
        }
    }
    __syncthreads();
}

__device__ __forceinline__ void team_barrier(unsigned* cnt, unsigned* tmo, unsigned& epoch, volatile LAS unsigned* same_xcd) {
    asm volatile("s_waitcnt vmcnt(0)" ::: "memory");
    __syncthreads();
    if (threadIdx.x == 0) {
        if (*same_xcd != 1u) { __builtin_amdgcn_fence(__ATOMIC_RELEASE, "agent"); }
        asm volatile("s_waitcnt vmcnt(0)" ::: "memory");
        (void)xb_add(cnt, 1u);
        const unsigned want = 4u * epoch; unsigned sp = 0u;
        while (xb_ld(cnt) < want) { __builtin_amdgcn_s_sleep(1); if ((++sp & 255u) == 0u) { if (xb_ld(tmo)) break; if (sp > XB_SPIN_CAP) { atomicAdd(tmo, 1u); break; } } }
        __builtin_amdgcn_fence(__ATOMIC_ACQUIRE, "agent");
        asm volatile("s_waitcnt vmcnt(0)" ::: "memory");
    }
    __syncthreads();
    ++epoch;
}

__device__ __forceinline__ float wave_sum(float v) {
#pragma unroll
    for (int o = 1; o < 64; o <<= 1) v += __shfl_xor(v, o);
    return v;
}
__device__ __forceinline__ void sincos_rev(double rev, float& s, float& c) {
    const double fr = rev - __builtin_rint(rev); const float f = (float)fr;
    s = __builtin_amdgcn_sinf(f); c = __builtin_amdgcn_cosf(f);
}
enum { MAP_PLAIN = 0, MAP_WIN = 1, MAP_GATE = 2, MAP_UP = 3 };
template <int MODE> __device__ __forceinline__ int map_row(int n) {
    if (MODE == MAP_WIN) {
        if (n < 1280) { const int d = n & 63; return (n & ~63) + (d < 32 ? 2 * d : 2 * (d - 32) + 1); }
        if (n < 1536) return 2304 + (n - 1280);
        return 1280 + (n - 1536);
    }
    if (MODE == MAP_GATE) return ((n >> 7) << 8) + (n & 127);
    if (MODE == MAP_UP) return ((n >> 7) << 8) + 128 + (n & 127);
    return n;
}
template <int MODE> __device__ __forceinline__ void transpose_item(const float* W, int K, int N, bf16* WT, const float* gs, LAS float* scr, int item, int lane) {
    const int nblk = N / 32, kb = item / nblk, nb = item % nblk, k0 = 64 * kb, n0 = 32 * nb;
    const float* src = W + (size_t)(k0 + (lane >> 5)) * N + n0 + (lane & 31);
    float v[32];
#pragma unroll
    for (int i = 0; i < 32; ++i) v[i] = src[(size_t)(2 * i) * N];
    const int c = lane & 7;
    f32x4 g0 = (f32x4){1.f, 1.f, 1.f, 1.f}, g1 = g0;
    if (gs) { g0 = *(const f32x4*)(gs + k0 + 8 * c); g1 = *(const f32x4*)(gs + k0 + 8 * c + 4); }
    LAS float* sw = scr + (lane >> 5) * 33 + (lane & 31);
#pragma unroll
    for (int i = 0; i < 32; ++i) sw[(2 * i) * 33] = v[i];
    LDS_WAIT(); asm volatile("" ::: "memory");
#pragma unroll
    for (int j = 0; j < 4; ++j) { const int n = (lane >> 3) + 8 * j; const LAS float* s = scr + (8 * c) * 33 + n;
        v4u o; o.x = cvt_pk_bf16(s[0 * 33] * g0.x, s[1 * 33] * g0.y); o.y = cvt_pk_bf16(s[2 * 33] * g0.z, s[3 * 33] * g0.w); o.z = cvt_pk_bf16(s[4 * 33] * g1.x, s[5 * 33] * g1.y); o.w = cvt_pk_bf16(s[6 * 33] * g1.z, s[7 * 33] * g1.w);
        *(v4u*)(WT + (size_t)map_row<MODE>(n0 + n) * K + k0 + 8 * c) = o; }
    LDS_WAIT(); asm volatile("" ::: "memory");
}

struct TrDesc { const float* W; bf16* WT; const float* gs; int K, N, mode, item; };
struct TrRegs { float v[32]; f32x4 g0, g1; };
__device__ __forceinline__ int map_row_rt(int mode, int n) {
    if (mode == MAP_WIN) return map_row<MAP_WIN>(n);
    if (mode == MAP_GATE) return map_row<MAP_GATE>(n);
    if (mode == MAP_UP) return map_row<MAP_UP>(n);
    return n;
}
__device__ __forceinline__ void tr_load(const TrDesc& d, int lane, TrRegs& t) {
    const int nblk = d.N / 32, kb = d.item / nblk, nb = d.item - kb * nblk, k0 = 64 * kb, n0 = 32 * nb;
    const float* src = d.W + (size_t)(k0 + (lane >> 5)) * d.N + n0 + (lane & 31);
#pragma unroll
    for (int i = 0; i < 32; ++i) t.v[i] = src[(size_t)(2 * i) * d.N];
    const int c = lane & 7;
    t.g0 = (f32x4){1.f, 1.f, 1.f, 1.f}; t.g1 = t.g0;
    if (d.gs) { t.g0 = *(const f32x4*)(d.gs + k0 + 8 * c); t.g1 = *(const f32x4*)(d.gs + k0 + 8 * c + 4); }
}
__device__ __forceinline__ void tr_finish(const TrDesc& d, const TrRegs& t, LAS float* scr, int lane) {
    const int nblk = d.N / 32, kb = d.item / nblk, nb = d.item - kb * nblk, k0 = 64 * kb, n0 = 32 * nb, c = lane & 7;
    LAS float* sw = scr + (lane >> 5) * 33 + (lane & 31);
#pragma unroll
    for (int i = 0; i < 32; ++i) sw[(2 * i) * 33] = t.v[i];
    LDS_WAIT(); asm volatile("" ::: "memory");
#pragma unroll
    for (int j = 0; j < 4; ++j) { const int n = (lane >> 3) + 8 * j; const LAS float* s = scr + (8 * c) * 33 + n;
        v4u o; o.x = cvt_pk_bf16(s[0 * 33] * t.g0.x, s[1 * 33] * t.g0.y); o.y = cvt_pk_bf16(s[2 * 33] * t.g0.z, s[3 * 33] * t.g0.w); o.z = cvt_pk_bf16(s[4 * 33] * t.g1.x, s[5 * 33] * t.g1.y); o.w = cvt_pk_bf16(s[6 * 33] * t.g1.z, s[7 * 33] * t.g1.w);
        *(v4u*)(d.WT + (size_t)map_row_rt(d.mode, n0 + n) * d.K + k0 + 8 * c) = o; }
    LDS_WAIT(); asm volatile("" ::: "memory");
}

struct Args {
    const float* x; const int* pos; const float* g_pre_mix; const float* w_in; const float* sinks; const float* a_re; const float* a_im; const float* log_dt;
    const float* b_re; const float* b_im; const float* c_re; const float* c_im; const float* d_skip; const float* w_glu; const float* b_glu;
    const float* g_attn_out; const float* g_ssm_out; const float* w_o; const float* g_post_mix; const float* g_pre_ffn; const float* w_gate; const float* w_up;
    const float* w_down; const float* g_post_ffn; float* out; unsigned char* ws;
};

__device__ __forceinline__ void ssm_precompute(const Args& a, int g, LAS unsigned char* lds, int tid) {
    typedef float f32x2v __attribute__((ext_vector_type(2)));
    LAS f32x2v* P = (LAS f32x2v*)lds;
    LAS f32x2v* Bb = (LAS f32x2v*)(lds + 8704);
    LAS f32x2v* Cc = (LAS f32x2v*)(lds + 8704 + 8192);
    LAS float* Kk = (LAS float*)(lds + 8704 + 16384);
    const float dt = __builtin_amdgcn_exp2f(a.log_dt[g] * 1.4426950408889634f);
    for (int e = tid; e < 17 * 64; e += 512) { const int k = e >> 6, n = e & 63; const float ar = a.a_re[g * 64 + n], ai = a.a_im[g * 64 + n];
        const float mag = __builtin_amdgcn_exp2f((float)k * ar * dt * 1.4426950408889634f); float s, c; sincos_rev((double)k * (double)ai * (double)dt * 0.15915494309189535, s, c);
        P[e] = (f32x2v){mag * c, mag * s}; }
    for (int e = tid; e < 1024; e += 512) { const int n = e >> 4; const float ar = a.a_re[g * 64 + n], ai = a.a_im[g * 64 + n];
        const float mag = __builtin_amdgcn_exp2f(ar * dt * 1.4426950408889634f); float s, c; sincos_rev((double)ai * (double)dt * 0.15915494309189535, s, c);
        const float lr = mag * c, li = mag * s, den = ar * ar + ai * ai, nr = lr - 1.0f, ni = li;
        const float fre = (nr * ar + ni * ai) / den, fim = (ni * ar - nr * ai) / den;
        const float br = a.b_re[(size_t)g * 1024 + e], bi = a.b_im[(size_t)g * 1024 + e];
        Bb[e] = (f32x2v){fre * br - fim * bi, fre * bi + fim * br};
        Cc[e] = (f32x2v){a.c_re[(size_t)g * 1024 + e], a.c_im[(size_t)g * 1024 + e]}; }
    LDS_WAIT(); __syncthreads();
    for (int e = tid; e < 4096; e += 512) { const int k = e >> 8, p = (e >> 4) & 15, q = e & 15; float s = 0.f;
        for (int n = 0; n < 64; ++n) { const f32x2v c = Cc[p * 64 + n], l = P[k * 64 + n], b = Bb[n * 16 + q];
            const float tr = c.x * l.x - c.y * l.y, ti = c.x * l.y + c.y * l.x; s += tr * b.x - ti * b.y; }
        Kk[e] = s; }
    LDS_WAIT(); __syncthreads();
    bf16* TC = (bf16*)(a.ws + WS_TC) + (size_t)g * 256 * A2LD;
    bf16* BZ = (bf16*)(a.ws + WS_BZ) + (size_t)g * 256 * 256;
    {
        const int row = tid >> 1, j = row >> 4, p = row & 15; const float dp = a.d_skip[g * 16 + p];
        for (int ci = 0; ci < 16; ++ci) { const int col0 = 128 * (tid & 1) + 8 * ci, i = col0 >> 4, q0 = col0 & 15; float v[8];
#pragma unroll
            for (int e = 0; e < 8; ++e) { float t = 0.f; if (i <= j) { t = Kk[((j - i) * 16 + p) * 16 + q0 + e]; if (i == j && q0 + e == p) t += dp; } v[e] = t; }
            v4u o; o.x = cvt_pk_bf16(v[0], v[1]); o.y = cvt_pk_bf16(v[2], v[3]); o.z = cvt_pk_bf16(v[4], v[5]); o.w = cvt_pk_bf16(v[6], v[7]);
            *(v4u*)(TC + (size_t)row * A2LD + col0) = o; }
        for (int ci = 0; ci < 8; ++ci) { const int n0 = 32 * (tid & 1) + 4 * ci; float v[8];
#pragma unroll
            for (int e = 0; e < 4; ++e) { const f32x2v c = Cc[p * 64 + n0 + e], l = P[(j + 1) * 64 + n0 + e]; v[2 * e] = c.x * l.x - c.y * l.y; v[2 * e + 1] = -(c.x * l.y + c.y * l.x); }
            v4u o; o.x = cvt_pk_bf16(v[0], v[1]); o.y = cvt_pk_bf16(v[2], v[3]); o.z = cvt_pk_bf16(v[4], v[5]); o.w = cvt_pk_bf16(v[6], v[7]);
            *(v4u*)(TC + (size_t)row * A2LD + 256 + 2 * n0) = o; }
    }
    {
        const int row = tid >> 2, n = row >> 1, ri = row & 1;
        for (int ci = 0; ci < 8; ++ci) { const int col0 = 64 * (tid & 3) + 8 * ci, i = col0 >> 4, q0 = col0 & 15; float v[8];
#pragma unroll
            for (int e = 0; e < 8; ++e) { const f32x2v l = P[(15 - i) * 64 + n], b = Bb[n * 16 + q0 + e]; v[e] = ri ? (l.x * b.y + l.y * b.x) : (l.x * b.x - l.y * b.y); }
            v4u o; o.x = cvt_pk_bf16(v[0], v[1]); o.y = cvt_pk_bf16(v[2], v[3]); o.z = cvt_pk_bf16(v[4], v[5]); o.w = cvt_pk_bf16(v[6], v[7]);
            *(v4u*)(BZ + (size_t)row * 256 + col0) = o;
            *(v4u*)(BZ + (size_t)(128 + row) * 256 + col0) = (v4u){0u, 0u, 0u, 0u}; }
    }
    if (tid < 64) { const f32x2v l = P[16 * 64 + tid]; ((float*)(a.ws + WS_LAM))[(g * 64 + tid) * 2] = l.x; ((float*)(a.ws + WS_LAM))[(g * 64 + tid) * 2 + 1] = l.y; }
    LDS_WAIT(); __syncthreads();
}

constexpr int AT_KROW = 144, AT_VROW = 392, AT_V_OFF = 192 * AT_KROW, AT_LDS_BYTES = AT_V_OFF + 64 * AT_VROW;
__device__ __forceinline__ int crow(int r, int hi) { return (r & 3) + 8 * (r >> 2) + 4 * hi; }
__device__ __forceinline__ void attn_phase(LAS unsigned char* lds, int vcu, int G, const bf16* Qp, const bf16* Kp, const bf16* Vt, const float* sinks, bf16* AO, int ldo, float* st) {
    typedef unsigned long long u64;
    int tid = threadIdx.x; asm volatile("" : "+v"(tid));
    const int lane = tid & 63, wave = __builtin_amdgcn_readfirstlane(tid >> 6), r32 = lane & 31, hi = lane >> 5, hq = wave & 3, qsub = wave >> 2;
    const float NEG = -INFINITY;
    for (int id = vcu; id < 1024; id += G) {
        const int b = id >> 7, kvh = (id >> 5) & 3, q0 = 64 * (id & 31), h = kvh * 4 + hq;
        const size_t tok0 = (size_t)b * SEQ;
        const int jt0 = (q0 >= 128) ? 0 : (128 - q0) / 32;
        v4u kv[3], vv[3];
#pragma unroll
        for (int i = 0; i < 3; ++i) { const int c = tid + 512 * i, row = c >> 3, ch = c & 7, key = q0 - 128 + row;
            if (key >= 0) kv[i] = *(const v4u*)(Kp + (tok0 + key) * D_KV + kvh * HD + ch * 8); }
#pragma unroll
        for (int i = 0; i < 3; ++i) { const int c = tid + 512 * i, d = c / 24, ch = c - d * 24, key0 = q0 - 128 + 8 * ch;
            if (key0 >= 0) vv[i] = *(const v4u*)(Vt + (size_t)(kvh * HD + d) * M + tok0 + key0); }
        const bf16* qrow = Qp + (tok0 + q0 + 32 * qsub + r32) * D_ATTN + h * HD + 32 * hi;
        bf16x8 qf[4];
#pragma unroll
        for (int kk = 0; kk < 4; ++kk) qf[kk] = *(const bf16x8*)(qrow + 8 * kk);
#pragma unroll
        for (int i = 0; i < 3; ++i) { const int c = tid + 512 * i, row = c >> 3, ch = c & 7, key = q0 - 128 + row;
            if (key >= 0) *(LAS v4u*)(lds + row * AT_KROW + ch * 16) = kv[i]; }
#pragma unroll
        for (int i = 0; i < 3; ++i) { const int c = tid + 512 * i, d = c / 24, ch = c - d * 24, key0 = q0 - 128 + 8 * ch;
            if (key0 >= 0) { LAS u64* p = (LAS u64*)(lds + AT_V_OFF + d * AT_VROW + ch * 16); p[0] = ((u64)vv[i].y << 32) | vv[i].x; p[1] = ((u64)vv[i].w << 32) | vv[i].z; } }
        LDS_WAIT(); __syncthreads();
        f32x16 s[5];
#pragma unroll
        for (int kt = 0; kt < 5; ++kt) {
            if (kt + qsub >= jt0) {
                const LAS unsigned char* kp = lds + (32 * (kt + qsub) + r32) * AT_KROW + 64 * hi;
                f32x16 acc = {0.f, 0.f, 0.f, 0.f, 0.f, 0.f, 0.f, 0.f, 0.f, 0.f, 0.f, 0.f, 0.f, 0.f, 0.f, 0.f};
#pragma unroll
                for (int kk = 0; kk < 4; ++kk) acc = __builtin_amdgcn_mfma_f32_32x32x16_bf16(*(const LAS bf16x8*)(kp + 16 * kk), qf[kk], acc, 0, 0, 0);
                s[kt] = acc;
            } else {
#pragma unroll
                for (int r = 0; r < 16; ++r) s[kt][r] = NEG;
            }
        }
#pragma unroll
        for (int r = 0; r < 16; ++r) { const int cr = crow(r, hi); if (!(cr > r32)) s[0][r] = NEG; if (!(cr <= r32)) s[4][r] = NEG; }
        const float sk = sinks[h] * 1.4426950408889634f;
        float mx = sk;
#pragma unroll
        for (int kt = 0; kt < 5; ++kt)
#pragma unroll
            for (int r = 0; r < 16; ++r) mx = fmaxf(mx, s[kt][r]);
        mx = fmaxf(mx, __shfl_xor(mx, 32));
        float l = 0.f;
#pragma unroll
        for (int kt = 0; kt < 5; ++kt)
#pragma unroll
            for (int r = 0; r < 16; ++r) { const float p = __builtin_amdgcn_exp2f(s[kt][r] - mx); s[kt][r] = p; l += p; }
        l += __shfl_xor(l, 32);
        l += __builtin_amdgcn_exp2f(sk - mx);
        const float inv = 1.0f / l;
        f32x16 o[2];
#pragma unroll
        for (int d = 0; d < 2; ++d)
#pragma unroll
            for (int r = 0; r < 16; ++r) o[d][r] = 0.f;
#pragma unroll
        for (int kt = 0; kt < 5; ++kt) {
            if (kt + qsub >= jt0) {
#pragma unroll
                for (int s2 = 0; s2 < 2; ++s2) {
                    v4u pw; pw.x = cvt_pk_bf16(s[kt][8 * s2 + 0] * inv, s[kt][8 * s2 + 1] * inv); pw.y = cvt_pk_bf16(s[kt][8 * s2 + 2] * inv, s[kt][8 * s2 + 3] * inv);
                    pw.z = cvt_pk_bf16(s[kt][8 * s2 + 4] * inv, s[kt][8 * s2 + 5] * inv); pw.w = cvt_pk_bf16(s[kt][8 * s2 + 6] * inv, s[kt][8 * s2 + 7] * inv);
                    const bf16x8 pf = __builtin_bit_cast(bf16x8, pw);
#pragma unroll
                    for (int dh = 0; dh < 2; ++dh) {
                        const LAS u64* vp = (const LAS u64*)(lds + AT_V_OFF + (dh * 32 + r32) * AT_VROW + (32 * (kt + qsub) + 16 * s2 + 4 * hi) * 2);
                        const u64 lo = vp[0], hi8 = vp[2];
                        const v4u vw = (v4u){(unsigned)lo, (unsigned)(lo >> 32), (unsigned)hi8, (unsigned)(hi8 >> 32)};
                        o[dh] = __builtin_amdgcn_mfma_f32_32x32x16_bf16(__builtin_bit_cast(bf16x8, vw), pf, o[dh], 0, 0, 0);
                    }
                }
            }
        }
        {
            float ssq = 0.f;
#pragma unroll
            for (int dh = 0; dh < 2; ++dh)
#pragma unroll
                for (int r = 0; r < 16; ++r) ssq += o[dh][r] * o[dh][r];
            ssq += __shfl_xor(ssq, 32);
            if (hi == 0) (void)__hip_atomic_fetch_add(st + tok0 + q0 + 32 * qsub + r32, ssq, __ATOMIC_RELAXED, __HIP_MEMORY_SCOPE_AGENT);
        }
        bf16* orow = AO + (tok0 + q0 + 32 * qsub + r32) * (size_t)ldo + h * HD + 4 * hi;
#pragma unroll
        for (int dh = 0; dh < 2; ++dh)
#pragma unroll
            for (int g4 = 0; g4 < 4; ++g4) { v2u w; w.x = cvt_pk_bf16(o[dh][4 * g4], o[dh][4 * g4 + 1]); w.y = cvt_pk_bf16(o[dh][4 * g4 + 2], o[dh][4 * g4 + 3]);
                *(v2u*)(orow + dh * 32 + 8 * g4) = w; }
        LDS_WAIT(); __syncthreads();
    }
}

__global__ void __launch_bounds__(NWAVES * 64, 2) hymba_fwd(Args a) {
    extern __shared__ __attribute__((aligned(16))) unsigned char lds_raw[];
    LAS unsigned char* lds = (LAS unsigned char*)lds_raw;
    volatile LAS unsigned* MISC = (volatile LAS unsigned*)(lds + MISC_OFF);
    const int tid = threadIdx.x;
    const int G = gridDim.x; const int bx = blockIdx.x; const int vcu = (G % 8 == 0) ? (bx % 8) * (G / 8) + bx / 8 : bx;
    unsigned char* ws = a.ws;
    unsigned* ctl = (unsigned*)(ws + WS_CTL);
    for (int u = tid; u < (LDS_BYTES - LDSCTL_OFF) / 4; u += NWAVES * 64) ((LAS unsigned*)(lds + LDSCTL_OFF))[u] = 0u;
    __syncthreads();
    XcdBarrier bar = xcd_barrier_post(ctl + CW_BAR, MISC + 8);
#define GRID_BAR() xcd_barrier(bar)
    const int team_pm = 8 * (bx & 7) + ((bx >> 3) & 7), team_k = bx >> 6;
    unsigned team_epoch = 1u;
#define TEAM_BAR() team_barrier(ctl + CW_TEAM + 64 * team_pm, ctl + CW_BAR + XB_TMO, team_epoch, MISC + 12)
    if (tid == 0) __hip_atomic_store(ctl + CW_TEAM + 64 * team_pm + 8 + team_k, 0x100u | bar.x, __ATOMIC_RELAXED, __HIP_MEMORY_SCOPE_AGENT);
    const int NGW = G * NWAVES;
#define PHASE_IDS() int tid_l = threadIdx.x; asm volatile("" : "+v"(tid_l)); const int lane = tid_l & 63, wave = __builtin_amdgcn_readfirstlane(tid_l >> 6), gw = vcu * NWAVES + wave; (void)lane; (void)gw
    bf16* Win_t = (bf16*)(ws + WS_WIN); bf16* Wglu_t = (bf16*)(ws + WS_WGLU); bf16* Wo_t = (bf16*)(ws + WS_WO); bf16* Wgu_t = (bf16*)(ws + WS_WGU); bf16* Wd_t = (bf16*)(ws + WS_WD);
    bf16* R1 = (bf16*)(ws + WS_R1); bf16* Qp = (bf16*)(ws + WS_Q); bf16* Kp = (bf16*)(ws + WS_K); bf16* Vt = (bf16*)(ws + WS_VT); bf16* MIX = (bf16*)(ws + WS_R2);
    bf16* A2 = (bf16*)(ws + WS_A2); float* Zst = (float*)(ws + WS_ZS); bf16* Zb = (bf16*)(ws + WS_Z); bf16* A3 = (bf16*)(ws + WS_A3); float* stat_a = (float*)(ctl + CW_STAT_A); float* stat_s = (float*)(ctl + CW_STAT_S); bf16* HID = (bf16*)(ws + WS_HID);

    {
        PHASE_IDS();
        if (bx < NG) ssm_precompute(a, bx, lds, tid_l);
        else {
            LAS float* scr = (LAS float*)(lds + wave * 16384);
            constexpr int I_IN = (DM / 64) * (D_IN / 32), I_GLU = (D_SSM / 64) * (D_SSM / 32), I_O = (DM / 64) * (DM / 32);
            constexpr int NITEMS = I_IN;
#define EARLY_DESC(D, IT) do { D = TrDesc{a.w_in, Win_t, a.g_pre_mix, DM, D_IN, MAP_WIN, (IT)}; } while (0)
            TrDesc dc, dn; TrRegs tc, tn;
            const int NCW = (G - NG) * NWAVES; int it = (bx - NG) * NWAVES + wave;
            if (it < NITEMS) { EARLY_DESC(dc, it); tr_load(dc, lane, tc); }
            while (it < NITEMS) {
                const int nx = it + NCW; const bool more = nx < NITEMS;
                if (more) { EARLY_DESC(dn, nx); tr_load(dn, lane, tn); }
                tr_finish(dc, tc, scr, lane);
                if (more) { dc = dn; tc = tn; }
                it = nx;
            }
#undef EARLY_DESC
        }
        for (int m = gw; m < M; m += 2 * NGW) {
            f32x4 v[2][8]; float s[2];
#pragma unroll
            for (int q = 0; q < 2; ++q) { const f32x4* xr = (const f32x4*)(a.x + (size_t)(m + q * NGW) * DM);
#pragma unroll
                for (int j = 0; j < 4; ++j) { v[q][2 * j] = xr[128 * j + 2 * lane]; v[q][2 * j + 1] = xr[128 * j + 2 * lane + 1]; } }
#pragma unroll
            for (int q = 0; q < 2; ++q) { float t = 0.f;
#pragma unroll
                for (int j = 0; j < 8; ++j) t += (v[q][j].x * v[q][j].x + v[q][j].y * v[q][j].y) + (v[q][j].z * v[q][j].z + v[q][j].w * v[q][j].w);
                s[q] = t; }
#pragma unroll
            for (int q = 0; q < 2; ++q) { const int mm = m + q * NGW;
                const float ms = wave_sum(s[q]) * (1.0f / DM) + RMS_EPS; const float r = 1.0f / sqrtf(ms);
                if (lane == 0) ((float*)(ws + WS_RX))[mm] = sqrtf(ms);
                v4u* o = (v4u*)(R1 + (size_t)mm * DM);
#pragma unroll
                for (int j = 0; j < 4; ++j) { v4u w; w.x = cvt_pk_bf16(v[q][2 * j].x * r, v[q][2 * j].y * r); w.y = cvt_pk_bf16(v[q][2 * j].z * r, v[q][2 * j].w * r);
                    w.z = cvt_pk_bf16(v[q][2 * j + 1].x * r, v[q][2 * j + 1].y * r); w.w = cvt_pk_bf16(v[q][2 * j + 1].z * r, v[q][2 * j + 1].w * r); o[64 * j + lane] = w; } }
        }
    }
    GRID_BAR();

    {
        PHASE_IDS();
        pg8::Gemm g{R1, Win_t, DM, DM, DM}; pg8::StaticOrder S; S.init(M, 2304, G, bx);
        LAS int* posl = (LAS int*)(lds + LDSCTL_OFF + 1024);
        if (tid_l < 256) posl[tid_l] = a.pos[team_pm * 256 + tid_l];
        LDS_WAIT(); __syncthreads();
        pg8::EpiQKU E{Qp, Kp, A2, posl};
        pg8::gemm_phase<pg8::EpiQKU, pg8::StaticOrder, true>(lds, g, S, E);
        pg8::Gemm g2{Win_t + (size_t)2304 * DM, R1, DM, DM, DM}; pg8::StaticOrder S2; S2.init(256, M, G, (bx + 192) % G);
        pg8::EpiBf16P E2{Vt, M};
        pg8::gemm_phase<pg8::EpiBf16P, pg8::StaticOrder, true>(lds, g2, S2, E2);
        if (bx >= G / 2) {
            int tid_c = threadIdx.x; asm volatile("" : "+v"(tid_c)); const int lane = tid_c & 63, wave = __builtin_amdgcn_readfirstlane(tid_c >> 6);
            LAS float* scr = (LAS float*)(lds + wave * 16384);
            constexpr int I_G = (DM / 64) * (D_FF / 32), I_D = (D_FF / 64) * (DM / 32);
            const int cw = (bx - G / 2) * NWAVES + wave, NCW = (G - G / 2) * NWAVES;
            constexpr int I_GLU = (D_SSM / 64) * (D_SSM / 32), I_O = (DM / 64) * (DM / 32);
            constexpr int NIT = I_GLU + I_O + 2 * I_G + I_D;
#define FFN_DESC(D, IT) do { int r_ = (IT); if (r_ < I_GLU) { D = TrDesc{a.w_glu, Wglu_t, nullptr, D_SSM, D_SSM, MAP_PLAIN, r_}; } \
                else if (r_ < I_GLU + I_O) { r_ -= I_GLU; D = TrDesc{a.w_o, Wo_t, (r_ / (DM / 32) < 16) ? a.g_attn_out : (a.g_ssm_out - 1024), DM, DM, MAP_PLAIN, r_}; } \
                else if ((r_ -= I_GLU + I_O) < I_G) { D = TrDesc{a.w_gate, Wgu_t, a.g_pre_ffn, DM, D_FF, MAP_GATE, r_}; } else if (r_ < 2 * I_G) { D = TrDesc{a.w_up, Wgu_t, a.g_pre_ffn, DM, D_FF, MAP_UP, r_ - I_G}; } \
                else { D = TrDesc{a.w_down, Wd_t, nullptr, D_FF, DM, MAP_PLAIN, r_ - 2 * I_G}; } } while (0)
            TrDesc dc, dn; TrRegs tc, tn;
            int it = cw;
            if (it < NIT) { FFN_DESC(dc, it); tr_load(dc, lane, tc); }
            while (it < NIT) {
                const int nx = it + NCW; const bool more = nx < NIT;
                if (more) { FFN_DESC(dn, nx); tr_load(dn, lane, tn); }
                tr_finish(dc, tc, scr, lane);
                if (more) { dc = dn; tc = tn; }
                it = nx;
            }
#undef FFN_DESC
        }
    }
    GRID_BAR();

    {
        PHASE_IDS();
        {
            pg8::Gemm g{A2, (const bf16*)(ws + WS_BZ), A2LD, 256, 256}; pg8::DiagOrder S{G, bx, 256};
            pg8::EpiZ E{Zst};
            pg8::gemm_phase<pg8::EpiZ, pg8::DiagOrder, true>(lds, g, S, E);
        }
        asm volatile("s_waitcnt vmcnt(0)" ::: "memory"); __syncthreads();
        {
            typedef float f32x2v __attribute__((ext_vector_type(2)));
            const int seq = wave >> 2, seg = wave & 3, g = bx >> 2, b = 2 * (bx & 3) + seq;
            const float lr = ((const float*)(ws + WS_LAM))[(g * 64 + lane) * 2], li = ((const float*)(ws + WS_LAM))[(g * 64 + lane) * 2 + 1];
            const size_t row0 = (size_t)g * 1024 + b * 128 + 32 * seg;
            const f32x2v* zp = (const f32x2v*)Zst + row0 * 64 + lane;
            f32x2v zz[32];
#pragma unroll
            for (int i = 0; i < 32; ++i) zz[i] = zp[(size_t)i * 64];
            float tr = 0.f, ti = 0.f;
#pragma unroll
            for (int i = 0; i < 32; ++i) { const float nr = lr * tr - li * ti + zz[i].x, ni = lr * ti + li * tr + zz[i].y; tr = nr; ti = ni; }
            float pr = lr, pi = li;
#pragma unroll
            for (int q = 0; q < 5; ++q) { const float nr = pr * pr - pi * pi, ni = 2.f * pr * pi; pr = nr; pi = ni; }
            LAS f32x2v* X = (LAS f32x2v*)lds;
            X[wave * 64 + lane] = (f32x2v){tr, ti};
            LDS_WAIT(); __syncthreads();
            float sr = 0.f, si = 0.f;
            for (int s = 0; s < seg; ++s) { const f32x2v t = X[(seq * 4 + s) * 64 + lane]; const float nr = pr * sr - pi * si + t.x, ni = pr * si + pi * sr + t.y; sr = nr; si = ni; }
            unsigned* sp = (unsigned*)(A2 + row0 * A2LD + 256) + lane;
#pragma unroll
            for (int i = 0; i < 32; ++i) {
                sp[(size_t)i * (A2LD / 2)] = cvt_pk_bf16(sr, si);
                const float nr = lr * sr - li * si + zz[i].x, ni = lr * si + li * sr + zz[i].y; sr = nr; si = ni;
            }
        }
        asm volatile("s_waitcnt vmcnt(0)" ::: "memory"); __syncthreads();
        {
            pg8::Gemm g{A2, (const bf16*)(ws + WS_TC), A2LD, A2LD, A2LD}; pg8::DiagOrder S{G, bx, 256};
            pg8::EpiY E{Zb};
            pg8::gemm_phase<pg8::EpiY, pg8::DiagOrder, true>(lds, g, S, E);
        }
        attn_phase(lds, vcu, G, Qp, Kp, Vt, a.sinks, A3, DM, stat_a);
    }
    GRID_BAR();

    if (tid == 0) { unsigned same = 1u; const unsigned me = 0x100u | bar.x;
        for (int k = 0; k < 4; ++k) same &= (xb_ld(ctl + CW_TEAM + 64 * team_pm + 8 + k) == me) ? 1u : 0u;
        MISC[12] = same; }
    __syncthreads();
    {
        PHASE_IDS();
        pg8::Gemm g{Zb, Wglu_t, D_SSM, D_SSM, D_SSM}; pg8::StaticOrder S; S.init(M, D_SSM, G, bx);
        pg8::EpiGlu E{Zb, a.b_glu, A3 + D_ATTN, DM, stat_s};
        pg8::gemm_phase<pg8::EpiGlu, pg8::StaticOrder, true>(lds, g, S, E);
    }
    TEAM_BAR();

    {
        PHASE_IDS();
        pg8::Gemm g{A3, Wo_t, DM, DM, DM}; pg8::StaticOrder S; S.init(M, DM, G, bx);
        LAS float* ratl = (LAS float*)(lds + LDSCTL_OFF + 2048); LAS float* rsl = ratl + 256;
        if (tid_l < 256) { const int row = team_pm * 256 + tid_l;
            const float sa = __uint_as_float(__hip_atomic_load((const unsigned*)(stat_a + row), __ATOMIC_RELAXED, __HIP_MEMORY_SCOPE_AGENT)), ss = __uint_as_float(__hip_atomic_load((const unsigned*)(stat_s + row), __ATOMIC_RELAXED, __HIP_MEMORY_SCOPE_AGENT));
            const float ra = 1.0f / sqrtf(sa * (1.0f / 1024.0f) + RMS_EPS), rsi = sqrtf(ss * (1.0f / 1024.0f) + RMS_EPS);
            ratl[tid_l] = ra * rsi; rsl[tid_l] = 1.0f / rsi; }
        LDS_WAIT(); __syncthreads();
        pg8::EpiMix E{MIX, DM, ratl, rsl};
        pg8::gemm_phase<pg8::EpiMix, pg8::StaticOrder, true>(lds, g, S, E);
    }
    TEAM_BAR();

    {
        PHASE_IDS();
        float* RH = (float*)(ws + WS_RH); const float* RX = (const float*)(ws + WS_RX);
        f32x4 gq[8];
#pragma unroll
        for (int j = 0; j < 4; ++j) { gq[2 * j] = ((const f32x4*)a.g_post_mix)[128 * j + 2 * lane]; gq[2 * j + 1] = ((const f32x4*)a.g_post_mix)[128 * j + 2 * lane + 1]; }
        for (int it = 0; it < 4; ++it) { const int mb = team_pm * 256 + team_k * 64 + wave * 8 + it * 2;
            v4u mv[2][4], xv[2][4]; float rxi[2], sm[2];
#pragma unroll
            for (int q = 0; q < 2; ++q) { const v4u* mr = (const v4u*)(MIX + (size_t)(mb + q) * DM); const v4u* xr = (const v4u*)(R1 + (size_t)(mb + q) * DM); rxi[q] = RX[mb + q];
#pragma unroll
                for (int j = 0; j < 4; ++j) { mv[q][j] = mr[64 * j + lane]; xv[q][j] = xr[64 * j + lane]; } }
#pragma unroll
            for (int q = 0; q < 2; ++q) { float t = 0.f;
#pragma unroll
                for (int j = 0; j < 4; ++j)
#pragma unroll
                    for (int e = 0; e < 4; ++e) { const float m0 = bf_lo(mv[q][j][e]), m1 = bf_hi(mv[q][j][e]); t += m0 * m0 + m1 * m1; }
                sm[q] = t; }
#pragma unroll
            for (int q = 0; q < 2; ++q) {
                const float rm = 1.0f / sqrtf(wave_sum(sm[q]) * (1.0f / DM) + RMS_EPS), rx = rxi[q];
                float sh = 0.f; v4u* xo = (v4u*)(R1 + (size_t)(mb + q) * DM); f32x4 hq[8];
#pragma unroll
                for (int j = 0; j < 4; ++j) {
                    const f32x4 g0 = gq[2 * j], g1 = gq[2 * j + 1]; const v4u mj = mv[q][j], xj = xv[q][j];
                    f32x4 h0, h1;
                    h0.x = bf_lo(xj.x) * rx + bf_lo(mj.x) * rm * g0.x; h0.y = bf_hi(xj.x) * rx + bf_hi(mj.x) * rm * g0.y; h0.z = bf_lo(xj.y) * rx + bf_lo(mj.y) * rm * g0.z; h0.w = bf_hi(xj.y) * rx + bf_hi(mj.y) * rm * g0.w;
                    h1.x = bf_lo(xj.z) * rx + bf_lo(mj.z) * rm * g1.x; h1.y = bf_hi(xj.z) * rx + bf_hi(mj.z) * rm * g1.y; h1.z = bf_lo(xj.w) * rx + bf_lo(mj.w) * rm * g1.z; h1.w = bf_hi(xj.w) * rx + bf_hi(mj.w) * rm * g1.w;
                    sh += (h0.x * h0.x + h0.y * h0.y) + (h0.z * h0.z + h0.w * h0.w) + (h1.x * h1.x + h1.y * h1.y) + (h1.z * h1.z + h1.w * h1.w);
                    hq[2 * j] = h0; hq[2 * j + 1] = h1;
                }
                const float msh = wave_sum(sh) * (1.0f / DM) + RMS_EPS, rh = 1.0f / sqrtf(msh);
                if (lane == 0) RH[mb + q] = sqrtf(msh);
#pragma unroll
                for (int j = 0; j < 4; ++j) { const f32x4 h0 = hq[2 * j] * rh, h1 = hq[2 * j + 1] * rh;
                    v4u w; w.x = cvt_pk_bf16(h0.x, h0.y); w.y = cvt_pk_bf16(h0.z, h0.w); w.z = cvt_pk_bf16(h1.x, h1.y); w.w = cvt_pk_bf16(h1.z, h1.w); xo[64 * j + lane] = w; }
            }
        }
    }
    TEAM_BAR();

    {
        PHASE_IDS();
        pg8::Gemm g{R1, Wgu_t, DM, DM, DM}; pg8::StaticOrder S; S.init(M, 2 * D_FF, G, bx);
        pg8::EpiSwiGLU E{HID, D_FF, (const float*)(ws + WS_RH)};
        pg8::gemm_phase<pg8::EpiSwiGLU, pg8::StaticOrder, true>(lds, g, S, E);
    }
    TEAM_BAR();

    {
        PHASE_IDS();
        pg8::Gemm g{HID, Wd_t, D_FF, D_FF, D_FF}; pg8::StaticOrder S; S.init(M, DM, G, bx);
        pg8::EpiBf16P E{MIX, DM};
        pg8::gemm_phase<pg8::EpiBf16P, pg8::StaticOrder, true>(lds, g, S, E);
    }
    TEAM_BAR();

    {
        PHASE_IDS();
        f32x4 gq[8];
#pragma unroll
        for (int j = 0; j < 4; ++j) { gq[2 * j] = ((const f32x4*)a.g_post_ffn)[128 * j + 2 * lane]; gq[2 * j + 1] = ((const f32x4*)a.g_post_ffn)[128 * j + 2 * lane + 1]; }
        for (int it = 0; it < 4; ++it) { const int mb = team_pm * 256 + team_k * 64 + wave * 8 + it * 2;
            v4u fv[2][4], hv[2][4]; float sf[2], rhi[2];
#pragma unroll
            for (int q = 0; q < 2; ++q) { const v4u* fr = (const v4u*)(MIX + (size_t)(mb + q) * DM); const v4u* hr = (const v4u*)(R1 + (size_t)(mb + q) * DM); rhi[q] = ((const float*)(ws + WS_RH))[mb + q];
#pragma unroll
                for (int j = 0; j < 4; ++j) { fv[q][j] = fr[64 * j + lane]; hv[q][j] = hr[64 * j + lane]; } }
#pragma unroll
            for (int q = 0; q < 2; ++q) { float t = 0.f;
#pragma unroll
                for (int j = 0; j < 4; ++j)
#pragma unroll
                    for (int e = 0; e < 4; ++e) { const float f0 = bf_lo(fv[q][j][e]), f1 = bf_hi(fv[q][j][e]); t += f0 * f0 + f1 * f1; }
                sf[q] = t; }
#pragma unroll
            for (int q = 0; q < 2; ++q) {
                const float rf = 1.0f / sqrtf(wave_sum(sf[q]) * (1.0f / DM) + RMS_EPS), rx = rhi[q]; f32x4* ho = (f32x4*)(a.out + (size_t)(mb + q) * DM);
#pragma unroll
                for (int j = 0; j < 4; ++j) {
                    const f32x4 g0 = gq[2 * j], g1 = gq[2 * j + 1]; const v4u fj = fv[q][j], hj = hv[q][j]; f32x4 h0, h1;
                    h0.x = bf_lo(hj.x) * rx + bf_lo(fj.x) * rf * g0.x; h0.y = bf_hi(hj.x) * rx + bf_hi(fj.x) * rf * g0.y; h0.z = bf_lo(hj.y) * rx + bf_lo(fj.y) * rf * g0.z; h0.w = bf_hi(hj.y) * rx + bf_hi(fj.y) * rf * g0.w;
                    h1.x = bf_lo(hj.z) * rx + bf_lo(fj.z) * rf * g1.x; h1.y = bf_hi(hj.z) * rx + bf_hi(fj.z) * rf * g1.y; h1.z = bf_lo(hj.w) * rx + bf_lo(fj.w) * rf * g1.z; h1.w = bf_hi(hj.w) * rx + bf_hi(fj.w) * rf * g1.w;
                    ho[128 * j + 2 * lane] = h0; ho[128 * j + 2 * lane + 1] = h1;
                }
            }
        }
    }
}

extern "C" void kernel_launch(void* const* d_in, const int* in_sizes, int n_in, void* d_out, int out_size, void* d_ws, size_t ws_size, hipStream_t stream) {
    static int grid = 0;
    if (grid == 0) {
        if (n_in != 24 || in_sizes[0] != M * DM || out_size != M * DM || ws_size < WS_END) { fprintf(stderr, "kernel_launch: unexpected shapes (n_in %d, in0 %d, out %d, ws %zu)\n", n_in, n_in > 0 ? in_sizes[0] : -1, out_size, ws_size); grid = -1; return; }
        int dev = 0, cus = 0;
        if (hipGetDevice(&dev) != hipSuccess || hipDeviceGetAttribute(&cus, hipDeviceAttributeMultiprocessorCount, dev) != hipSuccess) { grid = -1; return; }
        if (hipFuncSetAttribute((const void*)hymba_fwd, hipFuncAttributeMaxDynamicSharedMemorySize, LDS_BYTES) != hipSuccess) { fprintf(stderr, "kernel_launch: hipFuncSetAttribute failed\n"); grid = -1; return; }
        int per_cu = 0;
        (void)hipOccupancyMaxActiveBlocksPerMultiprocessor(&per_cu, (const void*)hymba_fwd, NWAVES * 64, LDS_BYTES);
        (void)hipGetLastError();
        grid = cus;
        if (grid != 256) { fprintf(stderr, "kernel_launch: built for a 256-CU device (team structure, SSM unit map); found %d CUs\n", cus); grid = -1; return; }
    }
    if (grid < 0) return;
    (void)hipMemsetAsync((char*)d_ws + WS_CTL, 0, CTL_ZERO_BYTES, stream);
    Args a{};
    a.x = (const float*)d_in[0]; a.pos = (const int*)d_in[1]; a.g_pre_mix = (const float*)d_in[2]; a.w_in = (const float*)d_in[3]; a.sinks = (const float*)d_in[4];
    a.a_re = (const float*)d_in[5]; a.a_im = (const float*)d_in[6]; a.log_dt = (const float*)d_in[7]; a.b_re = (const float*)d_in[8]; a.b_im = (const float*)d_in[9];
    a.c_re = (const float*)d_in[10]; a.c_im = (const float*)d_in[11]; a.d_skip = (const float*)d_in[12]; a.w_glu = (const float*)d_in[13]; a.b_glu = (const float*)d_in[14];
    a.g_attn_out = (const float*)d_in[15]; a.g_ssm_out = (const float*)d_in[16]; a.w_o = (const float*)d_in[17]; a.g_post_mix = (const float*)d_in[18]; a.g_pre_ffn = (const float*)d_in[19];
    a.w_gate = (const float*)d_in[20]; a.w_up = (const float*)d_in[21]; a.w_down = (const float*)d_in[22]; a.g_post_ffn = (const float*)d_in[23];
    a.out = (float*)d_out; a.ws = (unsigned char*)d_ws;
    hipLaunchKernelGGL(hymba_fwd, dim3(grid), dim3(NWAVES * 64), LDS_BYTES, stream, a);
}
```

```cpp
#include <hip/hip_runtime.h>
#include <cstdio>
#include <cstdint>

namespace pg8 {
#define PG8_LAS __attribute__((address_space(3)))
typedef unsigned short bf16_t;
typedef short bf16x8 __attribute__((ext_vector_type(8)));
typedef float f32x4 __attribute__((ext_vector_type(4)));
typedef unsigned u32x4 __attribute__((ext_vector_type(4)));
constexpr int BM = 256, BK = 64, HALF = 128, HTB = HALF * BK * 2, STAGE_BYTES = 8 * HTB, NXCD = 8, WGM = 8;

__host__ __device__ __forceinline__ int lds_byte(int r, int c) { const int st = (r >> 4) * 2 + (c >> 5), rr = r & 15, cc = c & 31, ob = rr * 64 + cc * 2; return st * 1024 + (ob ^ (((ob >> 9) & 1) << 5)); }
__host__ __device__ __forceinline__ void stage_rc(int b, int& R, int& C) { const int st = b / 1024, sb = b % 1024, swz = sb ^ (((sb >> 9) & 1) << 5); R = (st >> 1) * 16 + swz / 64; C = (st & 1) * 32 + (swz % 64) / 2; }
__host__ __device__ __forceinline__ int perm32(int rho) { const int n = rho >> 4, i = rho & 15; return 8 * (i >> 2) + 4 * n + (i & 3); }

struct Unit { int pm, pn; };
struct Gemm { const bf16_t* A; const bf16_t* Bt; int lda, ldb, K; };

struct StaticOrder {
    int nM, nN, nwg, G, c;
    __host__ __device__ void init(int M, int N, int G_, int c_) { nM = M / BM; nN = N / BM; nwg = nM * nN; G = G_; c = c_; }
    __host__ __device__ bool next(int i, Unit& u) const {
        const long L = (long)i * G + c; if (L >= nwg) return false;
        int wgid = (int)L; { const int q = nwg / NXCD, r = nwg % NXCD, xcd = wgid % NXCD, off = wgid / NXCD; wgid = (xcd < r ? xcd * (q + 1) : r * (q + 1) + (xcd - r) * q) + off; }
        const int nig = WGM * nN, gid = wgid / nig, fm = gid * WGM, gsz = (nM - fm) < WGM ? (nM - fm) : WGM;
        u.pm = fm + ((wgid % nig) % gsz); u.pn = (wgid % nig) / gsz; return true;
    }
};
struct DiagOrder {
    int G, c, n;
    __host__ __device__ bool next(int i, Unit& u) const { const int L = i * G + c; if (L >= n) return false; u.pm = L; u.pn = L >> 2; return true; }
};

__device__ __forceinline__ unsigned cvt_pk_bf16(float lo, float hi) { unsigned r; asm volatile("v_cvt_pk_bf16_f32 %0, %1, %2" : "=v"(r) : "v"(lo), "v"(hi)); return r; }
__device__ __forceinline__ float bf_lo(unsigned w) { return __uint_as_float(w << 16); }
__device__ __forceinline__ float bf_hi(unsigned w) { return __uint_as_float(w & 0xffff0000u); }
__device__ __forceinline__ float sigmoidf_(float x) { return __builtin_amdgcn_rcpf(1.0f + __builtin_amdgcn_exp2f(-1.4426950408889634f * x)); }
__device__ __forceinline__ float gelu_tanh(float x) { const float u = 1.5957691216057308f * (x + 0.044715f * x * x * x); return x * sigmoidf_(u); }

constexpr float ATT_C2 = 0.125f * 1.4426950408889634f;

struct EpiBf16P {
    static constexpr bool PERM = true, MIDK = false;
    bf16_t* O; int ldc;
    __device__ __forceinline__ void operator()(const f32x4 (&acc)[2][2][4][2], const Unit& u, int wr, int wc, int fr, int fq) const {
        const int row0 = u.pm * BM + wr * 64 + fr, col0 = u.pn * BM + wc * 32 + 8 * fq;
#pragma unroll
        for (int ai = 0; ai < 2; ++ai)
#pragma unroll
            for (int m = 0; m < 4; ++m) { bf16_t* rowp = O + (size_t)(row0 + ai * HALF + m * 16) * ldc + col0;
#pragma unroll
                for (int bj = 0; bj < 2; ++bj) { const f32x4 v0 = acc[ai][bj][m][0], v1 = acc[ai][bj][m][1];
                    u32x4 w; w.x = cvt_pk_bf16(v0[0], v0[1]); w.y = cvt_pk_bf16(v0[2], v0[3]); w.z = cvt_pk_bf16(v1[0], v1[1]); w.w = cvt_pk_bf16(v1[2], v1[3]);
                    *(u32x4*)(rowp + bj * HALF) = w; } }
    }
};
struct EpiMix {
    static constexpr bool PERM = true, MIDK = true;
    bf16_t* O; int ldc; const PG8_LAS float* ratio; const PG8_LAS float* rsl;
    __device__ __forceinline__ void midk(f32x4 (&acc)[2][2][4][2], const Unit& u, int wr, int fr) const {
#pragma unroll
        for (int ai = 0; ai < 2; ++ai)
#pragma unroll
            for (int m = 0; m < 4; ++m) { const float rt = ratio[wr * 64 + fr + ai * HALF + m * 16];
#pragma unroll
                for (int bj = 0; bj < 2; ++bj)
#pragma unroll
                    for (int n = 0; n < 2; ++n) acc[ai][bj][m][n] *= rt; }
    }
    __device__ __forceinline__ void operator()(const f32x4 (&acc)[2][2][4][2], const Unit& u, int wr, int wc, int fr, int fq) const {
        const int row0 = u.pm * BM + wr * 64 + fr, col0 = u.pn * BM + wc * 32 + 8 * fq;
#pragma unroll
        for (int ai = 0; ai < 2; ++ai)
#pragma unroll
            for (int m = 0; m < 4; ++m) { const int row = row0 + ai * HALF + m * 16; bf16_t* rowp = O + (size_t)row * ldc + col0;
                const float rs = rsl[wr * 64 + fr + ai * HALF + m * 16];
#pragma unroll
                for (int bj = 0; bj < 2; ++bj) { const f32x4 v0 = acc[ai][bj][m][0] * rs, v1 = acc[ai][bj][m][1] * rs;
                    u32x4 w; w.x = cvt_pk_bf16(v0[0], v0[1]); w.y = cvt_pk_bf16(v0[2], v0[3]); w.z = cvt_pk_bf16(v1[0], v1[1]); w.w = cvt_pk_bf16(v1[2], v1[3]);
                    *(u32x4*)(rowp + bj * HALF) = w; } }
    }
};
struct EpiQKU {
    static constexpr bool PERM = true, MIDK = false;
    bf16_t* Q; bf16_t* Kp; bf16_t* A2; const PG8_LAS int* posl;
    __device__ __forceinline__ void operator()(const f32x4 (&acc)[2][2][4][2], const Unit& u, int wr, int wc, int fr, int fq) const {
        const int row0 = u.pm * BM + wr * 64 + fr, cw = wc * 32 + 8 * fq;
        if (u.pn < 5) {
            const bool isq = u.pn < 4; const float sc = isq ? ATT_C2 : 1.0f;
            const int i0 = (cw & 63) >> 1;
            float invf[4];
#pragma unroll
            for (int t = 0; t < 4; ++t) invf[t] = __builtin_amdgcn_exp2f(-(float)(i0 + t) * (13.287712379549449f / 32.0f));
            bf16_t* base = isq ? (Q + u.pn * 256) : Kp; const int ld = isq ? 1024 : 256;
#pragma unroll
            for (int ai = 0; ai < 2; ++ai)
#pragma unroll
                for (int m = 0; m < 4; ++m) { const int row = row0 + ai * HALF + m * 16; const float p = (float)posl[wr * 64 + fr + ai * HALF + m * 16];
                    float cs[4], sn[4];
#pragma unroll
                    for (int t = 0; t < 4; ++t) { const float ang = p * invf[t]; const float fr_ = __builtin_amdgcn_fractf(ang * 0.15915494309189535f); sn[t] = __builtin_amdgcn_sinf(fr_) * sc; cs[t] = __builtin_amdgcn_cosf(fr_) * sc; }
#pragma unroll
                    for (int bj = 0; bj < 2; ++bj) { const f32x4 v0 = acc[ai][bj][m][0], v1 = acc[ai][bj][m][1];
                        u32x4 w;
                        w.x = cvt_pk_bf16(v0[0] * cs[0] - v0[1] * sn[0], v0[1] * cs[0] + v0[0] * sn[0]);
                        w.y = cvt_pk_bf16(v0[2] * cs[1] - v0[3] * sn[1], v0[3] * cs[1] + v0[2] * sn[1]);
                        w.z = cvt_pk_bf16(v1[0] * cs[2] - v1[1] * sn[2], v1[1] * cs[2] + v1[0] * sn[2]);
                        w.w = cvt_pk_bf16(v1[2] * cs[3] - v1[3] * sn[3], v1[3] * cs[3] + v1[2] * sn[3]);
                        *(u32x4*)(base + (size_t)row * ld + bj * HALF + cw) = w; } }
        } else {
#pragma unroll
            for (int ai = 0; ai < 2; ++ai)
#pragma unroll
                for (int m = 0; m < 4; ++m) { const int row = row0 + ai * HALF + m * 16;
#pragma unroll
                    for (int bj = 0; bj < 2; ++bj) { const f32x4 v0 = acc[ai][bj][m][0], v1 = acc[ai][bj][m][1];
                        const int gcol = (u.pn - 5) * 256 + bj * HALF + cw, g = gcol >> 4, q0 = gcol & 15;
                        u32x4 w; w.x = cvt_pk_bf16(v0[0], v0[1]); w.y = cvt_pk_bf16(v0[2], v0[3]); w.z = cvt_pk_bf16(v1[0], v1[1]); w.w = cvt_pk_bf16(v1[2], v1[3]);
                        *(u32x4*)(A2 + (size_t)g * (1024 * 384) + (size_t)(row >> 4) * 384 + (row & 15) * 16 + q0) = w; } }
        }
    }
};
struct EpiZ {
    static constexpr bool PERM = false, MIDK = false;
    float* Z;
    __device__ __forceinline__ void operator()(const f32x4 (&acc)[2][2][4][2], const Unit& u, int wr, int wc, int fr, int fq) const {
        const int row0 = u.pm * BM + wr * 64 + fr, col0 = wc * 32 + 4 * fq;
#pragma unroll
        for (int ai = 0; ai < 2; ++ai)
#pragma unroll
            for (int m = 0; m < 4; ++m) { float* rowp = Z + (size_t)(row0 + ai * HALF + m * 16) * 128 + col0;
#pragma unroll
                for (int n = 0; n < 2; ++n) *(f32x4*)(rowp + n * 16) = acc[ai][0][m][n]; }
    }
};
struct EpiY {
    static constexpr bool PERM = true, MIDK = false;
    bf16_t* Zb;
    __device__ __forceinline__ void operator()(const f32x4 (&acc)[2][2][4][2], const Unit& u, int wr, int wc, int fr, int fq) const {
        const int row0 = u.pm * BM + wr * 64 + fr, g = u.pn;
#pragma unroll
        for (int ai = 0; ai < 2; ++ai)
#pragma unroll
            for (int m = 0; m < 4; ++m) { const int bc = (row0 + ai * HALF + m * 16) & 1023;
#pragma unroll
                for (int bj = 0; bj < 2; ++bj) { const f32x4 v0 = acc[ai][bj][m][0], v1 = acc[ai][bj][m][1];
                    const int j = 8 * bj + 2 * wc + (fq >> 1), p0 = 8 * (fq & 1);
                    u32x4 w; w.x = cvt_pk_bf16(gelu_tanh(v0[0]), gelu_tanh(v0[1])); w.y = cvt_pk_bf16(gelu_tanh(v0[2]), gelu_tanh(v0[3]));
                    w.z = cvt_pk_bf16(gelu_tanh(v1[0]), gelu_tanh(v1[1])); w.w = cvt_pk_bf16(gelu_tanh(v1[2]), gelu_tanh(v1[3]));
                    *(u32x4*)(Zb + (size_t)(bc * 16 + j) * 1024 + g * 16 + p0) = w; asm volatile("" ::: "memory"); } }
    }
};
struct EpiGlu {
    static constexpr bool PERM = true, MIDK = false;
    const bf16_t* Zb; const float* bias; bf16_t* O; int ldo; float* st;
    __device__ __forceinline__ void operator()(const f32x4 (&acc)[2][2][4][2], const Unit& u, int wr, int wc, int fr, int fq) const {
        const int row0 = u.pm * BM + wr * 64 + fr, col0 = u.pn * BM + wc * 32 + 8 * fq;
        float part[2][4];
#pragma unroll
        for (int ai = 0; ai < 2; ++ai)
#pragma unroll
            for (int m = 0; m < 4; ++m) part[ai][m] = 0.f;
#pragma unroll
        for (int bj = 0; bj < 2; ++bj) { const f32x4 b0 = *(const f32x4*)(bias + col0 + bj * HALF), b1 = *(const f32x4*)(bias + col0 + bj * HALF + 4);
#pragma unroll
            for (int ai = 0; ai < 2; ++ai)
#pragma unroll
                for (int m = 0; m < 4; ++m) { const int row = row0 + ai * HALF + m * 16;
                    const u32x4 zi = *(const u32x4*)(Zb + (size_t)row * 1024 + col0 + bj * HALF); const f32x4 v0 = acc[ai][bj][m][0] + b0, v1 = acc[ai][bj][m][1] + b1;
                    float e[8];
                    e[0] = bf_lo(zi.x) * sigmoidf_(v0[0]); e[1] = bf_hi(zi.x) * sigmoidf_(v0[1]); e[2] = bf_lo(zi.y) * sigmoidf_(v0[2]); e[3] = bf_hi(zi.y) * sigmoidf_(v0[3]);
                    e[4] = bf_lo(zi.z) * sigmoidf_(v1[0]); e[5] = bf_hi(zi.z) * sigmoidf_(v1[1]); e[6] = bf_lo(zi.w) * sigmoidf_(v1[2]); e[7] = bf_hi(zi.w) * sigmoidf_(v1[3]);
                    part[ai][m] += (e[0] * e[0] + e[1] * e[1]) + (e[2] * e[2] + e[3] * e[3]) + (e[4] * e[4] + e[5] * e[5]) + (e[6] * e[6] + e[7] * e[7]);
                    u32x4 w; w.x = cvt_pk_bf16(e[0], e[1]); w.y = cvt_pk_bf16(e[2], e[3]); w.z = cvt_pk_bf16(e[4], e[5]); w.w = cvt_pk_bf16(e[6], e[7]);
                    *(u32x4*)(O + (size_t)row * ldo + col0 + bj * HALF) = w; } }
#pragma unroll
        for (int ai = 0; ai < 2; ++ai)
#pragma unroll
            for (int m = 0; m < 4; ++m) { float p = part[ai][m]; p += __shfl_xor(p, 16); p += __shfl_xor(p, 32);
                if (fq == 0) (void)__hip_atomic_fetch_add(st + row0 + ai * HALF + m * 16, p, __ATOMIC_RELAXED, __HIP_MEMORY_SCOPE_AGENT); }
    }
};
struct EpiSwiGLU {
    static constexpr bool PERM = true, MIDK = false;
    bf16_t* O; int ldc; const float* rs;
    __device__ __forceinline__ void operator()(const f32x4 (&acc)[2][2][4][2], const Unit& u, int wr, int wc, int fr, int fq) const {
        const int row0 = u.pm * BM + wr * 64 + fr, col0 = u.pn * HALF + wc * 32 + 8 * fq;
#pragma unroll
        for (int ai = 0; ai < 2; ++ai)
#pragma unroll
            for (int m = 0; m < 4; ++m) {
                const f32x4 g0 = acc[ai][0][m][0], g1 = acc[ai][0][m][1], u0 = acc[ai][1][m][0], u1 = acc[ai][1][m][1];
                u32x4 w;
                w.x = cvt_pk_bf16(g0[0] * sigmoidf_(g0[0]) * u0[0], g0[1] * sigmoidf_(g0[1]) * u0[1]); w.y = cvt_pk_bf16(g0[2] * sigmoidf_(g0[2]) * u0[2], g0[3] * sigmoidf_(g0[3]) * u0[3]);
                w.z = cvt_pk_bf16(g1[0] * sigmoidf_(g1[0]) * u1[0], g1[1] * sigmoidf_(g1[1]) * u1[1]); w.w = cvt_pk_bf16(g1[2] * sigmoidf_(g1[2]) * u1[2], g1[3] * sigmoidf_(g1[3]) * u1[3]);
                *(u32x4*)(O + (size_t)(row0 + ai * HALF + m * 16) * ldc + col0) = w; }
    }
};

template <class Epi, class Sched, bool ALIGN_EPI>
__device__ __forceinline__ void gemm_phase(PG8_LAS unsigned char* lds, const Gemm g, const Sched& S, const Epi& E) {
    int tid_ = threadIdx.x; asm volatile("" : "+v"(tid_));
    const int tid = tid_, wid = __builtin_amdgcn_readfirstlane(tid >> 6), lane = tid & 63, wr = wid >> 2, wc = wid & 3, fr = lane & 15, fq = lane >> 4;
    const int nt = g.K / BK;
    unsigned voffA[2], voffB[2];
#pragma unroll
    for (int i = 0; i < 2; ++i) { int R, C; stage_rc(tid * 16 + i * 8192, R, C); const int Rb = Epi::PERM ? ((R & ~31) + perm32(R & 31)) : R;
        voffA[i] = (unsigned)(R * g.lda + C) * 2u; voffB[i] = (unsigned)(Rb * g.ldb + C) * 2u; }
    const size_t kstep = (size_t)(BK * 2);
    const size_t hstepA = (size_t)HALF * g.lda * 2, hstepB = (size_t)HALF * g.ldb * 2;
    const size_t tstepA = 2 * hstepA, tstepB = 2 * hstepB;
    const unsigned ldsw = (unsigned)wid * 1024u;
    const size_t tailoff = (size_t)(nt - 2) * (size_t)(BK * 2);
    const int aoff = lds_byte(wr * 64 + fr, fq * 8), boff = lds_byte(wc * 32 + fr, fq * 8);
#define PG8_SA(b, h) (((b) * 2 + (h)) * HTB)
#define PG8_SB(b, h) ((4 + (b) * 2 + (h)) * HTB)
#define PG8_STAGE(bufoff, gbase, voff) do { _Pragma("unroll") for (int _i = 0; _i < 2; ++_i) \
        __builtin_amdgcn_global_load_lds((const unsigned*)((const char*)(gbase) + (voff)[_i]), (PG8_LAS unsigned*)(lds + (bufoff) + ldsw + _i * 8192), 16, 0, 0); } while (0)
#define PG8_LDA(dst, b, h) do { _Pragma("unroll") for (int m = 0; m < 4; ++m) _Pragma("unroll") for (int k = 0; k < 2; ++k) dst[m][k] = *(const PG8_LAS bf16x8*)(lds + PG8_SA(b, h) + aoff + m * 2048 + k * 1024); } while (0)
#define PG8_LDB(dst, b, h) do { _Pragma("unroll") for (int n = 0; n < 2; ++n) _Pragma("unroll") for (int k = 0; k < 2; ++k) dst[n][k] = *(const PG8_LAS bf16x8*)(lds + PG8_SB(b, h) + boff + n * 2048 + k * 1024); } while (0)
#define PG8_MMA(ai, bj, At, Bt) do { __builtin_amdgcn_s_setprio(1); _Pragma("unroll") for (int m = 0; m < 4; ++m) _Pragma("unroll") for (int n = 0; n < 2; ++n) _Pragma("unroll") for (int k = 0; k < 2; ++k) \
        acc[ai][bj][m][n] = __builtin_amdgcn_mfma_f32_16x16x32_bf16(Bt[n][k], At[m][k], acc[ai][bj][m][n], 0, 0, 0); __builtin_amdgcn_s_setprio(0); } while (0)
#define PG8_WAIT_V(n) asm volatile("s_waitcnt vmcnt(" #n ")" ::: "memory")
#define PG8_WAIT_L(n) asm volatile("s_waitcnt lgkmcnt(" #n ")" ::: "memory")
#define PG8_BAR __builtin_amdgcn_s_barrier()
#define PG8_SCHED __builtin_amdgcn_sched_barrier(0)
    Unit cur, nxt; int ui = 0;
    if (!S.next(0, cur)) return;
    f32x4 acc[2][2][4][2];
#pragma unroll
    for (int a = 0; a < 2; ++a)
#pragma unroll
        for (int b = 0; b < 2; ++b)
#pragma unroll
            for (int m = 0; m < 4; ++m)
#pragma unroll
                for (int n = 0; n < 2; ++n) acc[a][b][m][n] = (f32x4){0.f, 0.f, 0.f, 0.f};
    bf16x8 At[4][2], B0[2][2], B1[2][2];
    const char* cA = (const char*)g.A + (size_t)cur.pm * tstepA; const char* cB = (const char*)g.Bt + (size_t)cur.pn * tstepB;
    PG8_STAGE(PG8_SB(0, 0), cB, voffB); PG8_STAGE(PG8_SB(0, 1), cB + hstepB, voffB); PG8_STAGE(PG8_SA(0, 0), cA, voffA); PG8_STAGE(PG8_SA(0, 1), cA + hstepA, voffA);
    if (wr == 1) PG8_BAR;
    PG8_WAIT_V(2); PG8_BAR;
    PG8_STAGE(PG8_SB(1, 0), cB + kstep, voffB); PG8_STAGE(PG8_SA(1, 0), cA + kstep, voffA); PG8_STAGE(PG8_SB(1, 1), cB + hstepB + kstep, voffB);
    PG8_WAIT_V(6); PG8_BAR;
    for (;;) {
        const bool has_next = S.next(ui + 1, nxt);
        const size_t tail_ = has_next ? 0 : tailoff; const char* nA = (has_next ? (const char*)g.A + (size_t)nxt.pm * tstepA : cA) + tail_; const char* nB = (has_next ? (const char*)g.Bt + (size_t)nxt.pn * tstepB : cB) + tail_;
        for (int t = 0; t < nt; t += 2) {
            if constexpr (Epi::MIDK) { if (t == (nt >> 1)) E.midk(acc, cur, wr, fr); }
            const bool last = (t == nt - 2);
            const char* a1 = cA + (size_t)(t + 1) * kstep;
            const char* a2 = last ? nA : cA + (size_t)(t + 2) * kstep; const char* b2 = last ? nB : cB + (size_t)(t + 2) * kstep;
            const char* a3 = a2 + kstep; const char* b3 = b2 + kstep;
            PG8_LDB(B0, 0, 0); PG8_LDB(B1, 0, 1); PG8_SCHED; PG8_LDA(At, 0, 0); PG8_STAGE(PG8_SA(1, 1), a1 + hstepA, voffA);
            PG8_WAIT_V(8); PG8_WAIT_L(0); PG8_BAR; PG8_MMA(0, 0, At, B0); PG8_MMA(0, 1, At, B1); PG8_BAR; PG8_SCHED;
            PG8_LDA(At, 0, 1); PG8_STAGE(PG8_SB(0, 0), b2, voffB); PG8_STAGE(PG8_SB(0, 1), b2 + hstepB, voffB); PG8_STAGE(PG8_SA(0, 0), a2, voffA);
            PG8_WAIT_V(8); PG8_WAIT_L(0); PG8_BAR; PG8_MMA(1, 0, At, B0); PG8_MMA(1, 1, At, B1); PG8_BAR; PG8_SCHED;
            PG8_LDB(B0, 1, 0); PG8_LDB(B1, 1, 1); PG8_SCHED; PG8_LDA(At, 1, 0); PG8_STAGE(PG8_SA(0, 1), a2 + hstepA, voffA);
            PG8_WAIT_V(8); PG8_WAIT_L(0); PG8_BAR; PG8_MMA(0, 0, At, B0); PG8_MMA(0, 1, At, B1); PG8_BAR; PG8_SCHED;
            PG8_LDA(At, 1, 1); PG8_STAGE(PG8_SB(1, 0), b3, voffB); PG8_STAGE(PG8_SB(1, 1), b3 + hstepB, voffB); PG8_STAGE(PG8_SA(1, 0), a3, voffA);
            PG8_WAIT_V(8); PG8_WAIT_L(0); PG8_BAR; PG8_MMA(1, 0, At, B0); PG8_MMA(1, 1, At, B1); PG8_BAR; PG8_SCHED;
        }
        if constexpr (ALIGN_EPI) { if (wr == 0) PG8_BAR; }
        E(acc, cur, wr, wc, fr, fq);
        if (!has_next) break;
#pragma unroll
        for (int a = 0; a < 2; ++a)
#pragma unroll
            for (int b = 0; b < 2; ++b)
#pragma unroll
                for (int m = 0; m < 4; ++m)
#pragma unroll
                    for (int n = 0; n < 2; ++n) acc[a][b][m][n] = (f32x4){0.f, 0.f, 0.f, 0.f};
        cur = nxt; cA = nA; cB = nB; ++ui;
        if constexpr (ALIGN_EPI) { if (wr == 1) PG8_BAR; }
    }
    PG8_WAIT_V(0);
    if constexpr (!ALIGN_EPI) { if (wr == 0) PG8_BAR; }
    PG8_BAR;
#undef PG8_SA
#undef PG8_SB
#undef PG8_STAGE
#undef PG8_LDA
#undef PG8_LDB
#undef PG8_MMA
#undef PG8_WAIT_V
#undef PG8_WAIT_L
#undef PG8_BAR
#undef PG8_SCHED
}
}

constexpr int NWAVES = 8;
constexpr int BATCH = 8, SEQ = 2048, DM = 2048, M = BATCH * SEQ;
constexpr int D_ATTN = 1024, D_KV = 256, D_SSM = 1024, D_IN = 2560, D_FF = 5632, NQH = 16, NKVH = 4, HD = 64;
constexpr int NG = 64, NST = 64, PCH = 16, CH = 16, NCH = SEQ / CH;
constexpr int A2LD = 384;
constexpr float RMS_EPS = 1e-6f;

constexpr size_t MiB = 1u << 20;
constexpr size_t WS_CTL = 0, CTL_ZERO_BYTES = 1 * MiB;
constexpr size_t WS_WIN = 2 * MiB, WS_WGLU = 12 * MiB, WS_WO = 14 * MiB, WS_WGU = 22 * MiB, WS_WD = 66 * MiB;
constexpr size_t WS_TC = 88 * MiB, WS_BZ = 100 * MiB, WS_LAM = 108 * MiB, WS_RH = 109 * MiB, WS_RX = 110 * MiB;
constexpr size_t WS_R1 = 112 * MiB;
constexpr size_t WS_R2 = 176 * MiB;
constexpr size_t WS_Q = WS_R2, WS_K = WS_R2 + 32 * MiB, WS_VT = WS_R2 + 40 * MiB;
constexpr size_t WS_A3 = 240 * MiB, WS_Z = 304 * MiB;
constexpr size_t WS_A2 = 336 * MiB;
constexpr size_t WS_ZS = 384 * MiB;
constexpr size_t WS_HID = 336 * MiB;
constexpr size_t WS_END = 512 * MiB;
constexpr int CW_BAR = 4096, CW_TEAM = 16384, CW_STAT_A = 65536, CW_STAT_S = 81920;

constexpr int RING_BYTES = 131072, LDSCTL_OFF = RING_BYTES, MISC_OFF = LDSCTL_OFF + 320, LDS_BYTES = 147456;

#define GAS __attribute__((address_space(1)))
#define LAS __attribute__((address_space(3)))
typedef unsigned short bf16;
typedef unsigned v4u __attribute__((ext_vector_type(4)));
typedef unsigned v2u __attribute__((ext_vector_type(2)));
typedef float f32x4 __attribute__((ext_vector_type(4)));
typedef float f32x16 __attribute__((ext_vector_type(16)));
typedef short bf16x8 __attribute__((ext_vector_type(8)));
#define LDS_WAIT() asm volatile("s_waitcnt lgkmcnt(0)" ::: "memory")
using pg8::cvt_pk_bf16; using pg8::bf_lo; using pg8::bf_hi;

#define XB_TMO      128
#define XB_XCNT(j)  (256  + 64 * (j))
#define XB_XSUB(j)  (1280 + 64 * (j))
#define XB_XGEN(j)  (2304 + 64 * (j))
#define XB_TOP      3328
#define XB_TOPGEN   3392
#define XCD_BAR_WORDS 3456
#define XB_SPIN_CAP (1u << 18)
__device__ __forceinline__ unsigned xb_ld(unsigned* p)              { return __hip_atomic_load(p, __ATOMIC_RELAXED, __HIP_MEMORY_SCOPE_AGENT); }
__device__ __forceinline__ unsigned xb_add(unsigned* p, unsigned v) { return __hip_atomic_fetch_add(p, v, __ATOMIC_RELAXED, __HIP_MEMORY_SCOPE_AGENT); }
__device__ __forceinline__ unsigned xb_xcc_id() { return (unsigned)__builtin_amdgcn_s_getreg((3 << 11) | 20) & 0xFu; }
#define XB_SPIN(cond, bar) do { unsigned _sp = 0; while (cond) { __builtin_amdgcn_s_sleep(1); \
    if ((++_sp & 255u) == 0u) { if (xb_ld(&(bar)[XB_TMO])) break; if (_sp > XB_SPIN_CAP) { atomicAdd(&(bar)[XB_TMO], 1u); break; } } } } while (0)
struct XcdBarrier { unsigned* bar; unsigned x; volatile LAS unsigned* st; };
__device__ __forceinline__ XcdBarrier xcd_barrier_post(unsigned* bar, volatile LAS unsigned* st) {
    XcdBarrier b; b.bar = bar; b.x = xb_xcc_id(); b.st = st;
    if (threadIdx.x == 0) (void)xb_add(&bar[XB_XCNT(b.x)], 1u);
    return b;
}
__device__ __forceinline__ void xcd_barrier_complete(unsigned* bar, unsigned x, unsigned& nloc, unsigned& nx) {
    const unsigned G = gridDim.x * gridDim.y * gridDim.z;
    unsigned sum, cnt, mine, sp = 0u;
    for (;;) {
        sum = 0u; cnt = 0u; mine = 0u;
#pragma unroll
        for (unsigned j = 0; j < 16; ++j) { const unsigned c = xb_ld(&bar[XB_XCNT(j)]); sum += c; cnt += (c > 0u) ? 1u : 0u; mine = (j == x) ? c : mine; }
        if (sum == G) break;
        __builtin_amdgcn_s_sleep(1);
        if ((++sp & 255u) == 0u) { if (xb_ld(&bar[XB_TMO])) break; if (sp > XB_SPIN_CAP) { atomicAdd(&bar[XB_TMO], 1u); break; } }
    }
    nloc = mine > 0u ? mine : 1u; nx = cnt > 0u ? cnt : 1u;
}
__device__ __forceinline__ void xcd_barrier(const XcdBarrier& b) {
    asm volatile("s_waitcnt vmcnt(0)" ::: "memory");
    __syncthreads();
    if (threadIdx.x == 0) {
        unsigned* bar = b.bar;
        __builtin_amdgcn_s_waitcnt(0);
        unsigned nloc = b.st[0], nx = b.st[1];
        if (nloc == 0u) { xcd_barrier_complete(bar, b.x, nloc, nx); b.st[0] = nloc; b.st[1] = nx; }
        const unsigned old = xb_add(&bar[XB_XSUB(b.x)], 1u);
        const unsigned gen = old / nloc;
        if (old + 1u == (gen + 1u) * nloc) {
            __builtin_amdgcn_fence(__ATOMIC_RELEASE, "agent");
            asm volatile("s_waitcnt vmcnt(0)" ::: "memory");
            const unsigned og = xb_add(&bar[XB_TOP], 1u);
            const unsigned tg = og / nx;
            if (og + 1u == (tg + 1u) * nx) xb_add(&bar[XB_TOPGEN], 1u);
            else XB_SPIN(xb_ld(&bar[XB_TOPGEN]) == tg, bar);
            __builtin_amdgcn_fence(__ATOMIC_ACQUIRE, "agent");
            xb_add(&bar[XB_XGEN(b.x)], 1u);
            asm volatile("s_waitcnt vmcnt(0)" ::: "memory");
        } else {
            XB_SPIN(xb_ld(&bar[XB_XGEN(b.x)]) == gen, bar);
            __builtin_amdgcn_fence(__ATOMIC_ACQUIRE, "agent");
            asm volatile("s_waitcnt vmcnt(0)" ::: "memory");
        }
    }
    __syncthreads();
}

__device__ __forceinline__ void team_barrier(unsigned* cnt, unsigned* tmo, unsigned& epoch, volatile LAS unsigned* same_xcd) {
    asm volatile("s_waitcnt vmcnt(0)" ::: "memory");
    __syncthreads();
    if (threadIdx.x == 0) {
        if (*same_xcd != 1u) { __builtin_amdgcn_fence(__ATOMIC_RELEASE, "agent"); }
        asm volatile("s_waitcnt vmcnt(0)" ::: "memory");
        (void)xb_add(cnt, 1u);
        const unsigned want = 4u * epoch; unsigned sp = 0u;
        while (xb_ld(cnt) < want) { __builtin_amdgcn_s_sleep(1); if ((++sp & 255u) == 0u) { if (xb_ld(tmo)) break; if (sp > XB_SPIN_CAP) { atomicAdd(tmo, 1u); break; } } }
        __builtin_amdgcn_fence(__ATOMIC_ACQUIRE, "agent");
        asm volatile("s_waitcnt vmcnt(0)" ::: "memory");
    }
    __syncthreads();
    ++epoch;
}

__device__ __forceinline__ float wave_sum(float v) {
#pragma unroll
    for (int o = 1; o < 64; o <<= 1) v += __shfl_xor(v, o);
    return v;
}
__device__ __forceinline__ void sincos_rev(double rev, float& s, float& c) {
    const double fr = rev - __builtin_rint(rev); const float f = (float)fr;
    s = __builtin_amdgcn_sinf(f); c = __builtin_amdgcn_cosf(f);
}
enum { MAP_PLAIN = 0, MAP_WIN = 1, MAP_GATE = 2, MAP_UP = 3 };
template <int MODE> __device__ __forceinline__ int map_row(int n) {
    if (MODE == MAP_WIN) {
        if (n < 1280) { const int d = n & 63; return (n & ~63) + (d < 32 ? 2 * d : 2 * (d - 32) + 1); }
        if (n < 1536) return 2304 + (n - 1280);
        return 1280 + (n - 1536);
    }
    if (MODE == MAP_GATE) return ((n >> 7) << 8) + (n & 127);
    if (MODE == MAP_UP) return ((n >> 7) << 8) + 128 + (n & 127);
    return n;
}
template <int MODE> __device__ __forceinline__ void transpose_item(const float* W, int K, int N, bf16* WT, const float* gs, LAS float* scr, int item, int lane) {
    const int nblk = N / 32, kb = item / nblk, nb = item % nblk, k0 = 64 * kb, n0 = 32 * nb;
    const float* src = W + (size_t)(k0 + (lane >> 5)) * N + n0 + (lane & 31);
    float v[32];
#pragma unroll
    for (int i = 0; i < 32; ++i) v[i] = src[(size_t)(2 * i) * N];
    const int c = lane & 7;
    f32x4 g0 = (f32x4){1.f, 1.f, 1.f, 1.f}, g1 = g0;
    if (gs) { g0 = *(const f32x4*)(gs + k0 + 8 * c); g1 = *(const f32x4*)(gs + k0 + 8 * c + 4); }
    LAS float* sw = scr + (lane >> 5) * 33 + (lane & 31);
#pragma unroll
    for (int i = 0; i < 32; ++i) sw[(2 * i) * 33] = v[i];
    LDS_WAIT(); asm volatile("" ::: "memory");
#pragma unroll
    for (int j = 0; j < 4; ++j) { const int n = (lane >> 3) + 8 * j; const LAS float* s = scr + (8 * c) * 33 + n;
        v4u o; o.x = cvt_pk_bf16(s[0 * 33] * g0.x, s[1 * 33] * g0.y); o.y = cvt_pk_bf16(s[2 * 33] * g0.z, s[3 * 33] * g0.w); o.z = cvt_pk_bf16(s[4 * 33] * g1.x, s[5 * 33] * g1.y); o.w = cvt_pk_bf16(s[6 * 33] * g1.z, s[7 * 33] * g1.w);
        *(v4u*)(WT + (size_t)map_row<MODE>(n0 + n) * K + k0 + 8 * c) = o; }
    LDS_WAIT(); asm volatile("" ::: "memory");
}

struct TrDesc { const float* W; bf16* WT; const float* gs; int K, N, mode, item; };
struct TrRegs { float v[32]; f32x4 g0, g1; };
__device__ __forceinline__ int map_row_rt(int mode, int n) {
    if (mode == MAP_WIN) return map_row<MAP_WIN>(n);
    if (mode == MAP_GATE) return map_row<MAP_GATE>(n);
    if (mode == MAP_UP) return map_row<MAP_UP>(n);
    return n;
}
__device__ __forceinline__ void tr_load(const TrDesc& d, int lane, TrRegs& t) {
    const int nblk = d.N / 32, kb = d.item / nblk, nb = d.item - kb * nblk, k0 = 64 * kb, n0 = 32 * nb;
    const float* src = d.W + (size_t)(k0 + (lane >> 5)) * d.N + n0 + (lane & 31);
#pragma unroll
    for (int i = 0; i < 32; ++i) t.v[i] = src[(size_t)(2 * i) * d.N];
    const int c = lane & 7;
    t.g0 = (f32x4){1.f, 1.f, 1.f, 1.f}; t.g1 = t.g0;
    if (d.gs) { t.g0 = *(const f32x4*)(d.gs + k0 + 8 * c); t.g1 = *(const f32x4*)(d.gs + k0 + 8 * c + 4); }
}
__device__ __forceinline__ void tr_finish(const TrDesc& d, const TrRegs& t, LAS float* scr, int lane) {
    const int nblk = d.N / 32, kb = d.item / nblk, nb = d.item - kb * nblk, k0 = 64 * kb, n0 = 32 * nb, c = lane & 7;
    LAS float* sw = scr + (lane >> 5) * 33 + (lane & 31);
#pragma unroll
    for (int i = 0; i < 32; ++i) sw[(2 * i) * 33] = t.v[i];
    LDS_WAIT(); asm volatile("" ::: "memory");
#pragma unroll
    for (int j = 0; j < 4; ++j) { const int n = (lane >> 3) + 8 * j; const LAS float* s = scr + (8 * c) * 33 + n;
        v4u o; o.x = cvt_pk_bf16(s[0 * 33] * t.g0.x, s[1 * 33] * t.g0.y); o.y = cvt_pk_bf16(s[2 * 33] * t.g0.z, s[3 * 33] * t.g0.w); o.z = cvt_pk_bf16(s[4 * 33] * t.g1.x, s[5 * 33] * t.g1.y); o.w = cvt_pk_bf16(s[6 * 33] * t.g1.z, s[7 * 33] * t.g1.w);
        *(v4u*)(d.WT + (size_t)map_row_rt(d.mode, n0 + n) * d.K + k0 + 8 * c) = o; }
    LDS_WAIT(); asm volatile("" ::: "memory");
}

struct Args {
    const float* x; const int* pos; const float* g_pre_mix; const float* w_in; const float* sinks; const float* a_re; const float* a_im; const float* log_dt;
    const float* b_re; const float* b_im; const float* c_re; const float* c_im; const float* d_skip; const float* w_glu; const float* b_glu;
    const float* g_attn_out; const float* g_ssm_out; const float* w_o; const float* g_post_mix; const float* g_pre_ffn; const float* w_gate; const float* w_up;
    const float* w_down; const float* g_post_ffn; float* out; unsigned char* ws;
};

__device__ __forceinline__ void ssm_precompute(const Args& a, int g, LAS unsigned char* lds, int tid) {
    typedef float f32x2v __attribute__((ext_vector_type(2)));
    LAS f32x2v* P = (LAS f32x2v*)lds;
    LAS f32x2v* Bb = (LAS f32x2v*)(lds + 8704);
    LAS f32x2v* Cc = (LAS f32x2v*)(lds + 8704 + 8192);
    LAS float* Kk = (LAS float*)(lds + 8704 + 16384);
    const float dt = __builtin_amdgcn_exp2f(a.log_dt[g] * 1.4426950408889634f);
    for (int e = tid; e < 17 * 64; e += 512) { const int k = e >> 6, n = e & 63; const float ar = a.a_re[g * 64 + n], ai = a.a_im[g * 64 + n];
        const float mag = __builtin_amdgcn_exp2f((float)k * ar * dt * 1.4426950408889634f); float s, c; sincos_rev((double)k * (double)ai * (double)dt * 0.15915494309189535, s, c);
        P[e] = (f32x2v){mag * c, mag * s}; }
    for (int e = tid; e < 1024; e += 512) { const int n = e >> 4; const float ar = a.a_re[g * 64 + n], ai = a.a_im[g * 64 + n];
        const float mag = __builtin_amdgcn_exp2f(ar * dt * 1.4426950408889634f); float s, c; sincos_rev((double)ai * (double)dt * 0.15915494309189535, s, c);
        const float lr = mag * c, li = mag * s, den = ar * ar + ai * ai, nr = lr - 1.0f, ni = li;
        const float fre = (nr * ar + ni * ai) / den, fim = (ni * ar - nr * ai) / den;
        const float br = a.b_re[(size_t)g * 1024 + e], bi = a.b_im[(size_t)g * 1024 + e];
        Bb[e] = (f32x2v){fre * br - fim * bi, fre * bi + fim * br};
        Cc[e] = (f32x2v){a.c_re[(size_t)g * 1024 + e], a.c_im[(size_t)g * 1024 + e]}; }
    LDS_WAIT(); __syncthreads();
    for (int e = tid; e < 4096; e += 512) { const int k = e >> 8, p = (e >> 4) & 15, q = e & 15; float s = 0.f;
        for (int n = 0; n < 64; ++n) { const f32x2v c = Cc[p * 64 + n], l = P[k * 64 + n], b = Bb[n * 16 + q];
            const float tr = c.x * l.x - c.y * l.y, ti = c.x * l.y + c.y * l.x; s += tr * b.x - ti * b.y; }
        Kk[e] = s; }
    LDS_WAIT(); __syncthreads();
    bf16* TC = (bf16*)(a.ws + WS_TC) + (size_t)g * 256 * A2LD;
    bf16* BZ = (bf16*)(a.ws + WS_BZ) + (size_t)g * 256 * 256;
    {
        const int row = tid >> 1, j = row >> 4, p = row & 15; const float dp = a.d_skip[g * 16 + p];
        for (int ci = 0; ci < 16; ++ci) { const int col0 = 128 * (tid & 1) + 8 * ci, i = col0 >> 4, q0 = col0 & 15; float v[8];
#pragma unroll
            for (int e = 0; e < 8; ++e) { float t = 0.f; if (i <= j) { t = Kk[((j - i) * 16 + p) * 16 + q0 + e]; if (i == j && q0 + e == p) t += dp; } v[e] = t; }
            v4u o; o.x = cvt_pk_bf16(v[0], v[1]); o.y = cvt_pk_bf16(v[2], v[3]); o.z = cvt_pk_bf16(v[4], v[5]); o.w = cvt_pk_bf16(v[6], v[7]);
            *(v4u*)(TC + (size_t)row * A2LD + col0) = o; }
        for (int ci = 0; ci < 8; ++ci) { const int n0 = 32 * (tid & 1) + 4 * ci; float v[8];
#pragma unroll
            for (int e = 0; e < 4; ++e) { const f32x2v c = Cc[p * 64 + n0 + e], l = P[(j + 1) * 64 + n0 + e]; v[2 * e] = c.x * l.x - c.y * l.y; v[2 * e + 1] = -(c.x * l.y + c.y * l.x); }
            v4u o; o.x = cvt_pk_bf16(v[0], v[1]); o.y = cvt_pk_bf16(v[2], v[3]); o.z = cvt_pk_bf16(v[4], v[5]); o.w = cvt_pk_bf16(v[6], v[7]);
            *(v4u*)(TC + (size_t)row * A2LD + 256 + 2 * n0) = o; }
    }
    {
        const int row = tid >> 2, n = row >> 1, ri = row & 1;
        for (int ci = 0; ci < 8; ++ci) { const int col0 = 64 * (tid & 3) + 8 * ci, i = col0 >> 4, q0 = col0 & 15; float v[8];
#pragma unroll
            for (int e = 0; e < 8; ++e) { const f32x2v l = P[(15 - i) * 64 + n], b = Bb[n * 16 + q0 + e]; v[e] = ri ? (l.x * b.y + l.y * b.x) : (l.x * b.x - l.y * b.y); }
            v4u o; o.x = cvt_pk_bf16(v[0], v[1]); o.y = cvt_pk_bf16(v[2], v[3]); o.z = cvt_pk_bf16(v[4], v[5]); o.w = cvt_pk_bf16(v[6], v[7]);
            *(v4u*)(BZ + (size_t)row * 256 + col0) = o;
            *(v4u*)(BZ + (size_t)(128 + row) * 256 + col0) = (v4u){0u, 0u, 0u, 0u}; }
    }
    if (tid < 64) { const f32x2v l = P[16 * 64 + tid]; ((float*)(a.ws + WS_LAM))[(g * 64 + tid) * 2] = l.x; ((float*)(a.ws + WS_LAM))[(g * 64 + tid) * 2 + 1] = l.y; }
    LDS_WAIT(); __syncthreads();
}

constexpr int AT_KROW = 144, AT_VROW = 392, AT_V_OFF = 192 * AT_KROW, AT_LDS_BYTES = AT_V_OFF + 64 * AT_VROW;
__device__ __forceinline__ int crow(int r, int hi) { return (r & 3) + 8 * (r >> 2) + 4 * hi; }
__device__ __forceinline__ void attn_phase(LAS unsigned char* lds, int vcu, int G, const bf16* Qp, const bf16* Kp, const bf16* Vt, const float* sinks, bf16* AO, int ldo, float* st) {
    typedef unsigned long long u64;
    int tid = threadIdx.x; asm volatile("" : "+v"(tid));
    const int lane = tid & 63, wave = __builtin_amdgcn_readfirstlane(tid >> 6), r32 = lane & 31, hi = lane >> 5, hq = wave & 3, qsub = wave >> 2;
    const float NEG = -INFINITY;
    for (int id = vcu; id < 1024; id += G) {
        const int b = id >> 7, kvh = (id >> 5) & 3, q0 = 64 * (id & 31), h = kvh * 4 + hq;
        const size_t tok0 = (size_t)b * SEQ;
        const int jt0 = (q0 >= 128) ? 0 : (128 - q0) / 32;
        v4u kv[3], vv[3];
#pragma unroll
        for (int i = 0; i < 3; ++i) { const int c = tid + 512 * i, row = c >> 3, ch = c & 7, key = q0 - 128 + row;
            if (key >= 0) kv[i] = *(const v4u*)(Kp + (tok0 + key) * D_KV + kvh * HD + ch * 8); }
#pragma unroll
        for (int i = 0; i < 3; ++i) { const int c = tid + 512 * i, d = c / 24, ch = c - d * 24, key0 = q0 - 128 + 8 * ch;
            if (key0 >= 0) vv[i] = *(const v4u*)(Vt + (size_t)(kvh * HD + d) * M + tok0 + key0); }
        const bf16* qrow = Qp + (tok0 + q0 + 32 * qsub + r32) * D_ATTN + h * HD + 32 * hi;
        bf16x8 qf[4];
#pragma unroll
        for (int kk = 0; kk < 4; ++kk) qf[kk] = *(const bf16x8*)(qrow + 8 * kk);
#pragma unroll
        for (int i = 0; i < 3; ++i) { const int c = tid + 512 * i, row = c >> 3, ch = c & 7, key = q0 - 128 + row;
            if (key >= 0) *(LAS v4u*)(lds + row * AT_KROW + ch * 16) = kv[i]; }
#pragma unroll
        for (int i = 0; i < 3; ++i) { const int c = tid + 512 * i, d = c / 24, ch = c - d * 24, key0 = q0 - 128 + 8 * ch;
            if (key0 >= 0) { LAS u64* p = (LAS u64*)(lds + AT_V_OFF + d * AT_VROW + ch * 16); p[0] = ((u64)vv[i].y << 32) | vv[i].x; p[1] = ((u64)vv[i].w << 32) | vv[i].z; } }
        LDS_WAIT(); __syncthreads();
        f32x16 s[5];
#pragma unroll
        for (int kt = 0; kt < 5; ++kt) {
            if (kt + qsub >= jt0) {
                const LAS unsigned char* kp = lds + (32 * (kt + qsub) + r32) * AT_KROW + 64 * hi;
                f32x16 acc = {0.f, 0.f, 0.f, 0.f, 0.f, 0.f, 0.f, 0.f, 0.f, 0.f, 0.f, 0.f, 0.f, 0.f, 0.f, 0.f};
#pragma unroll
                for (int kk = 0; kk < 4; ++kk) acc = __builtin_amdgcn_mfma_f32_32x32x16_bf16(*(const LAS bf16x8*)(kp + 16 * kk), qf[kk], acc, 0, 0, 0);
                s[kt] = acc;
            } else {
#pragma unroll
                for (int r = 0; r < 16; ++r) s[kt][r] = NEG;
            }
        }
#pragma unroll
        for (int r = 0; r < 16; ++r) { const int cr = crow(r, hi); if (!(cr > r32)) s[0][r] = NEG; if (!(cr <= r32)) s[4][r] = NEG; }
        const float sk = sinks[h] * 1.4426950408889634f;
        float mx = sk;
#pragma unroll
        for (int kt = 0; kt < 5; ++kt)
#pragma unroll
            for (int r = 0; r < 16; ++r) mx = fmaxf(mx, s[kt][r]);
        mx = fmaxf(mx, __shfl_xor(mx, 32));
        float l = 0.f;
#pragma unroll
        for (int kt = 0; kt < 5; ++kt)
#pragma unroll
            for (int r = 0; r < 16; ++r) { const float p = __builtin_amdgcn_exp2f(s[kt][r] - mx); s[kt][r] = p; l += p; }
        l += __shfl_xor(l, 32);
        l += __builtin_amdgcn_exp2f(sk - mx);
        const float inv = 1.0f / l;
        f32x16 o[2];
#pragma unroll
        for (int d = 0; d < 2; ++d)
#pragma unroll
            for (int r = 0; r < 16; ++r) o[d][r] = 0.f;
#pragma unroll
        for (int kt = 0; kt < 5; ++kt) {
            if (kt + qsub >= jt0) {
#pragma unroll
                for (int s2 = 0; s2 < 2; ++s2) {
                    v4u pw; pw.x = cvt_pk_bf16(s[kt][8 * s2 + 0] * inv, s[kt][8 * s2 + 1] * inv); pw.y = cvt_pk_bf16(s[kt][8 * s2 + 2] * inv, s[kt][8 * s2 + 3] * inv);
                    pw.z = cvt_pk_bf16(s[kt][8 * s2 + 4] * inv, s[kt][8 * s2 + 5] * inv); pw.w = cvt_pk_bf16(s[kt][8 * s2 + 6] * inv, s[kt][8 * s2 + 7] * inv);
                    const bf16x8 pf = __builtin_bit_cast(bf16x8, pw);
#pragma unroll
                    for (int dh = 0; dh < 2; ++dh) {
                        const LAS u64* vp = (const LAS u64*)(lds + AT_V_OFF + (dh * 32 + r32) * AT_VROW + (32 * (kt + qsub) + 16 * s2 + 4 * hi) * 2);
                        const u64 lo = vp[0], hi8 = vp[2];
                        const v4u vw = (v4u){(unsigned)lo, (unsigned)(lo >> 32), (unsigned)hi8, (unsigned)(hi8 >> 32)};
                        o[dh] = __builtin_amdgcn_mfma_f32_32x32x16_bf16(__builtin_bit_cast(bf16x8, vw), pf, o[dh], 0, 0, 0);
                    }
                }
            }
        }
        {
            float ssq = 0.f;
#pragma unroll
            for (int dh = 0; dh < 2; ++dh)
#pragma unroll
                for (int r = 0; r < 16; ++r) ssq += o[dh][r] * o[dh][r];
            ssq += __shfl_xor(ssq, 32);
            if (hi == 0) (void)__hip_atomic_fetch_add(st + tok0 + q0 + 32 * qsub + r32, ssq, __ATOMIC_RELAXED, __HIP_MEMORY_SCOPE_AGENT);
        }
        bf16* orow = AO + (tok0 + q0 + 32 * qsub + r32) * (size_t)ldo + h * HD + 4 * hi;
#pragma unroll
        for (int dh = 0; dh < 2; ++dh)
#pragma unroll
            for (int g4 = 0; g4 < 4; ++g4) { v2u w; w.x = cvt_pk_bf16(o[dh][4 * g4], o[dh][4 * g4 + 1]); w.y = cvt_pk_bf16(o[dh][4 * g4 + 2], o[dh][4 * g4 + 3]);
                *(v2u*)(orow + dh * 32 + 8 * g4) = w; }
        LDS_WAIT(); __syncthreads();
    }
}

__global__ void __launch_bounds__(NWAVES * 64, 2) hymba_fwd(Args a) {
    extern __shared__ __attribute__((aligned(16))) unsigned char lds_raw[];
    LAS unsigned char* lds = (LAS unsigned char*)lds_raw;
    volatile LAS unsigned* MISC = (volatile LAS unsigned*)(lds + MISC_OFF);
    const int tid = threadIdx.x;
    const int G = gridDim.x; const int bx = blockIdx.x; const int vcu = (G % 8 == 0) ? (bx % 8) * (G / 8) + bx / 8 : bx;
    unsigned char* ws = a.ws;
    unsigned* ctl = (unsigned*)(ws + WS_CTL);
    for (int u = tid; u < (LDS_BYTES - LDSCTL_OFF) / 4; u += NWAVES * 64) ((LAS unsigned*)(lds + LDSCTL_OFF))[u] = 0u;
    __syncthreads();
    XcdBarrier bar = xcd_barrier_post(ctl + CW_BAR, MISC + 8);
#define GRID_BAR() xcd_barrier(bar)
    const int team_pm = 8 * (bx & 7) + ((bx >> 3) & 7), team_k = bx >> 6;
    unsigned team_epoch = 1u;
#define TEAM_BAR() team_barrier(ctl + CW_TEAM + 64 * team_pm, ctl + CW_BAR + XB_TMO, team_epoch, MISC + 12)
    if (tid == 0) __hip_atomic_store(ctl + CW_TEAM + 64 * team_pm + 8 + team_k, 0x100u | bar.x, __ATOMIC_RELAXED, __HIP_MEMORY_SCOPE_AGENT);
    const int NGW = G * NWAVES;
#define PHASE_IDS() int tid_l = threadIdx.x; asm volatile("" : "+v"(tid_l)); const int lane = tid_l & 63, wave = __builtin_amdgcn_readfirstlane(tid_l >> 6), gw = vcu * NWAVES + wave; (void)lane; (void)gw
    bf16* Win_t = (bf16*)(ws + WS_WIN); bf16* Wglu_t = (bf16*)(ws + WS_WGLU); bf16* Wo_t = (bf16*)(ws + WS_WO); bf16* Wgu_t = (bf16*)(ws + WS_WGU); bf16* Wd_t = (bf16*)(ws + WS_WD);
    bf16* R1 = (bf16*)(ws + WS_R1); bf16* Qp = (bf16*)(ws + WS_Q); bf16* Kp = (bf16*)(ws + WS_K); bf16* Vt = (bf16*)(ws + WS_VT); bf16* MIX = (bf16*)(ws + WS_R2);
    bf16* A2 = (bf16*)(ws + WS_A2); float* Zst = (float*)(ws + WS_ZS); bf16* Zb = (bf16*)(ws + WS_Z); bf16* A3 = (bf16*)(ws + WS_A3); float* stat_a = (float*)(ctl + CW_STAT_A); float* stat_s = (float*)(ctl + CW_STAT_S); bf16* HID = (bf16*)(ws + WS_HID);

    {
        PHASE_IDS();
        if (bx < NG) ssm_precompute(a, bx, lds, tid_l);
        else {
            LAS float* scr = (LAS float*)(lds + wave * 16384);
            constexpr int I_IN = (DM / 64) * (D_IN / 32), I_GLU = (D_SSM / 64) * (D_SSM / 32), I_O = (DM / 64) * (DM / 32);
            constexpr int NITEMS = I_IN;
#define EARLY_DESC(D, IT) do { D = TrDesc{a.w_in, Win_t, a.g_pre_mix, DM, D_IN, MAP_WIN, (IT)}; } while (0)
            TrDesc dc, dn; TrRegs tc, tn;
            const int NCW = (G - NG) * NWAVES; int it = (bx - NG) * NWAVES + wave;
            if (it < NITEMS) { EARLY_DESC(dc, it); tr_load(dc, lane, tc); }
            while (it < NITEMS) {
                const int nx = it + NCW; const bool more = nx < NITEMS;
                if (more) { EARLY_DESC(dn, nx); tr_load(dn, lane, tn); }
                tr_finish(dc, tc, scr, lane);
                if (more) { dc = dn; tc = tn; }
                it = nx;
            }
#undef EARLY_DESC
        }
        for (int m = gw; m < M; m += 2 * NGW) {
            f32x4 v[2][8]; float s[2];
#pragma unroll
            for (int q = 0; q < 2; ++q) { const f32x4* xr = (const f32x4*)(a.x + (size_t)(m + q * NGW) * DM);
#pragma unroll
                for (int j = 0; j < 4; ++j) { v[q][2 * j] = xr[128 * j + 2 * lane]; v[q][2 * j + 1] = xr[128 * j + 2 * lane + 1]; } }
#pragma unroll
            for (int q = 0; q < 2; ++q) { float t = 0.f;
#pragma unroll
                for (int j = 0; j < 8; ++j) t += (v[q][j].x * v[q][j].x + v[q][j].y * v[q][j].y) + (v[q][j].z * v[q][j].z + v[q][j].w * v[q][j].w);
                s[q] = t; }
#pragma unroll
            for (int q = 0; q < 2; ++q) { const int mm = m + q * NGW;
                const float ms = wave_sum(s[q]) * (1.0f / DM) + RMS_EPS; const float r = 1.0f / sqrtf(ms);
                if (lane == 0) ((float*)(ws + WS_RX))[mm] = sqrtf(ms);
                v4u* o = (v4u*)(R1 + (size_t)mm * DM);
#pragma unroll
                for (int j = 0; j < 4; ++j) { v4u w; w.x = cvt_pk_bf16(v[q][2 * j].x * r, v[q][2 * j].y * r); w.y = cvt_pk_bf16(v[q][2 * j].z * r, v[q][2 * j].w * r);
                    w.z = cvt_pk_bf16(v[q][2 * j + 1].x * r, v[q][2 * j + 1].y * r); w.w = cvt_pk_bf16(v[q][2 * j + 1].z * r, v[q][2 * j + 1].w * r); o[64 * j + lane] = w; } }
        }
    }
    GRID_BAR();

    {
        PHASE_IDS();
        pg8::Gemm g{R1, Win_t, DM, DM, DM}; pg8::StaticOrder S; S.init(M, 2304, G, bx);
        LAS int* posl = (LAS int*)(lds + LDSCTL_OFF + 1024);
        if (tid_l < 256) posl[tid_l] = a.pos[team_pm * 256 + tid_l];
        LDS_WAIT(); __syncthreads();
        pg8::EpiQKU E{Qp, Kp, A2, posl};
        pg8::gemm_phase<pg8::EpiQKU, pg8::StaticOrder, true>(lds, g, S, E);
        pg8::Gemm g2{Win_t + (size_t)2304 * DM, R1, DM, DM, DM}; pg8::StaticOrder S2; S2.init(256, M, G, (bx + 192) % G);
        pg8::EpiBf16P E2{Vt, M};
        pg8::gemm_phase<pg8::EpiBf16P, pg8::StaticOrder, true>(lds, g2, S2, E2);
        {
            int tid_c = threadIdx.x; asm volatile("" : "+v"(tid_c)); const int lane = tid_c & 63, wave = __builtin_amdgcn_readfirstlane(tid_c >> 6);
            LAS float* scr = (LAS float*)(lds + wave * 16384);
            constexpr int I_G = (DM / 64) * (D_FF / 32), I_D = (D_FF / 64) * (DM / 32);
            const int cw = (bx & (G / 2 - 1)) * NWAVES + wave, NCW = (G / 2) * NWAVES;
            constexpr int I_GLU = (D_SSM / 64) * (D_SSM / 32), I_O = (DM / 64) * (DM / 32);
            constexpr int NIT = I_GLU + I_O + 2 * I_G + I_D;
#define FFN_DESC(D, IT) do { int r_ = (IT); if (r_ < I_GLU) { D = TrDesc{a.w_glu, Wglu_t, nullptr, D_SSM, D_SSM, MAP_PLAIN, r_}; } \
                else if (r_ < I_GLU + I_O) { r_ -= I_GLU; D = TrDesc{a.w_o, Wo_t, (r_ / (DM / 32) < 16) ? a.g_attn_out : (a.g_ssm_out - 1024), DM, DM, MAP_PLAIN, r_}; } \
                else if ((r_ -= I_GLU + I_O) < I_G) { D = TrDesc{a.w_gate, Wgu_t, a.g_pre_ffn, DM, D_FF, MAP_GATE, r_}; } else if (r_ < 2 * I_G) { D = TrDesc{a.w_up, Wgu_t, a.g_pre_ffn, DM, D_FF, MAP_UP, r_ - I_G}; } \
                else { D = TrDesc{a.w_down, Wd_t, nullptr, D_FF, DM, MAP_PLAIN, r_ - 2 * I_G}; } } while (0)
            TrDesc dc, dn; TrRegs tc, tn;
            const int it_hi = (bx >= G / 2) ? NIT : (I_GLU + I_O);
            int it = ((bx >= G / 2) ? (I_GLU + I_O) : 0) + cw;
            if (it < it_hi) { FFN_DESC(dc, it); tr_load(dc, lane, tc); }
            while (it < it_hi) {
                const int nx = it + NCW; const bool more = nx < it_hi;
                if (more) { FFN_DESC(dn, nx); tr_load(dn, lane, tn); }
                tr_finish(dc, tc, scr, lane);
                if (more) { dc = dn; tc = tn; }
                it = nx;
            }
#undef FFN_DESC
        }
    }
    GRID_BAR();

    {
        PHASE_IDS();
        {
            pg8::Gemm g{A2, (const bf16*)(ws + WS_BZ), A2LD, 256, 256}; pg8::DiagOrder S{G, bx, 256};
            pg8::EpiZ E{Zst};
            pg8::gemm_phase<pg8::EpiZ, pg8::DiagOrder, true>(lds, g, S, E);
        }
        asm volatile("s_waitcnt vmcnt(0)" ::: "memory"); __syncthreads();
        {
            typedef float f32x2v __attribute__((ext_vector_type(2)));
            const int seq = wave >> 2, seg = wave & 3, g = bx >> 2, b = 2 * (bx & 3) + seq;
            const float lr = ((const float*)(ws + WS_LAM))[(g * 64 + lane) * 2], li = ((const float*)(ws + WS_LAM))[(g * 64 + lane) * 2 + 1];
            const size_t row0 = (size_t)g * 1024 + b * 128 + 32 * seg;
            const f32x2v* zp = (const f32x2v*)Zst + row0 * 64 + lane;
            f32x2v zz[32];
#pragma unroll
            for (int i = 0; i < 32; ++i) zz[i] = zp[(size_t)i * 64];
            float tr = 0.f, ti = 0.f;
#pragma unroll
            for (int i = 0; i < 32; ++i) { const float nr = lr * tr - li * ti + zz[i].x, ni = lr * ti + li * tr + zz[i].y; tr = nr; ti = ni; }
            float pr = lr, pi = li;
#pragma unroll
            for (int q = 0; q < 5; ++q) { const float nr = pr * pr - pi * pi, ni = 2.f * pr * pi; pr = nr; pi = ni; }
            LAS f32x2v* X = (LAS f32x2v*)lds;
            X[wave * 64 + lane] = (f32x2v){tr, ti};
            LDS_WAIT(); __syncthreads();
            float sr = 0.f, si = 0.f;
            for (int s = 0; s < seg; ++s) { const f32x2v t = X[(seq * 4 + s) * 64 + lane]; const float nr = pr * sr - pi * si + t.x, ni = pr * si + pi * sr + t.y; sr = nr; si = ni; }
            unsigned* sp = (unsigned*)(A2 + row0 * A2LD + 256) + lane;
#pragma unroll
            for (int i = 0; i < 32; ++i) {
                sp[(size_t)i * (A2LD / 2)] = cvt_pk_bf16(sr, si);
                const float nr = lr * sr - li * si + zz[i].x, ni = lr * si + li * sr + zz[i].y; sr = nr; si = ni;
            }
        }
        asm volatile("s_waitcnt vmcnt(0)" ::: "memory"); __syncthreads();
        {
            pg8::Gemm g{A2, (const bf16*)(ws + WS_TC), A2LD, A2LD, A2LD}; pg8::DiagOrder S{G, bx, 256};
            pg8::EpiY E{Zb};
            pg8::gemm_phase<pg8::EpiY, pg8::DiagOrder, true>(lds, g, S, E);
        }
        attn_phase(lds, vcu, G, Qp, Kp, Vt, a.sinks, A3, DM, stat_a);
    }
    GRID_BAR();

    if (tid == 0) { unsigned same = 1u; const unsigned me = 0x100u | bar.x;
        for (int k = 0; k < 4; ++k) same &= (xb_ld(ctl + CW_TEAM + 64 * team_pm + 8 + k) == me) ? 1u : 0u;
        MISC[12] = same; }
    __syncthreads();
    {
        PHASE_IDS();
        pg8::Gemm g{Zb, Wglu_t, D_SSM, D_SSM, D_SSM}; pg8::StaticOrder S; S.init(M, D_SSM, G, bx);
        pg8::EpiGlu E{Zb, a.b_glu, A3 + D_ATTN, DM, stat_s};
        pg8::gemm_phase<pg8::EpiGlu, pg8::StaticOrder, true>(lds, g, S, E);
    }
    TEAM_BAR();

    {
        PHASE_IDS();
        pg8::Gemm g{A3, Wo_t, DM, DM, DM}; pg8::StaticOrder S; S.init(M, DM, G, bx);
        LAS float* ratl = (LAS float*)(lds + LDSCTL_OFF + 2048); LAS float* rsl = ratl + 256;
        if (tid_l < 256) { const int row = team_pm * 256 + tid_l;
            const float sa = __uint_as_float(__hip_atomic_load((const unsigned*)(stat_a + row), __ATOMIC_RELAXED, __HIP_MEMORY_SCOPE_AGENT)), ss = __uint_as_float(__hip_atomic_load((const unsigned*)(stat_s + row), __ATOMIC_RELAXED, __HIP_MEMORY_SCOPE_AGENT));
            const float ra = 1.0f / sqrtf(sa * (1.0f / 1024.0f) + RMS_EPS), rsi = sqrtf(ss * (1.0f / 1024.0f) + RMS_EPS);
            ratl[tid_l] = ra * rsi; rsl[tid_l] = 1.0f / rsi; }
        LDS_WAIT(); __syncthreads();
        pg8::EpiMix E{MIX, DM, ratl, rsl};
        pg8::gemm_phase<pg8::EpiMix, pg8::StaticOrder, true>(lds, g, S, E);
    }
    TEAM_BAR();

    {
        PHASE_IDS();
        float* RH = (float*)(ws + WS_RH); const float* RX = (const float*)(ws + WS_RX);
        f32x4 gq[8];
#pragma unroll
        for (int j = 0; j < 4; ++j) { gq[2 * j] = ((const f32x4*)a.g_post_mix)[128 * j + 2 * lane]; gq[2 * j + 1] = ((const f32x4*)a.g_post_mix)[128 * j + 2 * lane + 1]; }
        for (int it = 0; it < 4; ++it) { const int mb = team_pm * 256 + team_k * 64 + wave * 8 + it * 2;
            v4u mv[2][4], xv[2][4]; float rxi[2], sm[2];
#pragma unroll
            for (int q = 0; q < 2; ++q) { const v4u* mr = (const v4u*)(MIX + (size_t)(mb + q) * DM); const v4u* xr = (const v4u*)(R1 + (size_t)(mb + q) * DM); rxi[q] = RX[mb + q];
#pragma unroll
                for (int j = 0; j < 4; ++j) { mv[q][j] = mr[64 * j + lane]; xv[q][j] = xr[64 * j + lane]; } }
#pragma unroll
            for (int q = 0; q < 2; ++q) { float t = 0.f;
#pragma unroll
                for (int j = 0; j < 4; ++j)
#pragma unroll
                    for (int e = 0; e < 4; ++e) { const float m0 = bf_lo(mv[q][j][e]), m1 = bf_hi(mv[q][j][e]); t += m0 * m0 + m1 * m1; }
                sm[q] = t; }
#pragma unroll
            for (int q = 0; q < 2; ++q) {
                const float rm = 1.0f / sqrtf(wave_sum(sm[q]) * (1.0f / DM) + RMS_EPS), rx = rxi[q];
                float sh = 0.f; v4u* xo = (v4u*)(R1 + (size_t)(mb + q) * DM); f32x4 hq[8];
#pragma unroll
                for (int j = 0; j < 4; ++j) {
                    const f32x4 g0 = gq[2 * j], g1 = gq[2 * j + 1]; const v4u mj = mv[q][j], xj = xv[q][j];
                    f32x4 h0, h1;
                    h0.x = bf_lo(xj.x) * rx + bf_lo(mj.x) * rm * g0.x; h0.y = bf_hi(xj.x) * rx + bf_hi(mj.x) * rm * g0.y; h0.z = bf_lo(xj.y) * rx + bf_lo(mj.y) * rm * g0.z; h0.w = bf_hi(xj.y) * rx + bf_hi(mj.y) * rm * g0.w;
                    h1.x = bf_lo(xj.z) * rx + bf_lo(mj.z) * rm * g1.x; h1.y = bf_hi(xj.z) * rx + bf_hi(mj.z) * rm * g1.y; h1.z = bf_lo(xj.w) * rx + bf_lo(mj.w) * rm * g1.z; h1.w = bf_hi(xj.w) * rx + bf_hi(mj.w) * rm * g1.w;
                    sh += (h0.x * h0.x + h0.y * h0.y) + (h0.z * h0.z + h0.w * h0.w) + (h1.x * h1.x + h1.y * h1.y) + (h1.z * h1.z + h1.w * h1.w);
                    hq[2 * j] = h0; hq[2 * j + 1] = h1;
                }
                const float msh = wave_sum(sh) * (1.0f / DM) + RMS_EPS, rh = 1.0f / sqrtf(msh);
                if (lane == 0) RH[mb + q] = sqrtf(msh);
#pragma unroll
                for (int j = 0; j < 4; ++j) { const f32x4 h0 = hq[2 * j] * rh, h1 = hq[2 * j + 1] * rh;
                    v4u w; w.x = cvt_pk_bf16(h0.x, h0.y); w.y = cvt_pk_bf16(h0.z, h0.w); w.z = cvt_pk_bf16(h1.x, h1.y); w.w = cvt_pk_bf16(h1.z, h1.w); xo[64 * j + lane] = w; }
            }
        }
    }
    TEAM_BAR();

    {
        PHASE_IDS();
        pg8::Gemm g{R1, Wgu_t, DM, DM, DM}; pg8::StaticOrder S; S.init(M, 2 * D_FF, G, bx);
        pg8::EpiSwiGLU E{HID, D_FF, (const float*)(ws + WS_RH)};
        pg8::gemm_phase<pg8::EpiSwiGLU, pg8::StaticOrder, true>(lds, g, S, E);
    }
    TEAM_BAR();

    {
        PHASE_IDS();
        pg8::Gemm g{HID, Wd_t, D_FF, D_FF, D_FF}; pg8::StaticOrder S; S.init(M, DM, G, bx);
        pg8::EpiBf16P E{MIX, DM};
        pg8::gemm_phase<pg8::EpiBf16P, pg8::StaticOrder, true>(lds, g, S, E);
    }
    TEAM_BAR();

    {
        PHASE_IDS();
        f32x4 gq[8];
#pragma unroll
        for (int j = 0; j < 4; ++j) { gq[2 * j] = ((const f32x4*)a.g_post_ffn)[128 * j + 2 * lane]; gq[2 * j + 1] = ((const f32x4*)a.g_post_ffn)[128 * j + 2 * lane + 1]; }
        for (int it = 0; it < 4; ++it) { const int mb = team_pm * 256 + team_k * 64 + wave * 8 + it * 2;
            v4u fv[2][4], hv[2][4]; float sf[2], rhi[2];
#pragma unroll
            for (int q = 0; q < 2; ++q) { const v4u* fr = (const v4u*)(MIX + (size_t)(mb + q) * DM); const v4u* hr = (const v4u*)(R1 + (size_t)(mb + q) * DM); rhi[q] = ((const float*)(ws + WS_RH))[mb + q];
#pragma unroll
                for (int j = 0; j < 4; ++j) { fv[q][j] = fr[64 * j + lane]; hv[q][j] = hr[64 * j + lane]; } }
#pragma unroll
            for (int q = 0; q < 2; ++q) { float t = 0.f;
#pragma unroll
                for (int j = 0; j < 4; ++j)
#pragma unroll
                    for (int e = 0; e < 4; ++e) { const float f0 = bf_lo(fv[q][j][e]), f1 = bf_hi(fv[q][j][e]); t += f0 * f0 + f1 * f1; }
                sf[q] = t; }
#pragma unroll
            for (int q = 0; q < 2; ++q) {
                const float rf = 1.0f / sqrtf(wave_sum(sf[q]) * (1.0f / DM) + RMS_EPS), rx = rhi[q]; f32x4* ho = (f32x4*)(a.out + (size_t)(mb + q) * DM);
#pragma unroll
                for (int j = 0; j < 4; ++j) {
                    const f32x4 g0 = gq[2 * j], g1 = gq[2 * j + 1]; const v4u fj = fv[q][j], hj = hv[q][j]; f32x4 h0, h1;
                    h0.x = bf_lo(hj.x) * rx + bf_lo(fj.x) * rf * g0.x; h0.y = bf_hi(hj.x) * rx + bf_hi(fj.x) * rf * g0.y; h0.z = bf_lo(hj.y) * rx + bf_lo(fj.y) * rf * g0.z; h0.w = bf_hi(hj.y) * rx + bf_hi(fj.y) * rf * g0.w;
                    h1.x = bf_lo(hj.z) * rx + bf_lo(fj.z) * rf * g1.x; h1.y = bf_hi(hj.z) * rx + bf_hi(fj.z) * rf * g1.y; h1.z = bf_lo(hj.w) * rx + bf_lo(fj.w) * rf * g1.z; h1.w = bf_hi(hj.w) * rx + bf_hi(fj.w) * rf * g1.w;
                    ho[128 * j + 2 * lane] = h0; ho[128 * j + 2 * lane + 1] = h1;
                }
            }
        }
    }
}

extern "C" void kernel_launch(void* const* d_in, const int* in_sizes, int n_in, void* d_out, int out_size, void* d_ws, size_t ws_size, hipStream_t stream) {
    static int grid = 0;
    if (grid == 0) {
        if (n_in != 24 || in_sizes[0] != M * DM || out_size != M * DM || ws_size < WS_END) { fprintf(stderr, "kernel_launch: unexpected shapes (n_in %d, in0 %d, out %d, ws %zu)\n", n_in, n_in > 0 ? in_sizes[0] : -1, out_size, ws_size); grid = -1; return; }
        int dev = 0, cus = 0;
        if (hipGetDevice(&dev) != hipSuccess || hipDeviceGetAttribute(&cus, hipDeviceAttributeMultiprocessorCount, dev) != hipSuccess) { grid = -1; return; }
        if (hipFuncSetAttribute((const void*)hymba_fwd, hipFuncAttributeMaxDynamicSharedMemorySize, LDS_BYTES) != hipSuccess) { fprintf(stderr, "kernel_launch: hipFuncSetAttribute failed\n"); grid = -1; return; }
        int per_cu = 0;
        (void)hipOccupancyMaxActiveBlocksPerMultiprocessor(&per_cu, (const void*)hymba_fwd, NWAVES * 64, LDS_BYTES);
        (void)hipGetLastError();
        grid = cus;
        if (grid != 256) { fprintf(stderr, "kernel_launch: built for a 256-CU device (team structure, SSM unit map); found %d CUs\n", cus); grid = -1; return; }
    }
    if (grid < 0) return;
    (void)hipMemsetAsync((char*)d_ws + WS_CTL, 0, CTL_ZERO_BYTES, stream);
    Args a{};
    a.x = (const float*)d_in[0]; a.pos = (const int*)d_in[1]; a.g_pre_mix = (const float*)d_in[2]; a.w_in = (const float*)d_in[3]; a.sinks = (const float*)d_in[4];
    a.a_re = (const float*)d_in[5]; a.a_im = (const float*)d_in[6]; a.log_dt = (const float*)d_in[7]; a.b_re = (const float*)d_in[8]; a.b_im = (const float*)d_in[9];
    a.c_re = (const float*)d_in[10]; a.c_im = (const float*)d_in[11]; a.d_skip = (const float*)d_in[12]; a.w_glu = (const float*)d_in[13]; a.b_glu = (const float*)d_in[14];
    a.g_attn_out = (const float*)d_in[15]; a.g_ssm_out = (const float*)d_in[16]; a.w_o = (const float*)d_in[17]; a.g_post_mix = (const float*)d_in[18]; a.g_pre_ffn = (const float*)d_in[19];
    a.w_gate = (const float*)d_in[20]; a.w_up = (const float*)d_in[21]; a.w_down = (const float*)d_in[22]; a.g_post_ffn = (const float*)d_in[23];
    a.out = (float*)d_out; a.ws = (unsigned char*)d_ws;
    hipLaunchKernelGGL(hymba_fwd, dim3(grid), dim3(NWAVES * 64), LDS_BYTES, stream, a);
}
```

```cpp
#include <hip/hip_runtime.h>
#include <cstdio>
#include <cstdint>

namespace pg8 {
#define PG8_LAS __attribute__((address_space(3)))
typedef unsigned short bf16_t;
typedef short bf16x8 __attribute__((ext_vector_type(8)));
typedef float f32x4 __attribute__((ext_vector_type(4)));
typedef unsigned u32x4 __attribute__((ext_vector_type(4)));
constexpr int BM = 256, BK = 64, HALF = 128, HTB = HALF * BK * 2, STAGE_BYTES = 8 * HTB, NXCD = 8, WGM = 8;

__host__ __device__ __forceinline__ int lds_byte(int r, int c) { const int st = (r >> 4) * 2 + (c >> 5), rr = r & 15, cc = c & 31, ob = rr * 64 + cc * 2; return st * 1024 + (ob ^ (((ob >> 9) & 1) << 5)); }
__host__ __device__ __forceinline__ void stage_rc(int b, int& R, int& C) { const int st = b / 1024, sb = b % 1024, swz = sb ^ (((sb >> 9) & 1) << 5); R = (st >> 1) * 16 + swz / 64; C = (st & 1) * 32 + (swz % 64) / 2; }
__host__ __device__ __forceinline__ int perm32(int rho) { const int n = rho >> 4, i = rho & 15; return 8 * (i >> 2) + 4 * n + (i & 3); }

struct Unit { int pm, pn; };
struct Gemm { const bf16_t* A; const bf16_t* Bt; int lda, ldb, K; };

struct StaticOrder {
    int nM, nN, nwg, G, c;
    __host__ __device__ void init(int M, int N, int G_, int c_) { nM = M / BM; nN = N / BM; nwg = nM * nN; G = G_; c = c_; }
    __host__ __device__ bool next(int i, Unit& u) const {
        const long L = (long)i * G + c; if (L >= nwg) return false;
        int wgid = (int)L; { const int q = nwg / NXCD, r = nwg % NXCD, xcd = wgid % NXCD, off = wgid / NXCD; wgid = (xcd < r ? xcd * (q + 1) : r * (q + 1) + (xcd - r) * q) + off; }
        const int nig = WGM * nN, gid = wgid / nig, fm = gid * WGM, gsz = (nM - fm) < WGM ? (nM - fm) : WGM;
        u.pm = fm + ((wgid % nig) % gsz); u.pn = (wgid % nig) / gsz; return true;
    }
};
struct DiagOrder {
    int G, c, n;
    __host__ __device__ bool next(int i, Unit& u) const { const int L = i * G + c; if (L >= n) return false; u.pm = L; u.pn = L >> 2; return true; }
};

__device__ __forceinline__ unsigned cvt_pk_bf16(float lo, float hi) { unsigned r; asm volatile("v_cvt_pk_bf16_f32 %0, %1, %2" : "=v"(r) : "v"(lo), "v"(hi)); return r; }
__device__ __forceinline__ float bf_lo(unsigned w) { return __uint_as_float(w << 16); }
__device__ __forceinline__ float bf_hi(unsigned w) { return __uint_as_float(w & 0xffff0000u); }
__device__ __forceinline__ float sigmoidf_(float x) { return __builtin_amdgcn_rcpf(1.0f + __builtin_amdgcn_exp2f(-1.4426950408889634f * x)); }
__device__ __forceinline__ float gelu_tanh(float x) { const float u = 1.5957691216057308f * (x + 0.044715f * x * x * x); return x * sigmoidf_(u); }

constexpr float ATT_C2 = 0.125f * 1.4426950408889634f;

struct EpiBf16P {
    static constexpr bool PERM = true, MIDK = false;
    bf16_t* O; int ldc;
    __device__ __forceinline__ void operator()(const f32x4 (&acc)[2][2][4][2], const Unit& u, int wr, int wc, int fr, int fq) const {
        const int row0 = u.pm * BM + wr * 64 + fr, col0 = u.pn * BM + wc * 32 + 8 * fq;
#pragma unroll
        for (int ai = 0; ai < 2; ++ai)
#pragma unroll
            for (int m = 0; m < 4; ++m) { bf16_t* rowp = O + (size_t)(row0 + ai * HALF + m * 16) * ldc + col0;
#pragma unroll
                for (int bj = 0; bj < 2; ++bj) { const f32x4 v0 = acc[ai][bj][m][0], v1 = acc[ai][bj][m][1];
                    u32x4 w; w.x = cvt_pk_bf16(v0[0], v0[1]); w.y = cvt_pk_bf16(v0[2], v0[3]); w.z = cvt_pk_bf16(v1[0], v1[1]); w.w = cvt_pk_bf16(v1[2], v1[3]);
                    *(u32x4*)(rowp + bj * HALF) = w; } }
    }
};
struct EpiMix {
    static constexpr bool PERM = true, MIDK = true;
    bf16_t* O; int ldc; const PG8_LAS float* ratio; const PG8_LAS float* rsl;
    __device__ __forceinline__ void midk(f32x4 (&acc)[2][2][4][2], const Unit& u, int wr, int fr) const {
#pragma unroll
        for (int ai = 0; ai < 2; ++ai)
#pragma unroll
            for (int m = 0; m < 4; ++m) { const float rt = ratio[wr * 64 + fr + ai * HALF + m * 16];
#pragma unroll
                for (int bj = 0; bj < 2; ++bj)
#pragma unroll
                    for (int n = 0; n < 2; ++n) acc[ai][bj][m][n] *= rt; }
    }
    __device__ __forceinline__ void operator()(const f32x4 (&acc)[2][2][4][2], const Unit& u, int wr, int wc, int fr, int fq) const {
        const int row0 = u.pm * BM + wr * 64 + fr, col0 = u.pn * BM + wc * 32 + 8 * fq;
#pragma unroll
        for (int ai = 0; ai < 2; ++ai)
#pragma unroll
            for (int m = 0; m < 4; ++m) { const int row = row0 + ai * HALF + m * 16; bf16_t* rowp = O + (size_t)row * ldc + col0;
                const float rs = rsl[wr * 64 + fr + ai * HALF + m * 16];
#pragma unroll
                for (int bj = 0; bj < 2; ++bj) { const f32x4 v0 = acc[ai][bj][m][0] * rs, v1 = acc[ai][bj][m][1] * rs;
                    u32x4 w; w.x = cvt_pk_bf16(v0[0], v0[1]); w.y = cvt_pk_bf16(v0[2], v0[3]); w.z = cvt_pk_bf16(v1[0], v1[1]); w.w = cvt_pk_bf16(v1[2], v1[3]);
                    *(u32x4*)(rowp + bj * HALF) = w; } }
    }
};
struct EpiQKU {
    static constexpr bool PERM = true, MIDK = false;
    bf16_t* Q; bf16_t* Kp; bf16_t* A2; const PG8_LAS int* posl;
    __device__ __forceinline__ void operator()(const f32x4 (&acc)[2][2][4][2], const Unit& u, int wr, int wc, int fr, int fq) const {
        const int row0 = u.pm * BM + wr * 64 + fr, cw = wc * 32 + 8 * fq;
        if (u.pn < 5) {
            const bool isq = u.pn < 4; const float sc = isq ? ATT_C2 : 1.0f;
            const int i0 = (cw & 63) >> 1;
            float invf[4];
#pragma unroll
            for (int t = 0; t < 4; ++t) invf[t] = __builtin_amdgcn_exp2f(-(float)(i0 + t) * (13.287712379549449f / 32.0f));
            bf16_t* base = isq ? (Q + u.pn * 256) : Kp; const int ld = isq ? 1024 : 256;
#pragma unroll
            for (int ai = 0; ai < 2; ++ai)
#pragma unroll
                for (int m = 0; m < 4; ++m) { const int row = row0 + ai * HALF + m * 16; const float p = (float)posl[wr * 64 + fr + ai * HALF + m * 16];
                    float cs[4], sn[4];
#pragma unroll
                    for (int t = 0; t < 4; ++t) { const float ang = p * invf[t]; const float fr_ = __builtin_amdgcn_fractf(ang * 0.15915494309189535f); sn[t] = __builtin_amdgcn_sinf(fr_) * sc; cs[t] = __builtin_amdgcn_cosf(fr_) * sc; }
#pragma unroll
                    for (int bj = 0; bj < 2; ++bj) { const f32x4 v0 = acc[ai][bj][m][0], v1 = acc[ai][bj][m][1];
                        u32x4 w;
                        w.x = cvt_pk_bf16(v0[0] * cs[0] - v0[1] * sn[0], v0[1] * cs[0] + v0[0] * sn[0]);
                        w.y = cvt_pk_bf16(v0[2] * cs[1] - v0[3] * sn[1], v0[3] * cs[1] + v0[2] * sn[1]);
                        w.z = cvt_pk_bf16(v1[0] * cs[2] - v1[1] * sn[2], v1[1] * cs[2] + v1[0] * sn[2]);
                        w.w = cvt_pk_bf16(v1[2] * cs[3] - v1[3] * sn[3], v1[3] * cs[3] + v1[2] * sn[3]);
                        *(u32x4*)(base + (size_t)row * ld + bj * HALF + cw) = w; } }
        } else {
#pragma unroll
            for (int ai = 0; ai < 2; ++ai)
#pragma unroll
                for (int m = 0; m < 4; ++m) { const int row = row0 + ai * HALF + m * 16;
#pragma unroll
                    for (int bj = 0; bj < 2; ++bj) { const f32x4 v0 = acc[ai][bj][m][0], v1 = acc[ai][bj][m][1];
                        const int gcol = (u.pn - 5) * 256 + bj * HALF + cw, g = gcol >> 4, q0 = gcol & 15;
                        u32x4 w; w.x = cvt_pk_bf16(v0[0], v0[1]); w.y = cvt_pk_bf16(v0[2], v0[3]); w.z = cvt_pk_bf16(v1[0], v1[1]); w.w = cvt_pk_bf16(v1[2], v1[3]);
                        *(u32x4*)(A2 + (size_t)g * (1024 * 384) + (size_t)(row >> 4) * 384 + (row & 15) * 16 + q0) = w; } }
        }
    }
};
struct EpiZ {
    static constexpr bool PERM = false, MIDK = false;
    float* Z;
    __device__ __forceinline__ void operator()(const f32x4 (&acc)[2][2][4][2], const Unit& u, int wr, int wc, int fr, int fq) const {
        const int row0 = u.pm * BM + wr * 64 + fr, col0 = wc * 32 + 4 * fq;
#pragma unroll
        for (int ai = 0; ai < 2; ++ai)
#pragma unroll
            for (int m = 0; m < 4; ++m) { float* rowp = Z + (size_t)(row0 + ai * HALF + m * 16) * 128 + col0;
#pragma unroll
                for (int n = 0; n < 2; ++n) *(f32x4*)(rowp + n * 16) = acc[ai][0][m][n]; }
    }
};
struct EpiY {
    static constexpr bool PERM = true, MIDK = false;
    bf16_t* Zb;
    __device__ __forceinline__ void operator()(const f32x4 (&acc)[2][2][4][2], const Unit& u, int wr, int wc, int fr, int fq) const {
        const int row0 = u.pm * BM + wr * 64 + fr, g = u.pn;
#pragma unroll
        for (int ai = 0; ai < 2; ++ai)
#pragma unroll
            for (int m = 0; m < 4; ++m) { const int bc = (row0 + ai * HALF + m * 16) & 1023;
#pragma unroll
                for (int bj = 0; bj < 2; ++bj) { const f32x4 v0 = acc[ai][bj][m][0], v1 = acc[ai][bj][m][1];
                    const int j = 8 * bj + 2 * wc + (fq >> 1), p0 = 8 * (fq & 1);
                    u32x4 w; w.x = cvt_pk_bf16(gelu_tanh(v0[0]), gelu_tanh(v0[1])); w.y = cvt_pk_bf16(gelu_tanh(v0[2]), gelu_tanh(v0[3]));
                    w.z = cvt_pk_bf16(gelu_tanh(v1[0]), gelu_tanh(v1[1])); w.w = cvt_pk_bf16(gelu_tanh(v1[2]), gelu_tanh(v1[3]));
                    *(u32x4*)(Zb + (size_t)(bc * 16 + j) * 1024 + g * 16 + p0) = w; asm volatile("" ::: "memory"); } }
    }
};
struct EpiGlu {
    static constexpr bool PERM = true, MIDK = false;
    const bf16_t* Zb; const float* bias; bf16_t* O; int ldo; float* st;
    __device__ __forceinline__ void operator()(const f32x4 (&acc)[2][2][4][2], const Unit& u, int wr, int wc, int fr, int fq) const {
        const int row0 = u.pm * BM + wr * 64 + fr, col0 = u.pn * BM + wc * 32 + 8 * fq;
        float part[2][4];
#pragma unroll
        for (int ai = 0; ai < 2; ++ai)
#pragma unroll
            for (int m = 0; m < 4; ++m) part[ai][m] = 0.f;
#pragma unroll
        for (int bj = 0; bj < 2; ++bj) { const f32x4 b0 = *(const f32x4*)(bias + col0 + bj * HALF), b1 = *(const f32x4*)(bias + col0 + bj * HALF + 4);
#pragma unroll
            for (int ai = 0; ai < 2; ++ai)
#pragma unroll
                for (int m = 0; m < 4; ++m) { const int row = row0 + ai * HALF + m * 16;
                    const u32x4 zi = *(const u32x4*)(Zb + (size_t)row * 1024 + col0 + bj * HALF); const f32x4 v0 = acc[ai][bj][m][0] + b0, v1 = acc[ai][bj][m][1] + b1;
                    float e[8];
                    e[0] = bf_lo(zi.x) * sigmoidf_(v0[0]); e[1] = bf_hi(zi.x) * sigmoidf_(v0[1]); e[2] = bf_lo(zi.y) * sigmoidf_(v0[2]); e[3] = bf_hi(zi.y) * sigmoidf_(v0[3]);
                    e[4] = bf_lo(zi.z) * sigmoidf_(v1[0]); e[5] = bf_hi(zi.z) * sigmoidf_(v1[1]); e[6] = bf_lo(zi.w) * sigmoidf_(v1[2]); e[7] = bf_hi(zi.w) * sigmoidf_(v1[3]);
                    part[ai][m] += (e[0] * e[0] + e[1] * e[1]) + (e[2] * e[2] + e[3] * e[3]) + (e[4] * e[4] + e[5] * e[5]) + (e[6] * e[6] + e[7] * e[7]);
                    u32x4 w; w.x = cvt_pk_bf16(e[0], e[1]); w.y = cvt_pk_bf16(e[2], e[3]); w.z = cvt_pk_bf16(e[4], e[5]); w.w = cvt_pk_bf16(e[6], e[7]);
                    *(u32x4*)(O + (size_t)row * ldo + col0 + bj * HALF) = w; } }
#pragma unroll
        for (int ai = 0; ai < 2; ++ai)
#pragma unroll
            for (int m = 0; m < 4; ++m) { float p = part[ai][m]; p += __shfl_xor(p, 16); p += __shfl_xor(p, 32);
                if (fq == 0) (void)__hip_atomic_fetch_add(st + row0 + ai * HALF + m * 16, p, __ATOMIC_RELAXED, __HIP_MEMORY_SCOPE_AGENT); }
    }
};
struct EpiSwiGLU {
    static constexpr bool PERM = true, MIDK = false;
    bf16_t* O; int ldc; const float* rs;
    __device__ __forceinline__ void operator()(const f32x4 (&acc)[2][2][4][2], const Unit& u, int wr, int wc, int fr, int fq) const {
        const int row0 = u.pm * BM + wr * 64 + fr, col0 = u.pn * HALF + wc * 32 + 8 * fq;
#pragma unroll
        for (int ai = 0; ai < 2; ++ai)
#pragma unroll
            for (int m = 0; m < 4; ++m) {
                const f32x4 g0 = acc[ai][0][m][0], g1 = acc[ai][0][m][1], u0 = acc[ai][1][m][0], u1 = acc[ai][1][m][1];
                u32x4 w;
                w.x = cvt_pk_bf16(g0[0] * sigmoidf_(g0[0]) * u0[0], g0[1] * sigmoidf_(g0[1]) * u0[1]); w.y = cvt_pk_bf16(g0[2] * sigmoidf_(g0[2]) * u0[2], g0[3] * sigmoidf_(g0[3]) * u0[3]);
                w.z = cvt_pk_bf16(g1[0] * sigmoidf_(g1[0]) * u1[0], g1[1] * sigmoidf_(g1[1]) * u1[1]); w.w = cvt_pk_bf16(g1[2] * sigmoidf_(g1[2]) * u1[2], g1[3] * sigmoidf_(g1[3]) * u1[3]);
                *(u32x4*)(O + (size_t)(row0 + ai * HALF + m * 16) * ldc + col0) = w; }
    }
};

template <class Epi, class Sched, bool ALIGN_EPI>
__device__ __forceinline__ void gemm_phase(PG8_LAS unsigned char* lds, const Gemm g, const Sched& S, const Epi& E) {
    int tid_ = threadIdx.x; asm volatile("" : "+v"(tid_));
    const int tid = tid_, wid = __builtin_amdgcn_readfirstlane(tid >> 6), lane = tid & 63, wr = wid >> 2, wc = wid & 3, fr = lane & 15, fq = lane >> 4;
    const int nt = g.K / BK;
    unsigned voffA[2], voffB[2];
#pragma unroll
    for (int i = 0; i < 2; ++i) { int R, C; stage_rc(tid * 16 + i * 8192, R, C); const int Rb = Epi::PERM ? ((R & ~31) + perm32(R & 31)) : R;
        voffA[i] = (unsigned)(R * g.lda + C) * 2u; voffB[i] = (unsigned)(Rb * g.ldb + C) * 2u; }
    const size_t kstep = (size_t)(BK * 2);
    const size_t hstepA = (size_t)HALF * g.lda * 2, hstepB = (size_t)HALF * g.ldb * 2;
    const size_t tstepA = 2 * hstepA, tstepB = 2 * hstepB;
    const unsigned ldsw = (unsigned)wid * 1024u;
    const size_t tailoff = (size_t)(nt - 2) * (size_t)(BK * 2);
    const int aoff = lds_byte(wr * 64 + fr, fq * 8), boff = lds_byte(wc * 32 + fr, fq * 8);
#define PG8_SA(b, h) (((b) * 2 + (h)) * HTB)
#define PG8_SB(b, h) ((4 + (b) * 2 + (h)) * HTB)
#define PG8_STAGE(bufoff, gbase, voff) do { _Pragma("unroll") for (int _i = 0; _i < 2; ++_i) \
        __builtin_amdgcn_global_load_lds((const unsigned*)((const char*)(gbase) + (voff)[_i]), (PG8_LAS unsigned*)(lds + (bufoff) + ldsw + _i * 8192), 16, 0, 0); } while (0)
#define PG8_LDA(dst, b, h) do { _Pragma("unroll") for (int m = 0; m < 4; ++m) _Pragma("unroll") for (int k = 0; k < 2; ++k) dst[m][k] = *(const PG8_LAS bf16x8*)(lds + PG8_SA(b, h) + aoff + m * 2048 + k * 1024); } while (0)
#define PG8_LDB(dst, b, h) do { _Pragma("unroll") for (int n = 0; n < 2; ++n) _Pragma("unroll") for (int k = 0; k < 2; ++k) dst[n][k] = *(const PG8_LAS bf16x8*)(lds + PG8_SB(b, h) + boff + n * 2048 + k * 1024); } while (0)
#define PG8_MMA(ai, bj, At, Bt) do { __builtin_amdgcn_s_setprio(1); _Pragma("unroll") for (int m = 0; m < 4; ++m) _Pragma("unroll") for (int n = 0; n < 2; ++n) _Pragma("unroll") for (int k = 0; k < 2; ++k) \
        acc[ai][bj][m][n] = __builtin_amdgcn_mfma_f32_16x16x32_bf16(Bt[n][k], At[m][k], acc[ai][bj][m][n], 0, 0, 0); __builtin_amdgcn_s_setprio(0); } while (0)
#define PG8_WAIT_V(n) asm volatile("s_waitcnt vmcnt(" #n ")" ::: "memory")
#define PG8_WAIT_L(n) asm volatile("s_waitcnt lgkmcnt(" #n ")" ::: "memory")
#define PG8_BAR __builtin_amdgcn_s_barrier()
#define PG8_SCHED __builtin_amdgcn_sched_barrier(0)
    Unit cur, nxt; int ui = 0;
    if (!S.next(0, cur)) return;
    f32x4 acc[2][2][4][2];
#pragma unroll
    for (int a = 0; a < 2; ++a)
#pragma unroll
        for (int b = 0; b < 2; ++b)
#pragma unroll
            for (int m = 0; m < 4; ++m)
#pragma unroll
                for (int n = 0; n < 2; ++n) acc[a][b][m][n] = (f32x4){0.f, 0.f, 0.f, 0.f};
    bf16x8 At[4][2], B0[2][2], B1[2][2];
    const char* cA = (const char*)g.A + (size_t)cur.pm * tstepA; const char* cB = (const char*)g.Bt + (size_t)cur.pn * tstepB;
    PG8_STAGE(PG8_SB(0, 0), cB, voffB); PG8_STAGE(PG8_SB(0, 1), cB + hstepB, voffB); PG8_STAGE(PG8_SA(0, 0), cA, voffA); PG8_STAGE(PG8_SA(0, 1), cA + hstepA, voffA);
    if (wr == 1) PG8_BAR;
    PG8_WAIT_V(2); PG8_BAR;
    PG8_STAGE(PG8_SB(1, 0), cB + kstep, voffB); PG8_STAGE(PG8_SA(1, 0), cA + kstep, voffA); PG8_STAGE(PG8_SB(1, 1), cB + hstepB + kstep, voffB);
    PG8_WAIT_V(6); PG8_BAR;
    for (;;) {
        const bool has_next = S.next(ui + 1, nxt);
        const size_t tail_ = has_next ? 0 : tailoff; const char* nA = (has_next ? (const char*)g.A + (size_t)nxt.pm * tstepA : cA) + tail_; const char* nB = (has_next ? (const char*)g.Bt + (size_t)nxt.pn * tstepB : cB) + tail_;
        for (int t = 0; t < nt; t += 2) {
            if constexpr (Epi::MIDK) { if (t == (nt >> 1)) E.midk(acc, cur, wr, fr); }
            const bool last = (t == nt - 2);
            const char* a1 = cA + (size_t)(t + 1) * kstep;
            const char* a2 = last ? nA : cA + (size_t)(t + 2) * kstep; const char* b2 = last ? nB : cB + (size_t)(t + 2) * kstep;
            const char* a3 = a2 + kstep; const char* b3 = b2 + kstep;
            PG8_LDB(B0, 0, 0); PG8_LDB(B1, 0, 1); PG8_SCHED; PG8_LDA(At, 0, 0); PG8_STAGE(PG8_SA(1, 1), a1 + hstepA, voffA);
            PG8_WAIT_V(8); PG8_WAIT_L(0); PG8_BAR; PG8_MMA(0, 0, At, B0); PG8_MMA(0, 1, At, B1); PG8_BAR; PG8_SCHED;
            PG8_LDA(At, 0, 1); PG8_STAGE(PG8_SB(0, 0), b2, voffB); PG8_STAGE(PG8_SB(0, 1), b2 + hstepB, voffB); PG8_STAGE(PG8_SA(0, 0), a2, voffA);
            PG8_WAIT_V(8); PG8_WAIT_L(0); PG8_BAR; PG8_MMA(1, 0, At, B0); PG8_MMA(1, 1, At, B1); PG8_BAR; PG8_SCHED;
            PG8_LDB(B0, 1, 0); PG8_LDB(B1, 1, 1); PG8_SCHED; PG8_LDA(At, 1, 0); PG8_STAGE(PG8_SA(0, 1), a2 + hstepA, voffA);
            PG8_WAIT_V(8); PG8_WAIT_L(0); PG8_BAR; PG8_MMA(0, 0, At, B0); PG8_MMA(0, 1, At, B1); PG8_BAR; PG8_SCHED;
            PG8_LDA(At, 1, 1); PG8_STAGE(PG8_SB(1, 0), b3, voffB); PG8_STAGE(PG8_SB(1, 1), b3 + hstepB, voffB); PG8_STAGE(PG8_SA(1, 0), a3, voffA);
            PG8_WAIT_V(8); PG8_WAIT_L(0); PG8_BAR; PG8_MMA(1, 0, At, B0); PG8_MMA(1, 1, At, B1); PG8_BAR; PG8_SCHED;
        }
        if constexpr (ALIGN_EPI) { if (wr == 0) PG8_BAR; }
        E(acc, cur, wr, wc, fr, fq);
        if (!has_next) break;
#pragma unroll
        for (int a = 0; a < 2; ++a)
#pragma unroll
            for (int b = 0; b < 2; ++b)
#pragma unroll
                for (int m = 0; m < 4; ++m)
#pragma unroll
                    for (int n = 0; n < 2; ++n) acc[a][b][m][n] = (f32x4){0.f, 0.f, 0.f, 0.f};
        cur = nxt; cA = nA; cB = nB; ++ui;
        if constexpr (ALIGN_EPI) { if (wr == 1) PG8_BAR; }
    }
    PG8_WAIT_V(0);
    if constexpr (!ALIGN_EPI) { if (wr == 0) PG8_BAR; }
    PG8_BAR;
#undef PG8_SA
#undef PG8_SB
#undef PG8_STAGE
#undef PG8_LDA
#undef PG8_LDB
#undef PG8_MMA
#undef PG8_WAIT_V
#undef PG8_WAIT_L
#undef PG8_BAR
#undef PG8_SCHED
}
}

constexpr int NWAVES = 8;
constexpr int BATCH = 8, SEQ = 2048, DM = 2048, M = BATCH * SEQ;
constexpr int D_ATTN = 1024, D_KV = 256, D_SSM = 1024, D_IN = 2560, D_FF = 5632, NQH = 16, NKVH = 4, HD = 64;
constexpr int NG = 64, NST = 64, PCH = 16, CH = 16, NCH = SEQ / CH;
constexpr int A2LD = 384;
constexpr float RMS_EPS = 1e-6f;

constexpr size_t MiB = 1u << 20;
constexpr size_t WS_CTL = 0, CTL_ZERO_BYTES = 1 * MiB;
constexpr size_t WS_WIN = 2 * MiB, WS_WGLU = 12 * MiB, WS_WO = 14 * MiB, WS_WGU = 22 * MiB, WS_WD = 66 * MiB;
constexpr size_t WS_TC = 88 * MiB, WS_BZ = 100 * MiB, WS_LAM = 108 * MiB, WS_RH = 109 * MiB, WS_RX = 110 * MiB;
constexpr size_t WS_R1 = 112 * MiB;
constexpr size_t WS_R2 = 176 * MiB;
constexpr size_t WS_Q = WS_R2, WS_K = WS_R2 + 32 * MiB, WS_VT = WS_R2 + 40 * MiB;
constexpr size_t WS_A3 = 240 * MiB, WS_Z = 304 * MiB;
constexpr size_t WS_A2 = 336 * MiB;
constexpr size_t WS_ZS = 384 * MiB;
constexpr size_t WS_HID = 336 * MiB;
constexpr size_t WS_END = 512 * MiB;
constexpr int CW_BAR = 4096, CW_TEAM = 16384, CW_STAT_A = 65536, CW_STAT_S = 81920;

constexpr int RING_BYTES = 131072, LDSCTL_OFF = RING_BYTES, MISC_OFF = LDSCTL_OFF + 320, LDS_BYTES = 147456;

#define GAS __attribute__((address_space(1)))
#define LAS __attribute__((address_space(3)))
typedef unsigned short bf16;
typedef unsigned v4u __attribute__((ext_vector_type(4)));
typedef unsigned v2u __attribute__((ext_vector_type(2)));
typedef float f32x4 __attribute__((ext_vector_type(4)));
typedef float f32x16 __attribute__((ext_vector_type(16)));
typedef short bf16x8 __attribute__((ext_vector_type(8)));
#define LDS_WAIT() asm volatile("s_waitcnt lgkmcnt(0)" ::: "memory")
using pg8::cvt_pk_bf16; using pg8::bf_lo; using pg8::bf_hi;

#define XB_TMO      128
#define XB_XCNT(j)  (256  + 64 * (j))
#define XB_XSUB(j)  (1280 + 64 * (j))
#define XB_XGEN(j)  (2304 + 64 * (j))
#define XB_TOP      3328
#define XB_TOPGEN   3392
#define XCD_BAR_WORDS 3456
#define XB_SPIN_CAP (1u << 18)
__device__ __forceinline__ unsigned xb_ld(unsigned* p)              { return __hip_atomic_load(p, __ATOMIC_RELAXED, __HIP_MEMORY_SCOPE_AGENT); }
__device__ __forceinline__ unsigned xb_add(unsigned* p, unsigned v) { return __hip_atomic_fetch_add(p, v, __ATOMIC_RELAXED, __HIP_MEMORY_SCOPE_AGENT); }
__device__ __forceinline__ unsigned xb_xcc_id() { return (unsigned)__builtin_amdgcn_s_getreg((3 << 11) | 20) & 0xFu; }
#define XB_SPIN(cond, bar) do { unsigned _sp = 0; while (cond) { __builtin_amdgcn_s_sleep(1); \
    if ((++_sp & 255u) == 0u) { if (xb_ld(&(bar)[XB_TMO])) break; if (_sp > XB_SPIN_CAP) { atomicAdd(&(bar)[XB_TMO], 1u); break; } } } } while (0)
struct XcdBarrier { unsigned* bar; unsigned x; volatile LAS unsigned* st; };
__device__ __forceinline__ XcdBarrier xcd_barrier_post(unsigned* bar, volatile LAS unsigned* st) {
    XcdBarrier b; b.bar = bar; b.x = xb_xcc_id(); b.st = st;
    if (threadIdx.x == 0) (void)xb_add(&bar[XB_XCNT(b.x)], 1u);
    return b;
}
__device__ __forceinline__ void xcd_barrier_complete(unsigned* bar, unsigned x, unsigned& nloc, unsigned& nx) {
    const unsigned G = gridDim.x * gridDim.y * gridDim.z;
    unsigned sum, cnt, mine, sp = 0u;
    for (;;) {
        sum = 0u; cnt = 0u; mine = 0u;
#pragma unroll
        for (unsigned j = 0; j < 16; ++j) { const unsigned c = xb_ld(&bar[XB_XCNT(j)]); sum += c; cnt += (c > 0u) ? 1u : 0u; mine = (j == x) ? c : mine; }
        if (sum == G) break;
        __builtin_amdgcn_s_sleep(1);
        if ((++sp & 255u) == 0u) { if (xb_ld(&bar[XB_TMO])) break; if (sp > XB_SPIN_CAP) { atomicAdd(&bar[XB_TMO], 1u); break; } }
    }
    nloc = mine > 0u ? mine : 1u; nx = cnt > 0u ? cnt : 1u;
}
__device__ __forceinline__ void xcd_barrier(const XcdBarrier& b) {
    asm volatile("s_waitcnt vmcnt(0)" ::: "memory");
    __syncthreads();
    if (threadIdx.x == 0) {
        unsigned* bar = b.bar;
        __builtin_amdgcn_s_waitcnt(0);
        unsigned nloc = b.st[0], nx = b.st[1];
        if (nloc == 0u) { xcd_barrier_complete(bar, b.x, nloc, nx); b.st[0] = nloc; b.st[1] = nx; }
        const unsigned old = xb_add(&bar[XB_XSUB(b.x)], 1u);
        const unsigned gen = old / nloc;
        if (old + 1u == (gen + 1u) * nloc) {
            __builtin_amdgcn_fence(__ATOMIC_RELEASE, "agent");
            asm volatile("s_waitcnt vmcnt(0)" ::: "memory");
            const unsigned og = xb_add(&bar[XB_TOP], 1u);
            const unsigned tg = og / nx;
            if (og + 1u == (tg + 1u) * nx) xb_add(&bar[XB_TOPGEN], 1u);
            else XB_SPIN(xb_ld(&bar[XB_TOPGEN]) == tg, bar);
            __builtin_amdgcn_fence(__ATOMIC_ACQUIRE, "agent");
            xb_add(&bar[XB_XGEN(b.x)], 1u);
            asm volatile("s_waitcnt vmcnt(0)" ::: "memory");
        } else {
            XB_SPIN(xb_ld(&bar[XB_XGEN(b.x)]) == gen, bar);
            __builtin_amdgcn_fence(__ATOMIC_ACQUIRE, "agent");
            asm volatile("s_waitcnt vmcnt(0)" ::: "memory");
        }
    }
    __syncthreads();
}

__device__ __forceinline__ void team_barrier(unsigned* cnt, unsigned* tmo, unsigned& epoch, volatile LAS unsigned* same_xcd) {
    asm volatile("s_waitcnt vmcnt(0)" ::: "memory");
    __syncthreads();
    if (threadIdx.x == 0) {
        if (*same_xcd != 1u) { __builtin_amdgcn_fence(__ATOMIC_RELEASE, "agent"); }
        asm volatile("s_waitcnt vmcnt(0)" ::: "memory");
        (void)xb_add(cnt, 1u);
        const unsigned want = 4u * epoch; unsigned sp = 0u;
        while (xb_ld(cnt) < want) { __builtin_amdgcn_s_sleep(1); if ((++sp & 255u) == 0u) { if (xb_ld(tmo)) break; if (sp > XB_SPIN_CAP) { atomicAdd(tmo, 1u); break; } } }
        __builtin_amdgcn_fence(__ATOMIC_ACQUIRE, "agent");
        asm volatile("s_waitcnt vmcnt(0)" ::: "memory");
    }
    __syncthreads();
    ++epoch;
}

__device__ __forceinline__ float wave_sum(float v) {
#pragma unroll
    for (int o = 1; o < 64; o <<= 1) v += __shfl_xor(v, o);
    return v;
}
__device__ __forceinline__ void sincos_rev(double rev, float& s, float& c) {
    const double fr = rev - __builtin_rint(rev); const float f = (float)fr;
    s = __builtin_amdgcn_sinf(f); c = __builtin_amdgcn_cosf(f);
}
enum { MAP_PLAIN = 0, MAP_WIN = 1, MAP_GATE = 2, MAP_UP = 3 };
template <int MODE> __device__ __forceinline__ int map_row(int n) {
    if (MODE == MAP_WIN) {
        if (n < 1280) { const int d = n & 63; return (n & ~63) + (d < 32 ? 2 * d : 2 * (d - 32) + 1); }
        if (n < 1536) return 2304 + (n - 1280);
        return 1280 + (n - 1536);
    }
    if (MODE == MAP_GATE) return ((n >> 7) << 8) + (n & 127);
    if (MODE == MAP_UP) return ((n >> 7) << 8) + 128 + (n & 127);
    return n;
}
template <int MODE> __device__ __forceinline__ void transpose_item(const float* W, int K, int N, bf16* WT, const float* gs, LAS float* scr, int item, int lane) {
    const int nblk = N / 32, kb = item / nblk, nb = item % nblk, k0 = 64 * kb, n0 = 32 * nb;
    const float* src = W + (size_t)(k0 + (lane >> 5)) * N + n0 + (lane & 31);
    float v[32];
#pragma unroll
    for (int i = 0; i < 32; ++i) v[i] = src[(size_t)(2 * i) * N];
    const int c = lane & 7;
    f32x4 g0 = (f32x4){1.f, 1.f, 1.f, 1.f}, g1 = g0;
    if (gs) { g0 = *(const f32x4*)(gs + k0 + 8 * c); g1 = *(const f32x4*)(gs + k0 + 8 * c + 4); }
    LAS float* sw = scr + (lane >> 5) * 33 + (lane & 31);
#pragma unroll
    for (int i = 0; i < 32; ++i) sw[(2 * i) * 33] = v[i];
    LDS_WAIT(); asm volatile("" ::: "memory");
#pragma unroll
    for (int j = 0; j < 4; ++j) { const int n = (lane >> 3) + 8 * j; const LAS float* s = scr + (8 * c) * 33 + n;
        v4u o; o.x = cvt_pk_bf16(s[0 * 33] * g0.x, s[1 * 33] * g0.y); o.y = cvt_pk_bf16(s[2 * 33] * g0.z, s[3 * 33] * g0.w); o.z = cvt_pk_bf16(s[4 * 33] * g1.x, s[5 * 33] * g1.y); o.w = cvt_pk_bf16(s[6 * 33] * g1.z, s[7 * 33] * g1.w);
        *(v4u*)(WT + (size_t)map_row<MODE>(n0 + n) * K + k0 + 8 * c) = o; }
    LDS_WAIT(); asm volatile("" ::: "memory");
}

struct TrDesc { const float* W; bf16* WT; const float* gs; int K, N, mode, item; };
struct TrRegs { float v[32]; f32x4 g0, g1; };
__device__ __forceinline__ int map_row_rt(int mode, int n) {
    if (mode == MAP_WIN) return map_row<MAP_WIN>(n);
    if (mode == MAP_GATE) return map_row<MAP_GATE>(n);
    if (mode == MAP_UP) return map_row<MAP_UP>(n);
    return n;
}
__device__ __forceinline__ void tr_load(const TrDesc& d, int lane, TrRegs& t) {
    const int nblk = d.N / 32, kb = d.item / nblk, nb = d.item - kb * nblk, k0 = 64 * kb, n0 = 32 * nb;
    const float* src = d.W + (size_t)(k0 + (lane >> 5)) * d.N + n0 + (lane & 31);
#pragma unroll
    for (int i = 0; i < 32; ++i) t.v[i] = src[(size_t)(2 * i) * d.N];
    const int c = lane & 7;
    t.g0 = (f32x4){1.f, 1.f, 1.f, 1.f}; t.g1 = t.g0;
    if (d.gs) { t.g0 = *(const f32x4*)(d.gs + k0 + 8 * c); t.g1 = *(const f32x4*)(d.gs + k0 + 8 * c + 4); }
}
__device__ __forceinline__ void tr_finish(const TrDesc& d, const TrRegs& t, LAS float* scr, int lane) {
    const int nblk = d.N / 32, kb = d.item / nblk, nb = d.item - kb * nblk, k0 = 64 * kb, n0 = 32 * nb, c = lane & 7;
    LAS float* sw = scr + (lane >> 5) * 33 + (lane & 31);
#pragma unroll
    for (int i = 0; i < 32; ++i) sw[(2 * i) * 33] = t.v[i];
    LDS_WAIT(); asm volatile("" ::: "memory");
#pragma unroll
    for (int j = 0; j < 4; ++j) { const int n = (lane >> 3) + 8 * j; const LAS float* s = scr + (8 * c) * 33 + n;
        v4u o; o.x = cvt_pk_bf16(s[0 * 33] * t.g0.x, s[1 * 33] * t.g0.y); o.y = cvt_pk_bf16(s[2 * 33] * t.g0.z, s[3 * 33] * t.g0.w); o.z = cvt_pk_bf16(s[4 * 33] * t.g1.x, s[5 * 33] * t.g1.y); o.w = cvt_pk_bf16(s[6 * 33] * t.g1.z, s[7 * 33] * t.g1.w);
        *(v4u*)(d.WT + (size_t)map_row_rt(d.mode, n0 + n) * d.K + k0 + 8 * c) = o; }
    LDS_WAIT(); asm volatile("" ::: "memory");
}

struct Args {
    const float* x; const int* pos; const float* g_pre_mix; const float* w_in; const float* sinks; const float* a_re; const float* a_im; const float* log_dt;
    const float* b_re; const float* b_im; const float* c_re; const float* c_im; const float* d_skip; const float* w_glu; const float* b_glu;
    const float* g_attn_out; const float* g_ssm_out; const float* w_o; const float* g_post_mix; const float* g_pre_ffn; const float* w_gate; const float* w_up;
    const float* w_down; const float* g_post_ffn; float* out; unsigned char* ws;
};

__device__ __forceinline__ void ssm_precompute(const Args& a, int g, LAS unsigned char* lds, int tid) {
    typedef float f32x2v __attribute__((ext_vector_type(2)));
    LAS f32x2v* P = (LAS f32x2v*)lds;
    LAS f32x2v* Bb = (LAS f32x2v*)(lds + 8704);
    LAS f32x2v* Cc = (LAS f32x2v*)(lds + 8704 + 8192);
    LAS float* Kk = (LAS float*)(lds + 8704 + 16384);
    const float dt = __builtin_amdgcn_exp2f(a.log_dt[g] * 1.4426950408889634f);
    for (int e = tid; e < 17 * 64; e += 512) { const int k = e >> 6, n = e & 63; const float ar = a.a_re[g * 64 + n], ai = a.a_im[g * 64 + n];
        const float mag = __builtin_amdgcn_exp2f((float)k * ar * dt * 1.4426950408889634f); float s, c; sincos_rev((double)k * (double)ai * (double)dt * 0.15915494309189535, s, c);
        P[e] = (f32x2v){mag * c, mag * s}; }
    for (int e = tid; e < 1024; e += 512) { const int n = e >> 4; const float ar = a.a_re[g * 64 + n], ai = a.a_im[g * 64 + n];
        const float mag = __builtin_amdgcn_exp2f(ar * dt * 1.4426950408889634f); float s, c; sincos_rev((double)ai * (double)dt * 0.15915494309189535, s, c);
        const float lr = mag * c, li = mag * s, den = ar * ar + ai * ai, nr = lr - 1.0f, ni = li;
        const float fre = (nr * ar + ni * ai) / den, fim = (ni * ar - nr * ai) / den;
        const float br = a.b_re[(size_t)g * 1024 + e], bi = a.b_im[(size_t)g * 1024 + e];
        Bb[e] = (f32x2v){fre * br - fim * bi, fre * bi + fim * br};
        Cc[e] = (f32x2v){a.c_re[(size_t)g * 1024 + e], a.c_im[(size_t)g * 1024 + e]}; }
    LDS_WAIT(); __syncthreads();
    for (int e = tid; e < 4096; e += 512) { const int k = e >> 8, p = (e >> 4) & 15, q = e & 15; float s = 0.f;
        for (int n = 0; n < 64; ++n) { const f32x2v c = Cc[p * 64 + n], l = P[k * 64 + n], b = Bb[n * 16 + q];
            const float tr = c.x * l.x - c.y * l.y, ti = c.x * l.y + c.y * l.x; s += tr * b.x - ti * b.y; }
        Kk[e] = s; }
    LDS_WAIT(); __syncthreads();
    bf16* TC = (bf16*)(a.ws + WS_TC) + (size_t)g * 256 * A2LD;
    bf16* BZ = (bf16*)(a.ws + WS_BZ) + (size_t)g * 256 * 256;
    {
        const int row = tid >> 1, j = row >> 4, p = row & 15; const float dp = a.d_skip[g * 16 + p];
        for (int ci = 0; ci < 16; ++ci) { const int col0 = 128 * (tid & 1) + 8 * ci, i = col0 >> 4, q0 = col0 & 15; float v[8];
#pragma unroll
            for (int e = 0; e < 8; ++e) { float t = 0.f; if (i <= j) { t = Kk[((j - i) * 16 + p) * 16 + q0 + e]; if (i == j && q0 + e == p) t += dp; } v[e] = t; }
            v4u o; o.x = cvt_pk_bf16(v[0], v[1]); o.y = cvt_pk_bf16(v[2], v[3]); o.z = cvt_pk_bf16(v[4], v[5]); o.w = cvt_pk_bf16(v[6], v[7]);
            *(v4u*)(TC + (size_t)row * A2LD + col0) = o; }
        for (int ci = 0; ci < 8; ++ci) { const int n0 = 32 * (tid & 1) + 4 * ci; float v[8];
#pragma unroll
            for (int e = 0; e < 4; ++e) { const f32x2v c = Cc[p * 64 + n0 + e], l = P[(j + 1) * 64 + n0 + e]; v[2 * e] = c.x * l.x - c.y * l.y; v[2 * e + 1] = -(c.x * l.y + c.y * l.x); }
            v4u o; o.x = cvt_pk_bf16(v[0], v[1]); o.y = cvt_pk_bf16(v[2], v[3]); o.z = cvt_pk_bf16(v[4], v[5]); o.w = cvt_pk_bf16(v[6], v[7]);
            *(v4u*)(TC + (size_t)row * A2LD + 256 + 2 * n0) = o; }
    }
    {
        const int row = tid >> 2, n = row >> 1, ri = row & 1;
        for (int ci = 0; ci < 8; ++ci) { const int col0 = 64 * (tid & 3) + 8 * ci, i = col0 >> 4, q0 = col0 & 15; float v[8];
#pragma unroll
            for (int e = 0; e < 8; ++e) { const f32x2v l = P[(15 - i) * 64 + n], b = Bb[n * 16 + q0 + e]; v[e] = ri ? (l.x * b.y + l.y * b.x) : (l.x * b.x - l.y * b.y); }
            v4u o; o.x = cvt_pk_bf16(v[0], v[1]); o.y = cvt_pk_bf16(v[2], v[3]); o.z = cvt_pk_bf16(v[4], v[5]); o.w = cvt_pk_bf16(v[6], v[7]);
            *(v4u*)(BZ + (size_t)row * 256 + col0) = o;
            *(v4u*)(BZ + (size_t)(128 + row) * 256 + col0) = (v4u){0u, 0u, 0u, 0u}; }
    }
    if (tid < 64) { const f32x2v l = P[16 * 64 + tid]; ((float*)(a.ws + WS_LAM))[(g * 64 + tid) * 2] = l.x; ((float*)(a.ws + WS_LAM))[(g * 64 + tid) * 2 + 1] = l.y; }
    LDS_WAIT(); __syncthreads();
}

constexpr int AT_KROW = 144, AT_VROW = 392, AT_V_OFF = 192 * AT_KROW, AT_LDS_BYTES = AT_V_OFF + 64 * AT_VROW;
__device__ __forceinline__ int crow(int r, int hi) { return (r & 3) + 8 * (r >> 2) + 4 * hi; }
__device__ __forceinline__ void attn_phase(LAS unsigned char* lds, int vcu, int G, const bf16* Qp, const bf16* Kp, const bf16* Vt, const float* sinks, bf16* AO, int ldo, float* st) {
    typedef unsigned long long u64;
    int tid = threadIdx.x; asm volatile("" : "+v"(tid));
    const int lane = tid & 63, wave = __builtin_amdgcn_readfirstlane(tid >> 6), r32 = lane & 31, hi = lane >> 5, hq = wave & 3, qsub = wave >> 2;
    const float NEG = -INFINITY;
    for (int id = vcu; id < 1024; id += G) {
        const int b = id >> 7, kvh = (id >> 5) & 3, q0 = 64 * (id & 31), h = kvh * 4 + hq;
        const size_t tok0 = (size_t)b * SEQ;
        const int jt0 = (q0 >= 128) ? 0 : (128 - q0) / 32;
        v4u kv[3], vv[3];
#pragma unroll
        for (int i = 0; i < 3; ++i) { const int c = tid + 512 * i, row = c >> 3, ch = c & 7, key = q0 - 128 + row;
            if (key >= 0) kv[i] = *(const v4u*)(Kp + (tok0 + key) * D_KV + kvh * HD + ch * 8); }
#pragma unroll
        for (int i = 0; i < 3; ++i) { const int c = tid + 512 * i, d = c / 24, ch = c - d * 24, key0 = q0 - 128 + 8 * ch;
            if (key0 >= 0) vv[i] = *(const v4u*)(Vt + (size_t)(kvh * HD + d) * M + tok0 + key0); }
        const bf16* qrow = Qp + (tok0 + q0 + 32 * qsub + r32) * D_ATTN + h * HD + 32 * hi;
        bf16x8 qf[4];
#pragma unroll
        for (int kk = 0; kk < 4; ++kk) qf[kk] = *(const bf16x8*)(qrow + 8 * kk);
#pragma unroll
        for (int i = 0; i < 3; ++i) { const int c = tid + 512 * i, row = c >> 3, ch = c & 7, key = q0 - 128 + row;
            if (key >= 0) *(LAS v4u*)(lds + row * AT_KROW + ch * 16) = kv[i]; }
#pragma unroll
        for (int i = 0; i < 3; ++i) { const int c = tid + 512 * i, d = c / 24, ch = c - d * 24, key0 = q0 - 128 + 8 * ch;
            if (key0 >= 0) { LAS u64* p = (LAS u64*)(lds + AT_V_OFF + d * AT_VROW + ch * 16); p[0] = ((u64)vv[i].y << 32) | vv[i].x; p[1] = ((u64)vv[i].w << 32) | vv[i].z; } }
        LDS_WAIT(); __syncthreads();
        f32x16 s[5];
#pragma unroll
        for (int kt = 0; kt < 5; ++kt) {
            if (kt + qsub >= jt0) {
                const LAS unsigned char* kp = lds + (32 * (kt + qsub) + r32) * AT_KROW + 64 * hi;
                f32x16 acc = {0.f, 0.f, 0.f, 0.f, 0.f, 0.f, 0.f, 0.f, 0.f, 0.f, 0.f, 0.f, 0.f, 0.f, 0.f, 0.f};
#pragma unroll
                for (int kk = 0; kk < 4; ++kk) acc = __builtin_amdgcn_mfma_f32_32x32x16_bf16(*(const LAS bf16x8*)(kp + 16 * kk), qf[kk], acc, 0, 0, 0);
                s[kt] = acc;
            } else {
#pragma unroll
                for (int r = 0; r < 16; ++r) s[kt][r] = NEG;
            }
        }
#pragma unroll
        for (int r = 0; r < 16; ++r) { const int cr = crow(r, hi); if (!(cr > r32)) s[0][r] = NEG; if (!(cr <= r32)) s[4][r] = NEG; }
        const float sk = sinks[h] * 1.4426950408889634f;
        float mx = sk;
#pragma unroll
        for (int kt = 0; kt < 5; ++kt)
#pragma unroll
            for (int r = 0; r < 16; ++r) mx = fmaxf(mx, s[kt][r]);
        mx = fmaxf(mx, __shfl_xor(mx, 32));
        float l = 0.f;
#pragma unroll
        for (int kt = 0; kt < 5; ++kt)
#pragma unroll
            for (int r = 0; r < 16; ++r) { const float p = __builtin_amdgcn_exp2f(s[kt][r] - mx); s[kt][r] = p; l += p; }
        l += __shfl_xor(l, 32);
        l += __builtin_amdgcn_exp2f(sk - mx);
        const float inv = 1.0f / l;
        f32x16 o[2];
#pragma unroll
        for (int d = 0; d < 2; ++d)
#pragma unroll
            for (int r = 0; r < 16; ++r) o[d][r] = 0.f;
#pragma unroll
        for (int kt = 0; kt < 5; ++kt) {
            if (kt + qsub >= jt0) {
#pragma unroll
                for (int s2 = 0; s2 < 2; ++s2) {
                    v4u pw; pw.x = cvt_pk_bf16(s[kt][8 * s2 + 0] * inv, s[kt][8 * s2 + 1] * inv); pw.y = cvt_pk_bf16(s[kt][8 * s2 + 2] * inv, s[kt][8 * s2 + 3] * inv);
                    pw.z = cvt_pk_bf16(s[kt][8 * s2 + 4] * inv, s[kt][8 * s2 + 5] * inv); pw.w = cvt_pk_bf16(s[kt][8 * s2 + 6] * inv, s[kt][8 * s2 + 7] * inv);
                    const bf16x8 pf = __builtin_bit_cast(bf16x8, pw);
#pragma unroll
                    for (int dh = 0; dh < 2; ++dh) {
                        const LAS u64* vp = (const LAS u64*)(lds + AT_V_OFF + (dh * 32 + r32) * AT_VROW + (32 * (kt + qsub) + 16 * s2 + 4 * hi) * 2);
                        const u64 lo = vp[0], hi8 = vp[2];
                        const v4u vw = (v4u){(unsigned)lo, (unsigned)(lo >> 32), (unsigned)hi8, (unsigned)(hi8 >> 32)};
                        o[dh] = __builtin_amdgcn_mfma_f32_32x32x16_bf16(__builtin_bit_cast(bf16x8, vw), pf, o[dh], 0, 0, 0);
                    }
                }
            }
        }
        {
            float ssq = 0.f;
#pragma unroll
            for (int dh = 0; dh < 2; ++dh)
#pragma unroll
                for (int r = 0; r < 16; ++r) ssq += o[dh][r] * o[dh][r];
            ssq += __shfl_xor(ssq, 32);
            if (hi == 0) (void)__hip_atomic_fetch_add(st + tok0 + q0 + 32 * qsub + r32, ssq, __ATOMIC_RELAXED, __HIP_MEMORY_SCOPE_AGENT);
        }
        bf16* orow = AO + (tok0 + q0 + 32 * qsub + r32) * (size_t)ldo + h * HD + 4 * hi;
#pragma unroll
        for (int dh = 0; dh < 2; ++dh)
#pragma unroll
            for (int g4 = 0; g4 < 4; ++g4) { v2u w; w.x = cvt_pk_bf16(o[dh][4 * g4], o[dh][4 * g4 + 1]); w.y = cvt_pk_bf16(o[dh][4 * g4 + 2], o[dh][4 * g4 + 3]);
                *(v2u*)(orow + dh * 32 + 8 * g4) = w; }
        LDS_WAIT(); __syncthreads();
    }
}

__global__ void __launch_bounds__(NWAVES * 64, 2) hymba_fwd(Args a) {
    extern __shared__ __attribute__((aligned(16))) unsigned char lds_raw[];
    LAS unsigned char* lds = (LAS unsigned char*)lds_raw;
    volatile LAS unsigned* MISC = (volatile LAS unsigned*)(lds + MISC_OFF);
    const int tid = threadIdx.x;
    const int G = gridDim.x; const int bx = blockIdx.x; const int vcu = (G % 8 == 0) ? (bx % 8) * (G / 8) + bx / 8 : bx;
    unsigned char* ws = a.ws;
    unsigned* ctl = (unsigned*)(ws + WS_CTL);
    for (int u = tid; u < (LDS_BYTES - LDSCTL_OFF) / 4; u += NWAVES * 64) ((LAS unsigned*)(lds + LDSCTL_OFF))[u] = 0u;
    __syncthreads();
    XcdBarrier bar = xcd_barrier_post(ctl + CW_BAR, MISC + 8);
#define GRID_BAR() xcd_barrier(bar)
    const int team_pm = 8 * (bx & 7) + ((bx >> 3) & 7), team_k = bx >> 6;
    unsigned team_epoch = 1u;
#define TEAM_BAR() team_barrier(ctl + CW_TEAM + 64 * team_pm, ctl + CW_BAR + XB_TMO, team_epoch, MISC + 12)
    if (tid == 0) __hip_atomic_store(ctl + CW_TEAM + 64 * team_pm + 8 + team_k, 0x100u | bar.x, __ATOMIC_RELAXED, __HIP_MEMORY_SCOPE_AGENT);
    const int NGW = G * NWAVES;
#define PHASE_IDS() int tid_l = threadIdx.x; asm volatile("" : "+v"(tid_l)); const int lane = tid_l & 63, wave = __builtin_amdgcn_readfirstlane(tid_l >> 6), gw = vcu * NWAVES + wave; (void)lane; (void)gw
    bf16* Win_t = (bf16*)(ws + WS_WIN); bf16* Wglu_t = (bf16*)(ws + WS_WGLU); bf16* Wo_t = (bf16*)(ws + WS_WO); bf16* Wgu_t = (bf16*)(ws + WS_WGU); bf16* Wd_t = (bf16*)(ws + WS_WD);
    bf16* R1 = (bf16*)(ws + WS_R1); bf16* Qp = (bf16*)(ws + WS_Q); bf16* Kp = (bf16*)(ws + WS_K); bf16* Vt = (bf16*)(ws + WS_VT); bf16* MIX = (bf16*)(ws + WS_R2);
    bf16* A2 = (bf16*)(ws + WS_A2); float* Zst = (float*)(ws + WS_ZS); bf16* Zb = (bf16*)(ws + WS_Z); bf16* A3 = (bf16*)(ws + WS_A3); float* stat_a = (float*)(ctl + CW_STAT_A); float* stat_s = (float*)(ctl + CW_STAT_S); bf16* HID = (bf16*)(ws + WS_HID);

    {
        PHASE_IDS();
        if (bx < NG) ssm_precompute(a, bx, lds, tid_l);
        else {
            LAS float* scr = (LAS float*)(lds + wave * 16384);
            constexpr int I_IN = (DM / 64) * (D_IN / 32), I_GLU = (D_SSM / 64) * (D_SSM / 32), I_O = (DM / 64) * (DM / 32);
            constexpr int NITEMS = I_IN;
#define EARLY_DESC(D, IT) do { D = TrDesc{a.w_in, Win_t, a.g_pre_mix, DM, D_IN, MAP_WIN, (IT)}; } while (0)
            TrDesc dc, dn; TrRegs tc, tn;
            const int NCW = (G - NG) * NWAVES; int it = (bx - NG) * NWAVES + wave;
            if (it < NITEMS) { EARLY_DESC(dc, it); tr_load(dc, lane, tc); }
            while (it < NITEMS) {
                const int nx = it + NCW; const bool more = nx < NITEMS;
                if (more) { EARLY_DESC(dn, nx); tr_load(dn, lane, tn); }
                tr_finish(dc, tc, scr, lane);
                if (more) { dc = dn; tc = tn; }
                it = nx;
            }
#undef EARLY_DESC
        }
        for (int m = gw; m < M; m += 2 * NGW) {
            f32x4 v[2][8]; float s[2];
#pragma unroll
            for (int q = 0; q < 2; ++q) { const f32x4* xr = (const f32x4*)(a.x + (size_t)(m + q * NGW) * DM);
#pragma unroll
                for (int j = 0; j < 4; ++j) { v[q][2 * j] = xr[128 * j + 2 * lane]; v[q][2 * j + 1] = xr[128 * j + 2 * lane + 1]; } }
#pragma unroll
            for (int q = 0; q < 2; ++q) { float t = 0.f;
#pragma unroll
                for (int j = 0; j < 8; ++j) t += (v[q][j].x * v[q][j].x + v[q][j].y * v[q][j].y) + (v[q][j].z * v[q][j].z + v[q][j].w * v[q][j].w);
                s[q] = t; }
#pragma unroll
            for (int q = 0; q < 2; ++q) { const int mm = m + q * NGW;
                const float ms = wave_sum(s[q]) * (1.0f / DM) + RMS_EPS; const float r = 1.0f / sqrtf(ms);
                if (lane == 0) ((float*)(ws + WS_RX))[mm] = sqrtf(ms);
                v4u* o = (v4u*)(R1 + (size_t)mm * DM);
#pragma unroll
                for (int j = 0; j < 4; ++j) { v4u w; w.x = cvt_pk_bf16(v[q][2 * j].x * r, v[q][2 * j].y * r); w.y = cvt_pk_bf16(v[q][2 * j].z * r, v[q][2 * j].w * r);
                    w.z = cvt_pk_bf16(v[q][2 * j + 1].x * r, v[q][2 * j + 1].y * r); w.w = cvt_pk_bf16(v[q][2 * j + 1].z * r, v[q][2 * j + 1].w * r); o[64 * j + lane] = w; } }
        }
    }
    GRID_BAR();

    {
        PHASE_IDS();
        pg8::Gemm g{R1, Win_t, DM, DM, DM}; pg8::StaticOrder S; S.init(M, 2304, G, bx);
        LAS int* posl = (LAS int*)(lds + LDSCTL_OFF + 1024);
        if (tid_l < 256) posl[tid_l] = a.pos[team_pm * 256 + tid_l];
        LDS_WAIT(); __syncthreads();
        pg8::EpiQKU E{Qp, Kp, A2, posl};
        pg8::gemm_phase<pg8::EpiQKU, pg8::StaticOrder, true>(lds, g, S, E);
        pg8::Gemm g2{Win_t + (size_t)2304 * DM, R1, DM, DM, DM}; pg8::StaticOrder S2; S2.init(256, M, G, (bx + 192) % G);
        pg8::EpiBf16P E2{Vt, M};
        pg8::gemm_phase<pg8::EpiBf16P, pg8::StaticOrder, true>(lds, g2, S2, E2);
        {
            int tid_c = threadIdx.x; asm volatile("" : "+v"(tid_c)); const int lane = tid_c & 63, wave = __builtin_amdgcn_readfirstlane(tid_c >> 6);
            LAS float* scr = (LAS float*)(lds + wave * 16384);
            constexpr int I_G = (DM / 64) * (D_FF / 32), I_D = (D_FF / 64) * (DM / 32);
            const int cw = (bx & (G / 2 - 1)) * NWAVES + wave, NCW = (G / 2) * NWAVES;
            constexpr int I_GLU = (D_SSM / 64) * (D_SSM / 32), I_O = (DM / 64) * (DM / 32);
            constexpr int NIT = I_GLU + I_O + 2 * I_G + I_D;
#define FFN_DESC(D, IT) do { int r_ = (IT); if (r_ < I_GLU) { D = TrDesc{a.w_glu, Wglu_t, nullptr, D_SSM, D_SSM, MAP_PLAIN, r_}; } \
                else if (r_ < I_GLU + I_O) { r_ -= I_GLU; D = TrDesc{a.w_o, Wo_t, (r_ / (DM / 32) < 16) ? a.g_attn_out : (a.g_ssm_out - 1024), DM, DM, MAP_PLAIN, r_}; } \
                else if ((r_ -= I_GLU + I_O) < I_G) { D = TrDesc{a.w_gate, Wgu_t, a.g_pre_ffn, DM, D_FF, MAP_GATE, r_}; } else if (r_ < 2 * I_G) { D = TrDesc{a.w_up, Wgu_t, a.g_pre_ffn, DM, D_FF, MAP_UP, r_ - I_G}; } \
                else { D = TrDesc{a.w_down, Wd_t, nullptr, D_FF, DM, MAP_PLAIN, r_ - 2 * I_G}; } } while (0)
            TrDesc dc, dn; TrRegs tc, tn;
            const int it_hi = (bx >= G / 2) ? NIT : (bx < G / 4 ? 1536 : (I_GLU + I_O));
            int it = (bx >= G / 2) ? (I_GLU + I_O) + cw : (bx < G / 4 ? cw : 1536 + (cw - 512));
            const int NCWx = (bx >= G / 2) ? NCW : 512;
            if (it < it_hi) { FFN_DESC(dc, it); tr_load(dc, lane, tc); }
            while (it < it_hi) {
                const int nx = it + NCWx; const bool more = nx < it_hi;
                if (more) { FFN_DESC(dn, nx); tr_load(dn, lane, tn); }
                tr_finish(dc, tc, scr, lane);
                if (more) { dc = dn; tc = tn; }
                it = nx;
            }
#undef FFN_DESC
        }
    }
    GRID_BAR();

    {
        PHASE_IDS();
        {
            pg8::Gemm g{A2, (const bf16*)(ws + WS_BZ), A2LD, 256, 256}; pg8::DiagOrder S{G, bx, 256};
            pg8::EpiZ E{Zst};
            pg8::gemm_phase<pg8::EpiZ, pg8::DiagOrder, true>(lds, g, S, E);
        }
        asm volatile("s_waitcnt vmcnt(0)" ::: "memory"); __syncthreads();
        {
            typedef float f32x2v __attribute__((ext_vector_type(2)));
            const int seq = wave >> 2, seg = wave & 3, g = bx >> 2, b = 2 * (bx & 3) + seq;
            const float lr = ((const float*)(ws + WS_LAM))[(g * 64 + lane) * 2], li = ((const float*)(ws + WS_LAM))[(g * 64 + lane) * 2 + 1];
            const size_t row0 = (size_t)g * 1024 + b * 128 + 32 * seg;
            const f32x2v* zp = (const f32x2v*)Zst + row0 * 64 + lane;
            f32x2v zz[32];
#pragma unroll
            for (int i = 0; i < 32; ++i) zz[i] = zp[(size_t)i * 64];
            float tr = 0.f, ti = 0.f;
#pragma unroll
            for (int i = 0; i < 32; ++i) { const float nr = lr * tr - li * ti + zz[i].x, ni = lr * ti + li * tr + zz[i].y; tr = nr; ti = ni; }
            float pr = lr, pi = li;
#pragma unroll
            for (int q = 0; q < 5; ++q) { const float nr = pr * pr - pi * pi, ni = 2.f * pr * pi; pr = nr; pi = ni; }
            LAS f32x2v* X = (LAS f32x2v*)lds;
            X[wave * 64 + lane] = (f32x2v){tr, ti};
            LDS_WAIT(); __syncthreads();
            float sr = 0.f, si = 0.f;
            for (int s = 0; s < seg; ++s) { const f32x2v t = X[(seq * 4 + s) * 64 + lane]; const float nr = pr * sr - pi * si + t.x, ni = pr * si + pi * sr + t.y; sr = nr; si = ni; }
            unsigned* sp = (unsigned*)(A2 + row0 * A2LD + 256) + lane;
#pragma unroll
            for (int i = 0; i < 32; ++i) {
                sp[(size_t)i * (A2LD / 2)] = cvt_pk_bf16(sr, si);
                const float nr = lr * sr - li * si + zz[i].x, ni = lr * si + li * sr + zz[i].y; sr = nr; si = ni;
            }
        }
        asm volatile("s_waitcnt vmcnt(0)" ::: "memory"); __syncthreads();
        {
            pg8::Gemm g{A2, (const bf16*)(ws + WS_TC), A2LD, A2LD, A2LD}; pg8::DiagOrder S{G, bx, 256};
            pg8::EpiY E{Zb};
            pg8::gemm_phase<pg8::EpiY, pg8::DiagOrder, true>(lds, g, S, E);
        }
        attn_phase(lds, vcu, G, Qp, Kp, Vt, a.sinks, A3, DM, stat_a);
    }
    GRID_BAR();

    if (tid == 0) { unsigned same = 1u; const unsigned me = 0x100u | bar.x;
        for (int k = 0; k < 4; ++k) same &= (xb_ld(ctl + CW_TEAM + 64 * team_pm + 8 + k) == me) ? 1u : 0u;
        MISC[12] = same; }
    __syncthreads();
    {
        PHASE_IDS();
        pg8::Gemm g{Zb, Wglu_t, D_SSM, D_SSM, D_SSM}; pg8::StaticOrder S; S.init(M, D_SSM, G, bx);
        pg8::EpiGlu E{Zb, a.b_glu, A3 + D_ATTN, DM, stat_s};
        pg8::gemm_phase<pg8::EpiGlu, pg8::StaticOrder, true>(lds, g, S, E);
    }
    TEAM_BAR();

    {
        PHASE_IDS();
        pg8::Gemm g{A3, Wo_t, DM, DM, DM}; pg8::StaticOrder S; S.init(M, DM, G, bx);
        LAS float* ratl = (LAS float*)(lds + LDSCTL_OFF + 2048); LAS float* rsl = ratl + 256;
        if (tid_l < 256) { const int row = team_pm * 256 + tid_l;
            const float sa = __uint_as_float(__hip_atomic_load((const unsigned*)(stat_a + row), __ATOMIC_RELAXED, __HIP_MEMORY_SCOPE_AGENT)), ss = __uint_as_float(__hip_atomic_load((const unsigned*)(stat_s + row), __ATOMIC_RELAXED, __HIP_MEMORY_SCOPE_AGENT));
            const float ra = 1.0f / sqrtf(sa * (1.0f / 1024.0f) + RMS_EPS), rsi = sqrtf(ss * (1.0f / 1024.0f) + RMS_EPS);
            ratl[tid_l] = ra * rsi; rsl[tid_l] = 1.0f / rsi; }
        LDS_WAIT(); __syncthreads();
        pg8::EpiMix E{MIX, DM, ratl, rsl};
        pg8::gemm_phase<pg8::EpiMix, pg8::StaticOrder, true>(lds, g, S, E);
    }
    TEAM_BAR();

    {
        PHASE_IDS();
        float* RH = (float*)(ws + WS_RH); const float* RX = (const float*)(ws + WS_RX);
        f32x4 gq[8];
#pragma unroll
        for (int j = 0; j < 4; ++j) { gq[2 * j] = ((const f32x4*)a.g_post_mix)[128 * j + 2 * lane]; gq[2 * j + 1] = ((const f32x4*)a.g_post_mix)[128 * j + 2 * lane + 1]; }
        for (int it = 0; it < 4; ++it) { const int mb = team_pm * 256 + team_k * 64 + wave * 8 + it * 2;
            v4u mv[2][4], xv[2][4]; float rxi[2], sm[2];
#pragma unroll
            for (int q = 0; q < 2; ++q) { const v4u* mr = (const v4u*)(MIX + (size_t)(mb + q) * DM); const v4u* xr = (const v4u*)(R1 + (size_t)(mb + q) * DM); rxi[q] = RX[mb + q];
#pragma unroll
                for (int j = 0; j < 4; ++j) { mv[q][j] = mr[64 * j + lane]; xv[q][j] = xr[64 * j + lane]; } }
#pragma unroll
            for (int q = 0; q < 2; ++q) { float t = 0.f;
#pragma unroll
                for (int j = 0; j < 4; ++j)
#pragma unroll
                    for (int e = 0; e < 4; ++e) { const float m0 = bf_lo(mv[q][j][e]), m1 = bf_hi(mv[q][j][e]); t += m0 * m0 + m1 * m1; }
                sm[q] = t; }
#pragma unroll
            for (int q = 0; q < 2; ++q) {
                const float rm = 1.0f / sqrtf(wave_sum(sm[q]) * (1.0f / DM) + RMS_EPS), rx = rxi[q];
                float sh = 0.f; v4u* xo = (v4u*)(R1 + (size_t)(mb + q) * DM); f32x4 hq[8];
#pragma unroll
                for (int j = 0; j < 4; ++j) {
                    const f32x4 g0 = gq[2 * j], g1 = gq[2 * j + 1]; const v4u mj = mv[q][j], xj = xv[q][j];
                    f32x4 h0, h1;
                    h0.x = bf_lo(xj.x) * rx + bf_lo(mj.x) * rm * g0.x; h0.y = bf_hi(xj.x) * rx + bf_hi(mj.x) * rm * g0.y; h0.z = bf_lo(xj.y) * rx + bf_lo(mj.y) * rm * g0.z; h0.w = bf_hi(xj.y) * rx + bf_hi(mj.y) * rm * g0.w;
                    h1.x = bf_lo(xj.z) * rx + bf_lo(mj.z) * rm * g1.x; h1.y = bf_hi(xj.z) * rx + bf_hi(mj.z) * rm * g1.y; h1.z = bf_lo(xj.w) * rx + bf_lo(mj.w) * rm * g1.z; h1.w = bf_hi(xj.w) * rx + bf_hi(mj.w) * rm * g1.w;
                    sh += (h0.x * h0.x + h0.y * h0.y) + (h0.z * h0.z + h0.w * h0.w) + (h1.x * h1.x + h1.y * h1.y) + (h1.z * h1.z + h1.w * h1.w);
                    hq[2 * j] = h0; hq[2 * j + 1] = h1;
                }
                const float msh = wave_sum(sh) * (1.0f / DM) + RMS_EPS, rh = 1.0f / sqrtf(msh);
                if (lane == 0) RH[mb + q] = sqrtf(msh);
#pragma unroll
                for (int j = 0; j < 4; ++j) { const f32x4 h0 = hq[2 * j] * rh, h1 = hq[2 * j + 1] * rh;
                    v4u w; w.x = cvt_pk_bf16(h0.x, h0.y); w.y = cvt_pk_bf16(h0.z, h0.w); w.z = cvt_pk_bf16(h1.x, h1.y); w.w = cvt_pk_bf16(h1.z, h1.w); xo[64 * j + lane] = w; }
            }
        }
    }
    TEAM_BAR();

    {
        PHASE_IDS();
        pg8::Gemm g{R1, Wgu_t, DM, DM, DM}; pg8::StaticOrder S; S.init(M, 2 * D_FF, G, bx);
        pg8::EpiSwiGLU E{HID, D_FF, (const float*)(ws + WS_RH)};
        pg8::gemm_phase<pg8::EpiSwiGLU, pg8::StaticOrder, true>(lds, g, S, E);
    }
    TEAM_BAR();

    {
        PHASE_IDS();
        pg8::Gemm g{HID, Wd_t, D_FF, D_FF, D_FF}; pg8::StaticOrder S; S.init(M, DM, G, bx);
        pg8::EpiBf16P E{MIX, DM};
        pg8::gemm_phase<pg8::EpiBf16P, pg8::StaticOrder, true>(lds, g, S, E);
    }
    TEAM_BAR();

    {
        PHASE_IDS();
        f32x4 gq[8];
#pragma unroll
        for (int j = 0; j < 4; ++j) { gq[2 * j] = ((const f32x4*)a.g_post_ffn)[128 * j + 2 * lane]; gq[2 * j + 1] = ((const f32x4*)a.g_post_ffn)[128 * j + 2 * lane + 1]; }
        for (int it = 0; it < 4; ++it) { const int mb = team_pm * 256 + team_k * 64 + wave * 8 + it * 2;
            v4u fv[2][4], hv[2][4]; float sf[2], rhi[2];
#pragma unroll
            for (int q = 0; q < 2; ++q) { const v4u* fr = (const v4u*)(MIX + (size_t)(mb + q) * DM); const v4u* hr = (const v4u*)(R1 + (size_t)(mb + q) * DM); rhi[q] = ((const float*)(ws + WS_RH))[mb + q];
#pragma unroll
                for (int j = 0; j < 4; ++j) { fv[q][j] = fr[64 * j + lane]; hv[q][j] = hr[64 * j + lane]; } }
#pragma unroll
            for (int q = 0; q < 2; ++q) { float t = 0.f;
#pragma unroll
                for (int j = 0; j < 4; ++j)
#pragma unroll
                    for (int e = 0; e < 4; ++e) { const float f0 = bf_lo(fv[q][j][e]), f1 = bf_hi(fv[q][j][e]); t += f0 * f0 + f1 * f1; }
                sf[q] = t; }
#pragma unroll
            for (int q = 0; q < 2; ++q) {
                const float rf = 1.0f / sqrtf(wave_sum(sf[q]) * (1.0f / DM) + RMS_EPS), rx = rhi[q]; f32x4* ho = (f32x4*)(a.out + (size_t)(mb + q) * DM);
#pragma unroll
                for (int j = 0; j < 4; ++j) {
                    const f32x4 g0 = gq[2 * j], g1 = gq[2 * j + 1]; const v4u fj = fv[q][j], hj = hv[q][j]; f32x4 h0, h1;
                    h0.x = bf_lo(hj.x) * rx + bf_lo(fj.x) * rf * g0.x; h0.y = bf_hi(hj.x) * rx + bf_hi(fj.x) * rf * g0.y; h0.z = bf_lo(hj.y) * rx + bf_lo(fj.y) * rf * g0.z; h0.w = bf_hi(hj.y) * rx + bf_hi(fj.y) * rf * g0.w;
                    h1.x = bf_lo(hj.z) * rx + bf_lo(fj.z) * rf * g1.x; h1.y = bf_hi(hj.z) * rx + bf_hi(fj.z) * rf * g1.y; h1.z = bf_lo(hj.w) * rx + bf_lo(fj.w) * rf * g1.z; h1.w = bf_hi(hj.w) * rx + bf_hi(fj.w) * rf * g1.w;
                    ho[128 * j + 2 * lane] = h0; ho[128 * j + 2 * lane + 1] = h1;
                }
            }
        }
    }
}

extern "C" void kernel_launch(void* const* d_in, const int* in_sizes, int n_in, void* d_out, int out_size, void* d_ws, size_t ws_size, hipStream_t stream) {
    static int grid = 0;
    if (grid == 0) {
        if (n_in != 24 || in_sizes[0] != M * DM || out_size != M * DM || ws_size < WS_END) { fprintf(stderr, "kernel_launch: unexpected shapes (n_in %d, in0 %d, out %d, ws %zu)\n", n_in, n_in > 0 ? in_sizes[0] : -1, out_size, ws_size); grid = -1; return; }
        int dev = 0, cus = 0;
        if (hipGetDevice(&dev) != hipSuccess || hipDeviceGetAttribute(&cus, hipDeviceAttributeMultiprocessorCount, dev) != hipSuccess) { grid = -1; return; }
        if (hipFuncSetAttribute((const void*)hymba_fwd, hipFuncAttributeMaxDynamicSharedMemorySize, LDS_BYTES) != hipSuccess) { fprintf(stderr, "kernel_launch: hipFuncSetAttribute failed\n"); grid = -1; return; }
        int per_cu = 0;
        (void)hipOccupancyMaxActiveBlocksPerMultiprocessor(&per_cu, (const void*)hymba_fwd, NWAVES * 64, LDS_BYTES);
        (void)hipGetLastError();
        grid = cus;
        if (grid != 256) { fprintf(stderr, "kernel_launch: built for a 256-CU device (team structure, SSM unit map); found %d CUs\n", cus); grid = -1; return; }
    }
    if (grid < 0) return;
    (void)hipMemsetAsync((char*)d_ws + WS_CTL, 0, CTL_ZERO_BYTES, stream);
    Args a{};
    a.x = (const float*)d_in[0]; a.pos = (const int*)d_in[1]; a.g_pre_mix = (const float*)d_in[2]; a.w_in = (const float*)d_in[3]; a.sinks = (const float*)d_in[4];
    a.a_re = (const float*)d_in[5]; a.a_im = (const float*)d_in[6]; a.log_dt = (const float*)d_in[7]; a.b_re = (const float*)d_in[8]; a.b_im = (const float*)d_in[9];
    a.c_re = (const float*)d_in[10]; a.c_im = (const float*)d_in[11]; a.d_skip = (const float*)d_in[12]; a.w_glu = (const float*)d_in[13]; a.b_glu = (const float*)d_in[14];
    a.g_attn_out = (const float*)d_in[15]; a.g_ssm_out = (const float*)d_in[16]; a.w_o = (const float*)d_in[17]; a.g_post_mix = (const float*)d_in[18]; a.g_pre_ffn = (const float*)d_in[19];
    a.w_gate = (const float*)d_in[20]; a.w_up = (const float*)d_in[21]; a.w_down = (const float*)d_in[22]; a.g_post_ffn = (const float*)d_in[23];
    a.out = (float*)d_out; a.ws = (unsigned char*)d_ws;
    hipLaunchKernelGGL(hymba_fwd, dim3(grid), dim3(NWAVES * 64), LDS_BYTES, stream, a);
}
```

```cpp
#include <hip/hip_runtime.h>
#include <cstdio>
#include <cstdint>

namespace pg8 {
#define PG8_LAS __attribute__((address_space(3)))
typedef unsigned short bf16_t;
typedef short bf16x8 __attribute__((ext_vector_type(8)));
typedef float f32x4 __attribute__((ext_vector_type(4)));
typedef unsigned u32x4 __attribute__((ext_vector_type(4)));
constexpr int BM = 256, BK = 64, HALF = 128, HTB = HALF * BK * 2, STAGE_BYTES = 8 * HTB, NXCD = 8, WGM = 8;

__host__ __device__ __forceinline__ int lds_byte(int r, int c) { const int st = (r >> 4) * 2 + (c >> 5), rr = r & 15, cc = c & 31, ob = rr * 64 + cc * 2; return st * 1024 + (ob ^ (((ob >> 9) & 1) << 5)); }
__host__ __device__ __forceinline__ void stage_rc(int b, int& R, int& C) { const int st = b / 1024, sb = b % 1024, swz = sb ^ (((sb >> 9) & 1) << 5); R = (st >> 1) * 16 + swz / 64; C = (st & 1) * 32 + (swz % 64) / 2; }
__host__ __device__ __forceinline__ int perm32(int rho) { const int n = rho >> 4, i = rho & 15; return 8 * (i >> 2) + 4 * n + (i & 3); }

struct Unit { int pm, pn; };
struct Gemm { const bf16_t* A; const bf16_t* Bt; int lda, ldb, K; };

struct StaticOrder {
    int nM, nN, nwg, G, c;
    __host__ __device__ void init(int M, int N, int G_, int c_) { nM = M / BM; nN = N / BM; nwg = nM * nN; G = G_; c = c_; }
    __host__ __device__ bool next(int i, Unit& u) const {
        const long L = (long)i * G + c; if (L >= nwg) return false;
        int wgid = (int)L; { const int q = nwg / NXCD, r = nwg % NXCD, xcd = wgid % NXCD, off = wgid / NXCD; wgid = (xcd < r ? xcd * (q + 1) : r * (q + 1) + (xcd - r) * q) + off; }
        const int nig = WGM * nN, gid = wgid / nig, fm = gid * WGM, gsz = (nM - fm) < WGM ? (nM - fm) : WGM;
        u.pm = fm + ((wgid % nig) % gsz); u.pn = (wgid % nig) / gsz; return true;
    }
};
struct DiagOrder {
    int G, c, n;
    __host__ __device__ bool next(int i, Unit& u) const { const int L = i * G + c; if (L >= n) return false; u.pm = L; u.pn = L >> 2; return true; }
};

__device__ __forceinline__ unsigned cvt_pk_bf16(float lo, float hi) { unsigned r; asm volatile("v_cvt_pk_bf16_f32 %0, %1, %2" : "=v"(r) : "v"(lo), "v"(hi)); return r; }
__device__ __forceinline__ float bf_lo(unsigned w) { return __uint_as_float(w << 16); }
__device__ __forceinline__ float bf_hi(unsigned w) { return __uint_as_float(w & 0xffff0000u); }
__device__ __forceinline__ float sigmoidf_(float x) { return __builtin_amdgcn_rcpf(1.0f + __builtin_amdgcn_exp2f(-1.4426950408889634f * x)); }
__device__ __forceinline__ float gelu_tanh(float x) { const float u = 1.5957691216057308f * (x + 0.044715f * x * x * x); return x * sigmoidf_(u); }

constexpr float ATT_C2 = 0.125f * 1.4426950408889634f;

struct EpiBf16P {
    static constexpr bool PERM = true, MIDK = false;
    bf16_t* O; int ldc;
    __device__ __forceinline__ void operator()(const f32x4 (&acc)[2][2][4][2], const Unit& u, int wr, int wc, int fr, int fq) const {
        const int row0 = u.pm * BM + wr * 64 + fr, col0 = u.pn * BM + wc * 32 + 8 * fq;
#pragma unroll
        for (int ai = 0; ai < 2; ++ai)
#pragma unroll
            for (int m = 0; m < 4; ++m) { bf16_t* rowp = O + (size_t)(row0 + ai * HALF + m * 16) * ldc + col0;
#pragma unroll
                for (int bj = 0; bj < 2; ++bj) { const f32x4 v0 = acc[ai][bj][m][0], v1 = acc[ai][bj][m][1];
                    u32x4 w; w.x = cvt_pk_bf16(v0[0], v0[1]); w.y = cvt_pk_bf16(v0[2], v0[3]); w.z = cvt_pk_bf16(v1[0], v1[1]); w.w = cvt_pk_bf16(v1[2], v1[3]);
                    *(u32x4*)(rowp + bj * HALF) = w; } }
    }
};
struct EpiMix {
    static constexpr bool PERM = true, MIDK = true;
    bf16_t* O; int ldc; const PG8_LAS float* ratio; const PG8_LAS float* rsl;
    __device__ __forceinline__ void midk(f32x4 (&acc)[2][2][4][2], const Unit& u, int wr, int fr) const {
#pragma unroll
        for (int ai = 0; ai < 2; ++ai)
#pragma unroll
            for (int m = 0; m < 4; ++m) { const float rt = ratio[wr * 64 + fr + ai * HALF + m * 16];
#pragma unroll
                for (int bj = 0; bj < 2; ++bj)
#pragma unroll
                    for (int n = 0; n < 2; ++n) acc[ai][bj][m][n] *= rt; }
    }
    __device__ __forceinline__ void operator()(const f32x4 (&acc)[2][2][4][2], const Unit& u, int wr, int wc, int fr, int fq) const {
        const int row0 = u.pm * BM + wr * 64 + fr, col0 = u.pn * BM + wc * 32 + 8 * fq;
#pragma unroll
        for (int ai = 0; ai < 2; ++ai)
#pragma unroll
            for (int m = 0; m < 4; ++m) { const int row = row0 + ai * HALF + m * 16; bf16_t* rowp = O + (size_t)row * ldc + col0;
                const float rs = rsl[wr * 64 + fr + ai * HALF + m * 16];
#pragma unroll
                for (int bj = 0; bj < 2; ++bj) { const f32x4 v0 = acc[ai][bj][m][0] * rs, v1 = acc[ai][bj][m][1] * rs;
                    u32x4 w; w.x = cvt_pk_bf16(v0[0], v0[1]); w.y = cvt_pk_bf16(v0[2], v0[3]); w.z = cvt_pk_bf16(v1[0], v1[1]); w.w = cvt_pk_bf16(v1[2], v1[3]);
                    *(u32x4*)(rowp + bj * HALF) = w; } }
    }
};
struct EpiQKU {
    static constexpr bool PERM = true, MIDK = false;
    bf16_t* Q; bf16_t* Kp; bf16_t* A2; const PG8_LAS int* posl;
    __device__ __forceinline__ void operator()(const f32x4 (&acc)[2][2][4][2], const Unit& u, int wr, int wc, int fr, int fq) const {
        const int row0 = u.pm * BM + wr * 64 + fr, cw = wc * 32 + 8 * fq;
        if (u.pn < 5) {
            const bool isq = u.pn < 4; const float sc = isq ? ATT_C2 : 1.0f;
            const int i0 = (cw & 63) >> 1;
            float invf[4];
#pragma unroll
            for (int t = 0; t < 4; ++t) invf[t] = __builtin_amdgcn_exp2f(-(float)(i0 + t) * (13.287712379549449f / 32.0f));
            bf16_t* base = isq ? (Q + u.pn * 256) : Kp; const int ld = isq ? 1024 : 256;
#pragma unroll
            for (int ai = 0; ai < 2; ++ai)
#pragma unroll
                for (int m = 0; m < 4; ++m) { const int row = row0 + ai * HALF + m * 16; const float p = (float)posl[wr * 64 + fr + ai * HALF + m * 16];
                    float cs[4], sn[4];
#pragma unroll
                    for (int t = 0; t < 4; ++t) { const float ang = p * invf[t]; const float fr_ = __builtin_amdgcn_fractf(ang * 0.15915494309189535f); sn[t] = __builtin_amdgcn_sinf(fr_) * sc; cs[t] = __builtin_amdgcn_cosf(fr_) * sc; }
#pragma unroll
                    for (int bj = 0; bj < 2; ++bj) { const f32x4 v0 = acc[ai][bj][m][0], v1 = acc[ai][bj][m][1];
                        u32x4 w;
                        w.x = cvt_pk_bf16(v0[0] * cs[0] - v0[1] * sn[0], v0[1] * cs[0] + v0[0] * sn[0]);
                        w.y = cvt_pk_bf16(v0[2] * cs[1] - v0[3] * sn[1], v0[3] * cs[1] + v0[2] * sn[1]);
                        w.z = cvt_pk_bf16(v1[0] * cs[2] - v1[1] * sn[2], v1[1] * cs[2] + v1[0] * sn[2]);
                        w.w = cvt_pk_bf16(v1[2] * cs[3] - v1[3] * sn[3], v1[3] * cs[3] + v1[2] * sn[3]);
                        *(u32x4*)(base + (size_t)row * ld + bj * HALF + cw) = w; } }
        } else {
#pragma unroll
            for (int ai = 0; ai < 2; ++ai)
#pragma unroll
                for (int m = 0; m < 4; ++m) { const int row = row0 + ai * HALF + m * 16;
#pragma unroll
                    for (int bj = 0; bj < 2; ++bj) { const f32x4 v0 = acc[ai][bj][m][0], v1 = acc[ai][bj][m][1];
                        const int gcol = (u.pn - 5) * 256 + bj * HALF + cw, g = gcol >> 4, q0 = gcol & 15;
                        u32x4 w; w.x = cvt_pk_bf16(v0[0], v0[1]); w.y = cvt_pk_bf16(v0[2], v0[3]); w.z = cvt_pk_bf16(v1[0], v1[1]); w.w = cvt_pk_bf16(v1[2], v1[3]);
                        *(u32x4*)(A2 + (size_t)g * (1024 * 384) + (size_t)(row >> 4) * 384 + (row & 15) * 16 + q0) = w; } }
        }
    }
};
struct EpiZ {
    static constexpr bool PERM = false, MIDK = false;
    float* Z;
    __device__ __forceinline__ void operator()(const f32x4 (&acc)[2][2][4][2], const Unit& u, int wr, int wc, int fr, int fq) const {
        const int row0 = u.pm * BM + wr * 64 + fr, col0 = wc * 32 + 4 * fq;
#pragma unroll
        for (int ai = 0; ai < 2; ++ai)
#pragma unroll
            for (int m = 0; m < 4; ++m) { float* rowp = Z + (size_t)(row0 + ai * HALF + m * 16) * 128 + col0;
#pragma unroll
                for (int n = 0; n < 2; ++n) *(f32x4*)(rowp + n * 16) = acc[ai][0][m][n]; }
    }
};
struct EpiY {
    static constexpr bool PERM = true, MIDK = false;
    bf16_t* Zb;
    __device__ __forceinline__ void operator()(const f32x4 (&acc)[2][2][4][2], const Unit& u, int wr, int wc, int fr, int fq) const {
        const int row0 = u.pm * BM + wr * 64 + fr, g = u.pn;
#pragma unroll
        for (int ai = 0; ai < 2; ++ai)
#pragma unroll
            for (int m = 0; m < 4; ++m) { const int bc = (row0 + ai * HALF + m * 16) & 1023;
#pragma unroll
                for (int bj = 0; bj < 2; ++bj) { const f32x4 v0 = acc[ai][bj][m][0], v1 = acc[ai][bj][m][1];
                    const int j = 8 * bj + 2 * wc + (fq >> 1), p0 = 8 * (fq & 1);
                    u32x4 w; w.x = cvt_pk_bf16(gelu_tanh(v0[0]), gelu_tanh(v0[1])); w.y = cvt_pk_bf16(gelu_tanh(v0[2]), gelu_tanh(v0[3]));
                    w.z = cvt_pk_bf16(gelu_tanh(v1[0]), gelu_tanh(v1[1])); w.w = cvt_pk_bf16(gelu_tanh(v1[2]), gelu_tanh(v1[3]));
                    *(u32x4*)(Zb + (size_t)(bc * 16 + j) * 1024 + g * 16 + p0) = w; asm volatile("" ::: "memory"); } }
    }
};
struct EpiGlu {
    static constexpr bool PERM = true, MIDK = false;
    const bf16_t* Zb; const float* bias; bf16_t* O; int ldo; float* st;
    __device__ __forceinline__ void operator()(const f32x4 (&acc)[2][2][4][2], const Unit& u, int wr, int wc, int fr, int fq) const {
        const int row0 = u.pm * BM + wr * 64 + fr, col0 = u.pn * BM + wc * 32 + 8 * fq;
        float part[2][4];
#pragma unroll
        for (int ai = 0; ai < 2; ++ai)
#pragma unroll
            for (int m = 0; m < 4; ++m) part[ai][m] = 0.f;
#pragma unroll
        for (int bj = 0; bj < 2; ++bj) { const f32x4 b0 = *(const f32x4*)(bias + col0 + bj * HALF), b1 = *(const f32x4*)(bias + col0 + bj * HALF + 4);
#pragma unroll
            for (int ai = 0; ai < 2; ++ai)
#pragma unroll
                for (int m = 0; m < 4; ++m) { const int row = row0 + ai * HALF + m * 16;
                    const u32x4 zi = *(const u32x4*)(Zb + (size_t)row * 1024 + col0 + bj * HALF); const f32x4 v0 = acc[ai][bj][m][0] + b0, v1 = acc[ai][bj][m][1] + b1;
                    float e[8];
                    e[0] = bf_lo(zi.x) * sigmoidf_(v0[0]); e[1] = bf_hi(zi.x) * sigmoidf_(v0[1]); e[2] = bf_lo(zi.y) * sigmoidf_(v0[2]); e[3] = bf_hi(zi.y) * sigmoidf_(v0[3]);
                    e[4] = bf_lo(zi.z) * sigmoidf_(v1[0]); e[5] = bf_hi(zi.z) * sigmoidf_(v1[1]); e[6] = bf_lo(zi.w) * sigmoidf_(v1[2]); e[7] = bf_hi(zi.w) * sigmoidf_(v1[3]);
                    part[ai][m] += (e[0] * e[0] + e[1] * e[1]) + (e[2] * e[2] + e[3] * e[3]) + (e[4] * e[4] + e[5] * e[5]) + (e[6] * e[6] + e[7] * e[7]);
                    u32x4 w; w.x = cvt_pk_bf16(e[0], e[1]); w.y = cvt_pk_bf16(e[2], e[3]); w.z = cvt_pk_bf16(e[4], e[5]); w.w = cvt_pk_bf16(e[6], e[7]);
                    *(u32x4*)(O + (size_t)row * ldo + col0 + bj * HALF) = w; } }
#pragma unroll
        for (int ai = 0; ai < 2; ++ai)
#pragma unroll
            for (int m = 0; m < 4; ++m) { float p = part[ai][m]; p += __shfl_xor(p, 16); p += __shfl_xor(p, 32);
                if (fq == 0) (void)__hip_atomic_fetch_add(st + row0 + ai * HALF + m * 16, p, __ATOMIC_RELAXED, __HIP_MEMORY_SCOPE_AGENT); }
    }
};
struct EpiSwiGLU {
    static constexpr bool PERM = true, MIDK = false;
    bf16_t* O; int ldc; const float* rs;
    __device__ __forceinline__ void operator()(const f32x4 (&acc)[2][2][4][2], const Unit& u, int wr, int wc, int fr, int fq) const {
        const int row0 = u.pm * BM + wr * 64 + fr, col0 = u.pn * HALF + wc * 32 + 8 * fq;
#pragma unroll
        for (int ai = 0; ai < 2; ++ai)
#pragma unroll
            for (int m = 0; m < 4; ++m) {
                const f32x4 g0 = acc[ai][0][m][0], g1 = acc[ai][0][m][1], u0 = acc[ai][1][m][0], u1 = acc[ai][1][m][1];
                u32x4 w;
                w.x = cvt_pk_bf16(g0[0] * sigmoidf_(g0[0]) * u0[0], g0[1] * sigmoidf_(g0[1]) * u0[1]); w.y = cvt_pk_bf16(g0[2] * sigmoidf_(g0[2]) * u0[2], g0[3] * sigmoidf_(g0[3]) * u0[3]);
                w.z = cvt_pk_bf16(g1[0] * sigmoidf_(g1[0]) * u1[0], g1[1] * sigmoidf_(g1[1]) * u1[1]); w.w = cvt_pk_bf16(g1[2] * sigmoidf_(g1[2]) * u1[2], g1[3] * sigmoidf_(g1[3]) * u1[3]);
                *(u32x4*)(O + (size_t)(row0 + ai * HALF + m * 16) * ldc + col0) = w; }
    }
};

template <class Epi, class Sched, bool ALIGN_EPI>
__device__ __forceinline__ void gemm_phase(PG8_LAS unsigned char* lds, const Gemm g, const Sched& S, const Epi& E) {
    int tid_ = threadIdx.x; asm volatile("" : "+v"(tid_));
    const int tid = tid_, wid = __builtin_amdgcn_readfirstlane(tid >> 6), lane = tid & 63, wr = wid >> 2, wc = wid & 3, fr = lane & 15, fq = lane >> 4;
    const int nt = g.K / BK;
    unsigned voffA[2], voffB[2];
#pragma unroll
    for (int i = 0; i < 2; ++i) { int R, C; stage_rc(tid * 16 + i * 8192, R, C); const int Rb = Epi::PERM ? ((R & ~31) + perm32(R & 31)) : R;
        voffA[i] = (unsigned)(R * g.lda + C) * 2u; voffB[i] = (unsigned)(Rb * g.ldb + C) * 2u; }
    const size_t kstep = (size_t)(BK * 2);
    const size_t hstepA = (size_t)HALF * g.lda * 2, hstepB = (size_t)HALF * g.ldb * 2;
    const size_t tstepA = 2 * hstepA, tstepB = 2 * hstepB;
    const unsigned ldsw = (unsigned)wid * 1024u;
    const size_t tailoff = (size_t)(nt - 2) * (size_t)(BK * 2);
    const int aoff = lds_byte(wr * 64 + fr, fq * 8), boff = lds_byte(wc * 32 + fr, fq * 8);
#define PG8_SA(b, h) (((b) * 2 + (h)) * HTB)
#define PG8_SB(b, h) ((4 + (b) * 2 + (h)) * HTB)
#define PG8_STAGE(bufoff, gbase, voff) do { _Pragma("unroll") for (int _i = 0; _i < 2; ++_i) \
        __builtin_amdgcn_global_load_lds((const unsigned*)((const char*)(gbase) + (voff)[_i]), (PG8_LAS unsigned*)(lds + (bufoff) + ldsw + _i * 8192), 16, 0, 0); } while (0)
#define PG8_LDA(dst, b, h) do { _Pragma("unroll") for (int m = 0; m < 4; ++m) _Pragma("unroll") for (int k = 0; k < 2; ++k) dst[m][k] = *(const PG8_LAS bf16x8*)(lds + PG8_SA(b, h) + aoff + m * 2048 + k * 1024); } while (0)
#define PG8_LDB(dst, b, h) do { _Pragma("unroll") for (int n = 0; n < 2; ++n) _Pragma("unroll") for (int k = 0; k < 2; ++k) dst[n][k] = *(const PG8_LAS bf16x8*)(lds + PG8_SB(b, h) + boff + n * 2048 + k * 1024); } while (0)
#define PG8_MMA(ai, bj, At, Bt) do { __builtin_amdgcn_s_setprio(1); _Pragma("unroll") for (int m = 0; m < 4; ++m) _Pragma("unroll") for (int n = 0; n < 2; ++n) _Pragma("unroll") for (int k = 0; k < 2; ++k) \
        acc[ai][bj][m][n] = __builtin_amdgcn_mfma_f32_16x16x32_bf16(Bt[n][k], At[m][k], acc[ai][bj][m][n], 0, 0, 0); __builtin_amdgcn_s_setprio(0); } while (0)
#define PG8_WAIT_V(n) asm volatile("s_waitcnt vmcnt(" #n ")" ::: "memory")
#define PG8_WAIT_L(n) asm volatile("s_waitcnt lgkmcnt(" #n ")" ::: "memory")
#define PG8_BAR __builtin_amdgcn_s_barrier()
#define PG8_SCHED __builtin_amdgcn_sched_barrier(0)
    Unit cur, nxt; int ui = 0;
    if (!S.next(0, cur)) return;
    f32x4 acc[2][2][4][2];
#pragma unroll
    for (int a = 0; a < 2; ++a)
#pragma unroll
        for (int b = 0; b < 2; ++b)
#pragma unroll
            for (int m = 0; m < 4; ++m)
#pragma unroll
                for (int n = 0; n < 2; ++n) acc[a][b][m][n] = (f32x4){0.f, 0.f, 0.f, 0.f};
    bf16x8 At[4][2], B0[2][2], B1[2][2];
    const char* cA = (const char*)g.A + (size_t)cur.pm * tstepA; const char* cB = (const char*)g.Bt + (size_t)cur.pn * tstepB;
    PG8_STAGE(PG8_SB(0, 0), cB, voffB); PG8_STAGE(PG8_SB(0, 1), cB + hstepB, voffB); PG8_STAGE(PG8_SA(0, 0), cA, voffA); PG8_STAGE(PG8_SA(0, 1), cA + hstepA, voffA);
    if (wr == 1) PG8_BAR;
    PG8_WAIT_V(2); PG8_BAR;
    PG8_STAGE(PG8_SB(1, 0), cB + kstep, voffB); PG8_STAGE(PG8_SA(1, 0), cA + kstep, voffA); PG8_STAGE(PG8_SB(1, 1), cB + hstepB + kstep, voffB);
    PG8_WAIT_V(6); PG8_BAR;
    for (;;) {
        const bool has_next = S.next(ui + 1, nxt);
        const size_t tail_ = has_next ? 0 : tailoff; const char* nA = (has_next ? (const char*)g.A + (size_t)nxt.pm * tstepA : cA) + tail_; const char* nB = (has_next ? (const char*)g.Bt + (size_t)nxt.pn * tstepB : cB) + tail_;
        for (int t = 0; t < nt; t += 2) {
            if constexpr (Epi::MIDK) { if (t == (nt >> 1)) E.midk(acc, cur, wr, fr); }
            const bool last = (t == nt - 2);
            const char* a1 = cA + (size_t)(t + 1) * kstep;
            const char* a2 = last ? nA : cA + (size_t)(t + 2) * kstep; const char* b2 = last ? nB : cB + (size_t)(t + 2) * kstep;
            const char* a3 = a2 + kstep; const char* b3 = b2 + kstep;
            PG8_LDB(B0, 0, 0); PG8_LDB(B1, 0, 1); PG8_SCHED; PG8_LDA(At, 0, 0); PG8_STAGE(PG8_SA(1, 1), a1 + hstepA, voffA);
            PG8_WAIT_V(8); PG8_WAIT_L(0); PG8_BAR; PG8_MMA(0, 0, At, B0); PG8_MMA(0, 1, At, B1); PG8_BAR; PG8_SCHED;
            PG8_LDA(At, 0, 1); PG8_STAGE(PG8_SB(0, 0), b2, voffB); PG8_STAGE(PG8_SB(0, 1), b2 + hstepB, voffB); PG8_STAGE(PG8_SA(0, 0), a2, voffA);
            PG8_WAIT_V(8); PG8_WAIT_L(0); PG8_BAR; PG8_MMA(1, 0, At, B0); PG8_MMA(1, 1, At, B1); PG8_BAR; PG8_SCHED;
            PG8_LDB(B0, 1, 0); PG8_LDB(B1, 1, 1); PG8_SCHED; PG8_LDA(At, 1, 0); PG8_STAGE(PG8_SA(0, 1), a2 + hstepA, voffA);
            PG8_WAIT_V(8); PG8_WAIT_L(0); PG8_BAR; PG8_MMA(0, 0, At, B0); PG8_MMA(0, 1, At, B1); PG8_BAR; PG8_SCHED;
            PG8_LDA(At, 1, 1); PG8_STAGE(PG8_SB(1, 0), b3, voffB); PG8_STAGE(PG8_SB(1, 1), b3 + hstepB, voffB); PG8_STAGE(PG8_SA(1, 0), a3, voffA);
            PG8_WAIT_V(8); PG8_WAIT_L(0); PG8_BAR; PG8_MMA(1, 0, At, B0); PG8_MMA(1, 1, At, B1); PG8_BAR; PG8_SCHED;
        }
        if constexpr (ALIGN_EPI) { if (wr == 0) PG8_BAR; }
        E(acc, cur, wr, wc, fr, fq);
        if (!has_next) break;
#pragma unroll
        for (int a = 0; a < 2; ++a)
#pragma unroll
            for (int b = 0; b < 2; ++b)
#pragma unroll
                for (int m = 0; m < 4; ++m)
#pragma unroll
                    for (int n = 0; n < 2; ++n) acc[a][b][m][n] = (f32x4){0.f, 0.f, 0.f, 0.f};
        cur = nxt; cA = nA; cB = nB; ++ui;
        if constexpr (ALIGN_EPI) { if (wr == 1) PG8_BAR; }
    }
    PG8_WAIT_V(0);
    if constexpr (!ALIGN_EPI) { if (wr == 0) PG8_BAR; }
    PG8_BAR;
#undef PG8_SA
#undef PG8_SB
#undef PG8_STAGE
#undef PG8_LDA
#undef PG8_LDB
#undef PG8_MMA
#undef PG8_WAIT_V
#undef PG8_WAIT_L
#undef PG8_BAR
#undef PG8_SCHED
}
}

constexpr int NWAVES = 8;
constexpr int BATCH = 8, SEQ = 2048, DM = 2048, M = BATCH * SEQ;
constexpr int D_ATTN = 1024, D_KV = 256, D_SSM = 1024, D_IN = 2560, D_FF = 5632, NQH = 16, NKVH = 4, HD = 64;
constexpr int NG = 64, NST = 64, PCH = 16, CH = 16, NCH = SEQ / CH;
constexpr int A2LD = 384;
constexpr float RMS_EPS = 1e-6f;

constexpr size_t MiB = 1u << 20;
constexpr size_t WS_CTL = 0, CTL_ZERO_BYTES = 1 * MiB;
constexpr size_t WS_WIN = 2 * MiB, WS_WGLU = 12 * MiB, WS_WO = 14 * MiB, WS_WGU = 22 * MiB, WS_WD = 66 * MiB;
constexpr size_t WS_TC = 88 * MiB, WS_BZ = 100 * MiB, WS_LAM = 108 * MiB, WS_RH = 109 * MiB, WS_RX = 110 * MiB;
constexpr size_t WS_R1 = 112 * MiB;
constexpr size_t WS_R2 = 176 * MiB;
constexpr size_t WS_Q = WS_R2, WS_K = WS_R2 + 32 * MiB, WS_VT = WS_R2 + 40 * MiB;
constexpr size_t WS_A3 = 240 * MiB, WS_Z = 304 * MiB;
constexpr size_t WS_A2 = 336 * MiB;
constexpr size_t WS_ZS = 384 * MiB;
constexpr size_t WS_HID = 336 * MiB;
constexpr size_t WS_END = 512 * MiB;
constexpr int CW_BAR = 4096, CW_TEAM = 16384, CW_STAT_A = 65536, CW_STAT_S = 81920;

constexpr int RING_BYTES = 131072, LDSCTL_OFF = RING_BYTES, MISC_OFF = LDSCTL_OFF + 320, LDS_BYTES = 147456;

#define GAS __attribute__((address_space(1)))
#define LAS __attribute__((address_space(3)))
typedef unsigned short bf16;
typedef unsigned v4u __attribute__((ext_vector_type(4)));
typedef unsigned v2u __attribute__((ext_vector_type(2)));
typedef float f32x4 __attribute__((ext_vector_type(4)));
typedef float f32x16 __attribute__((ext_vector_type(16)));
typedef short bf16x8 __attribute__((ext_vector_type(8)));
#define LDS_WAIT() asm volatile("s_waitcnt lgkmcnt(0)" ::: "memory")
using pg8::cvt_pk_bf16; using pg8::bf_lo; using pg8::bf_hi;

#define XB_TMO      128
#define XB_XCNT(j)  (256  + 64 * (j))
#define XB_XSUB(j)  (1280 + 64 * (j))
#define XB_XGEN(j)  (2304 + 64 * (j))
#define XB_TOP      3328
#define XB_TOPGEN   3392
#define XCD_BAR_WORDS 3456
#define XB_SPIN_CAP (1u << 18)
__device__ __forceinline__ unsigned xb_ld(unsigned* p)              { return __hip_atomic_load(p, __ATOMIC_RELAXED, __HIP_MEMORY_SCOPE_AGENT); }
__device__ __forceinline__ unsigned xb_add(unsigned* p, unsigned v) { return __hip_atomic_fetch_add(p, v, __ATOMIC_RELAXED, __HIP_MEMORY_SCOPE_AGENT); }
__device__ __forceinline__ unsigned xb_xcc_id() { return (unsigned)__builtin_amdgcn_s_getreg((3 << 11) | 20) & 0xFu; }
#define XB_SPIN(cond, bar) do { unsigned _sp = 0; while (cond) { __builtin_amdgcn_s_sleep(1); \
    if ((++_sp & 255u) == 0u) { if (xb_ld(&(bar)[XB_TMO])) break; if (_sp > XB_SPIN_CAP) { atomicAdd(&(bar)[XB_TMO], 1u); break; } } } } while (0)
struct XcdBarrier { unsigned* bar; unsigned x; volatile LAS unsigned* st; };
__device__ __forceinline__ XcdBarrier xcd_barrier_post(unsigned* bar, volatile LAS unsigned* st) {
    XcdBarrier b; b.bar = bar; b.x = xb_xcc_id(); b.st = st;
    if (threadIdx.x == 0) (void)xb_add(&bar[XB_XCNT(b.x)], 1u);
    return b;
}
__device__ __forceinline__ void xcd_barrier_complete(unsigned* bar, unsigned x, unsigned& nloc, unsigned& nx) {
    const unsigned G = gridDim.x * gridDim.y * gridDim.z;
    unsigned sum, cnt, mine, sp = 0u;
    for (;;) {
        sum = 0u; cnt = 0u; mine = 0u;
#pragma unroll
        for (unsigned j = 0; j < 16; ++j) { const unsigned c = xb_ld(&bar[XB_XCNT(j)]); sum += c; cnt += (c > 0u) ? 1u : 0u; mine = (j == x) ? c : mine; }
        if (sum == G) break;
        __builtin_amdgcn_s_sleep(1);
        if ((++sp & 255u) == 0u) { if (xb_ld(&bar[XB_TMO])) break; if (sp > XB_SPIN_CAP) { atomicAdd(&bar[XB_TMO], 1u); break; } }
    }
    nloc = mine > 0u ? mine : 1u; nx = cnt > 0u ? cnt : 1u;
}
__device__ __forceinline__ void xcd_barrier(const XcdBarrier& b) {
    asm volatile("s_waitcnt vmcnt(0)" ::: "memory");
    __syncthreads();
    if (threadIdx.x == 0) {
        unsigned* bar = b.bar;
        __builtin_amdgcn_s_waitcnt(0);
        unsigned nloc = b.st[0], nx = b.st[1];
        if (nloc == 0u) { xcd_barrier_complete(bar, b.x, nloc, nx); b.st[0] = nloc; b.st[1] = nx; }
        const unsigned old = xb_add(&bar[XB_XSUB(b.x)], 1u);
        const unsigned gen = old / nloc;
        if (old + 1u == (gen + 1u) * nloc) {
            __builtin_amdgcn_fence(__ATOMIC_RELEASE, "agent");
            asm volatile("s_waitcnt vmcnt(0)" ::: "memory");
            const unsigned og = xb_add(&bar[XB_TOP], 1u);
            const unsigned tg = og / nx;
            if (og + 1u == (tg + 1u) * nx) xb_add(&bar[XB_TOPGEN], 1u);
            else XB_SPIN(xb_ld(&bar[XB_TOPGEN]) == tg, bar);
            __builtin_amdgcn_fence(__ATOMIC_ACQUIRE, "agent");
            xb_add(&bar[XB_XGEN(b.x)], 1u);
            asm volatile("s_waitcnt vmcnt(0)" ::: "memory");
        } else {
            XB_SPIN(xb_ld(&bar[XB_XGEN(b.x)]) == gen, bar);
            __builtin_amdgcn_fence(__ATOMIC_ACQUIRE, "agent");
            asm volatile("s_waitcnt vmcnt(0)" ::: "memory");
        }
    }
    __syncthreads();
}

__device__ __forceinline__ void team_barrier(unsigned* cnt, unsigned* tmo, unsigned& epoch, volatile LAS unsigned* same_xcd) {
    asm volatile("s_waitcnt vmcnt(0)" ::: "memory");
    __syncthreads();
    if (threadIdx.x == 0) {
        if (*same_xcd != 1u) { __builtin_amdgcn_fence(__ATOMIC_RELEASE, "agent"); }
        asm volatile("s_waitcnt vmcnt(0)" ::: "memory");
        (void)xb_add(cnt, 1u);
        const unsigned want = 4u * epoch; unsigned sp = 0u;
        while (xb_ld(cnt) < want) { __builtin_amdgcn_s_sleep(1); if ((++sp & 255u) == 0u) { if (xb_ld(tmo)) break; if (sp > XB_SPIN_CAP) { atomicAdd(tmo, 1u); break; } } }
        __builtin_amdgcn_fence(__ATOMIC_ACQUIRE, "agent");
        asm volatile("s_waitcnt vmcnt(0)" ::: "memory");
    }
    __syncthreads();
    ++epoch;
}

__device__ __forceinline__ float wave_sum(float v) {
#pragma unroll
    for (int o = 1; o < 64; o <<= 1) v += __shfl_xor(v, o);
    return v;
}
__device__ __forceinline__ void sincos_rev(double rev, float& s, float& c) {
    const double fr = rev - __builtin_rint(rev); const float f = (float)fr;
    s = __builtin_amdgcn_sinf(f); c = __builtin_amdgcn_cosf(f);
}
enum { MAP_PLAIN = 0, MAP_WIN = 1, MAP_GATE = 2, MAP_UP = 3 };
template <int MODE> __device__ __forceinline__ int map_row(int n) {
    if (MODE == MAP_WIN) {
        if (n < 1280) { const int d = n & 63; return (n & ~63) + (d < 32 ? 2 * d : 2 * (d - 32) + 1); }
        if (n < 1536) return 2304 + (n - 1280);
        return 1280 + (n - 1536);
    }
    if (MODE == MAP_GATE) return ((n >> 7) << 8) + (n & 127);
    if (MODE == MAP_UP) return ((n >> 7) << 8) + 128 + (n & 127);
    return n;
}
template <int MODE> __device__ __forceinline__ void transpose_item(const float* W, int K, int N, bf16* WT, const float* gs, LAS float* scr, int item, int lane) {
    const int nblk = N / 32, kb = item / nblk, nb = item % nblk, k0 = 64 * kb, n0 = 32 * nb;
    const float* src = W + (size_t)(k0 + (lane >> 5)) * N + n0 + (lane & 31);
    float v[32];
#pragma unroll
    for (int i = 0; i < 32; ++i) v[i] = src[(size_t)(2 * i) * N];
    const int c = lane & 7;
    f32x4 g0 = (f32x4){1.f, 1.f, 1.f, 1.f}, g1 = g0;
    if (gs) { g0 = *(const f32x4*)(gs + k0 + 8 * c); g1 = *(const f32x4*)(gs + k0 + 8 * c + 4); }
    LAS float* sw = scr + (lane >> 5) * 33 + (lane & 31);
#pragma unroll
    for (int i = 0; i < 32; ++i) sw[(2 * i) * 33] = v[i];
    LDS_WAIT(); asm volatile("" ::: "memory");
#pragma unroll
    for (int j = 0; j < 4; ++j) { const int n = (lane >> 3) + 8 * j; const LAS float* s = scr + (8 * c) * 33 + n;
        v4u o; o.x = cvt_pk_bf16(s[0 * 33] * g0.x, s[1 * 33] * g0.y); o.y = cvt_pk_bf16(s[2 * 33] * g0.z, s[3 * 33] * g0.w); o.z = cvt_pk_bf16(s[4 * 33] * g1.x, s[5 * 33] * g1.y); o.w = cvt_pk_bf16(s[6 * 33] * g1.z, s[7 * 33] * g1.w);
        *(v4u*)(WT + (size_t)map_row<MODE>(n0 + n) * K + k0 + 8 * c) = o; }
    LDS_WAIT(); asm volatile("" ::: "memory");
}

struct TrDesc { const float* W; bf16* WT; const float* gs; int K, N, mode, item; };
struct TrRegs { float v[32]; f32x4 g0, g1; };
__device__ __forceinline__ int map_row_rt(int mode, int n) {
    if (mode == MAP_WIN) return map_row<MAP_WIN>(n);
    if (mode == MAP_GATE) return map_row<MAP_GATE>(n);
    if (mode == MAP_UP) return map_row<MAP_UP>(n);
    return n;
}
__device__ __forceinline__ void tr_load(const TrDesc& d, int lane, TrRegs& t) {
    const int nblk = d.N / 32, kb = d.item / nblk, nb = d.item - kb * nblk, k0 = 64 * kb, n0 = 32 * nb;
    const float* src = d.W + (size_t)(k0 + (lane >> 5)) * d.N + n0 + (lane & 31);
#pragma unroll
    for (int i = 0; i < 32; ++i) t.v[i] = src[(size_t)(2 * i) * d.N];
    const int c = lane & 7;
    t.g0 = (f32x4){1.f, 1.f, 1.f, 1.f}; t.g1 = t.g0;
    if (d.gs) { t.g0 = *(const f32x4*)(d.gs + k0 + 8 * c); t.g1 = *(const f32x4*)(d.gs + k0 + 8 * c + 4); }
}
__device__ __forceinline__ void tr_finish(const TrDesc& d, const TrRegs& t, LAS float* scr, int lane) {
    const int nblk = d.N / 32, kb = d.item / nblk, nb = d.item - kb * nblk, k0 = 64 * kb, n0 = 32 * nb, c = lane & 7;
    LAS float* sw = scr + (lane >> 5) * 33 + (lane & 31);
#pragma unroll
    for (int i = 0; i < 32; ++i) sw[(2 * i) * 33] = t.v[i];
    LDS_WAIT(); asm volatile("" ::: "memory");
#pragma unroll
    for (int j = 0; j < 4; ++j) { const int n = (lane >> 3) + 8 * j; const LAS float* s = scr + (8 * c) * 33 + n;
        v4u o; o.x = cvt_pk_bf16(s[0 * 33] * t.g0.x, s[1 * 33] * t.g0.y); o.y = cvt_pk_bf16(s[2 * 33] * t.g0.z, s[3 * 33] * t.g0.w); o.z = cvt_pk_bf16(s[4 * 33] * t.g1.x, s[5 * 33] * t.g1.y); o.w = cvt_pk_bf16(s[6 * 33] * t.g1.z, s[7 * 33] * t.g1.w);
        *(v4u*)(d.WT + (size_t)map_row_rt(d.mode, n0 + n) * d.K + k0 + 8 * c) = o; }
    LDS_WAIT(); asm volatile("" ::: "memory");
}

struct Args {
    const float* x; const int* pos; const float* g_pre_mix; const float* w_in; const float* sinks; const float* a_re; const float* a_im; const float* log_dt;
    const float* b_re; const float* b_im; const float* c_re; const float* c_im; const float* d_skip; const float* w_glu; const float* b_glu;
    const float* g_attn_out; const float* g_ssm_out; const float* w_o; const float* g_post_mix; const float* g_pre_ffn; const float* w_gate; const float* w_up;
    const float* w_down; const float* g_post_ffn; float* out; unsigned char* ws;
};

__device__ __forceinline__ void ssm_precompute(const Args& a, int g, LAS unsigned char* lds, int tid) {
    typedef float f32x2v __attribute__((ext_vector_type(2)));
    LAS f32x2v* P = (LAS f32x2v*)lds;
    LAS f32x2v* Bb = (LAS f32x2v*)(lds + 8704);
    LAS f32x2v* Cc = (LAS f32x2v*)(lds + 8704 + 8192);
    LAS float* Kk = (LAS float*)(lds + 8704 + 16384);
    const float dt = __builtin_amdgcn_exp2f(a.log_dt[g] * 1.4426950408889634f);
    for (int e = tid; e < 17 * 64; e += 512) { const int k = e >> 6, n = e & 63; const float ar = a.a_re[g * 64 + n], ai = a.a_im[g * 64 + n];
        const float mag = __builtin_amdgcn_exp2f((float)k * ar * dt * 1.4426950408889634f); float s, c; sincos_rev((double)k * (double)ai * (double)dt * 0.15915494309189535, s, c);
        P[e] = (f32x2v){mag * c, mag * s}; }
    for (int e = tid; e < 1024; e += 512) { const int n = e >> 4; const float ar = a.a_re[g * 64 + n], ai = a.a_im[g * 64 + n];
        const float mag = __builtin_amdgcn_exp2f(ar * dt * 1.4426950408889634f); float s, c; sincos_rev((double)ai * (double)dt * 0.15915494309189535, s, c);
        const float lr = mag * c, li = mag * s, den = ar * ar + ai * ai, nr = lr - 1.0f, ni = li;
        const float fre = (nr * ar + ni * ai) / den, fim = (ni * ar - nr * ai) / den;
        const float br = a.b_re[(size_t)g * 1024 + e], bi = a.b_im[(size_t)g * 1024 + e];
        Bb[e] = (f32x2v){fre * br - fim * bi, fre * bi + fim * br};
        Cc[e] = (f32x2v){a.c_re[(size_t)g * 1024 + e], a.c_im[(size_t)g * 1024 + e]}; }
    LDS_WAIT(); __syncthreads();
    for (int e = tid; e < 4096; e += 512) { const int k = e >> 8, p = (e >> 4) & 15, q = e & 15; float s = 0.f;
        for (int n = 0; n < 64; ++n) { const f32x2v c = Cc[p * 64 + n], l = P[k * 64 + n], b = Bb[n * 16 + q];
            const float tr = c.x * l.x - c.y * l.y, ti = c.x * l.y + c.y * l.x; s += tr * b.x - ti * b.y; }
        Kk[e] = s; }
    LDS_WAIT(); __syncthreads();
    bf16* TC = (bf16*)(a.ws + WS_TC) + (size_t)g * 256 * A2LD;
    bf16* BZ = (bf16*)(a.ws + WS_BZ) + (size_t)g * 256 * 256;
    {
        const int row = tid >> 1, j = row >> 4, p = row & 15; const float dp = a.d_skip[g * 16 + p];
        for (int ci = 0; ci < 16; ++ci) { const int col0 = 128 * (tid & 1) + 8 * ci, i = col0 >> 4, q0 = col0 & 15; float v[8];
#pragma unroll
            for (int e = 0; e < 8; ++e) { float t = 0.f; if (i <= j) { t = Kk[((j - i) * 16 + p) * 16 + q0 + e]; if (i == j && q0 + e == p) t += dp; } v[e] = t; }
            v4u o; o.x = cvt_pk_bf16(v[0], v[1]); o.y = cvt_pk_bf16(v[2], v[3]); o.z = cvt_pk_bf16(v[4], v[5]); o.w = cvt_pk_bf16(v[6], v[7]);
            *(v4u*)(TC + (size_t)row * A2LD + col0) = o; }
        for (int ci = 0; ci < 8; ++ci) { const int n0 = 32 * (tid & 1) + 4 * ci; float v[8];
#pragma unroll
            for (int e = 0; e < 4; ++e) { const f32x2v c = Cc[p * 64 + n0 + e], l = P[(j + 1) * 64 + n0 + e]; v[2 * e] = c.x * l.x - c.y * l.y; v[2 * e + 1] = -(c.x * l.y + c.y * l.x); }
            v4u o; o.x = cvt_pk_bf16(v[0], v[1]); o.y = cvt_pk_bf16(v[2], v[3]); o.z = cvt_pk_bf16(v[4], v[5]); o.w = cvt_pk_bf16(v[6], v[7]);
            *(v4u*)(TC + (size_t)row * A2LD + 256 + 2 * n0) = o; }
    }
    {
        const int row = tid >> 2, n = row >> 1, ri = row & 1;
        for (int ci = 0; ci < 8; ++ci) { const int col0 = 64 * (tid & 3) + 8 * ci, i = col0 >> 4, q0 = col0 & 15; float v[8];
#pragma unroll
            for (int e = 0; e < 8; ++e) { const f32x2v l = P[(15 - i) * 64 + n], b = Bb[n * 16 + q0 + e]; v[e] = ri ? (l.x * b.y + l.y * b.x) : (l.x * b.x - l.y * b.y); }
            v4u o; o.x = cvt_pk_bf16(v[0], v[1]); o.y = cvt_pk_bf16(v[2], v[3]); o.z = cvt_pk_bf16(v[4], v[5]); o.w = cvt_pk_bf16(v[6], v[7]);
            *(v4u*)(BZ + (size_t)row * 256 + col0) = o;
            *(v4u*)(BZ + (size_t)(128 + row) * 256 + col0) = (v4u){0u, 0u, 0u, 0u}; }
    }
    if (tid < 64) { const f32x2v l = P[16 * 64 + tid]; ((float*)(a.ws + WS_LAM))[(g * 64 + tid) * 2] = l.x; ((float*)(a.ws + WS_LAM))[(g * 64 + tid) * 2 + 1] = l.y; }
    LDS_WAIT(); __syncthreads();
}

constexpr int AT_KROW = 144, AT_VROW = 392, AT_V_OFF = 192 * AT_KROW, AT_LDS_BYTES = AT_V_OFF + 64 * AT_VROW;
__device__ __forceinline__ int crow(int r, int hi) { return (r & 3) + 8 * (r >> 2) + 4 * hi; }
__device__ __forceinline__ void attn_phase(LAS unsigned char* lds, int vcu, int G, const bf16* Qp, const bf16* Kp, const bf16* Vt, const float* sinks, bf16* AO, int ldo, float* st) {
    typedef unsigned long long u64;
    int tid = threadIdx.x; asm volatile("" : "+v"(tid));
    const int lane = tid & 63, wave = __builtin_amdgcn_readfirstlane(tid >> 6), r32 = lane & 31, hi = lane >> 5, hq = wave & 3, qsub = wave >> 2;
    const float NEG = -INFINITY;
    float ssq_acc = 0.f;
    for (int it = 0; it < 4; ++it) { const int id = ((vcu >> 5) << 7) | (it << 5) | (vcu & 31);
        const int b = id >> 7, kvh = (id >> 5) & 3, q0 = 64 * (id & 31), h = kvh * 4 + hq;
        const size_t tok0 = (size_t)b * SEQ;
        const int jt0 = (q0 >= 128) ? 0 : (128 - q0) / 32;
        v4u kv[3], vv[3];
#pragma unroll
        for (int i = 0; i < 3; ++i) { const int c = tid + 512 * i, row = c >> 3, ch = c & 7, key = q0 - 128 + row;
            if (key >= 0) kv[i] = *(const v4u*)(Kp + (tok0 + key) * D_KV + kvh * HD + ch * 8); }
#pragma unroll
        for (int i = 0; i < 3; ++i) { const int c = tid + 512 * i, d = c / 24, ch = c - d * 24, key0 = q0 - 128 + 8 * ch;
            if (key0 >= 0) vv[i] = *(const v4u*)(Vt + (size_t)(kvh * HD + d) * M + tok0 + key0); }
        const bf16* qrow = Qp + (tok0 + q0 + 32 * qsub + r32) * D_ATTN + h * HD + 32 * hi;
        bf16x8 qf[4];
#pragma unroll
        for (int kk = 0; kk < 4; ++kk) qf[kk] = *(const bf16x8*)(qrow + 8 * kk);
#pragma unroll
        for (int i = 0; i < 3; ++i) { const int c = tid + 512 * i, row = c >> 3, ch = c & 7, key = q0 - 128 + row;
            if (key >= 0) *(LAS v4u*)(lds + row * AT_KROW + ch * 16) = kv[i]; }
#pragma unroll
        for (int i = 0; i < 3; ++i) { const int c = tid + 512 * i, d = c / 24, ch = c - d * 24, key0 = q0 - 128 + 8 * ch;
            if (key0 >= 0) { LAS u64* p = (LAS u64*)(lds + AT_V_OFF + d * AT_VROW + ch * 16); p[0] = ((u64)vv[i].y << 32) | vv[i].x; p[1] = ((u64)vv[i].w << 32) | vv[i].z; } }
        LDS_WAIT(); __syncthreads();
        f32x16 s[5];
#pragma unroll
        for (int kt = 0; kt < 5; ++kt) {
            if (kt + qsub >= jt0) {
                const LAS unsigned char* kp = lds + (32 * (kt + qsub) + r32) * AT_KROW + 64 * hi;
                f32x16 acc = {0.f, 0.f, 0.f, 0.f, 0.f, 0.f, 0.f, 0.f, 0.f, 0.f, 0.f, 0.f, 0.f, 0.f, 0.f, 0.f};
#pragma unroll
                for (int kk = 0; kk < 4; ++kk) acc = __builtin_amdgcn_mfma_f32_32x32x16_bf16(*(const LAS bf16x8*)(kp + 16 * kk), qf[kk], acc, 0, 0, 0);
                s[kt] = acc;
            } else {
#pragma unroll
                for (int r = 0; r < 16; ++r) s[kt][r] = NEG;
            }
        }
#pragma unroll
        for (int r = 0; r < 16; ++r) { const int cr = crow(r, hi); if (!(cr > r32)) s[0][r] = NEG; if (!(cr <= r32)) s[4][r] = NEG; }
        const float sk = sinks[h] * 1.4426950408889634f;
        float mx = sk;
#pragma unroll
        for (int kt = 0; kt < 5; ++kt)
#pragma unroll
            for (int r = 0; r < 16; ++r) mx = fmaxf(mx, s[kt][r]);
        mx = fmaxf(mx, __shfl_xor(mx, 32));
        float l = 0.f;
#pragma unroll
        for (int kt = 0; kt < 5; ++kt)
#pragma unroll
            for (int r = 0; r < 16; ++r) { const float p = __builtin_amdgcn_exp2f(s[kt][r] - mx); s[kt][r] = p; l += p; }
        l += __shfl_xor(l, 32);
        l += __builtin_amdgcn_exp2f(sk - mx);
        const float inv = 1.0f / l;
        f32x16 o[2];
#pragma unroll
        for (int d = 0; d < 2; ++d)
#pragma unroll
            for (int r = 0; r < 16; ++r) o[d][r] = 0.f;
#pragma unroll
        for (int kt = 0; kt < 5; ++kt) {
            if (kt + qsub >= jt0) {
#pragma unroll
                for (int s2 = 0; s2 < 2; ++s2) {
                    v4u pw; pw.x = cvt_pk_bf16(s[kt][8 * s2 + 0] * inv, s[kt][8 * s2 + 1] * inv); pw.y = cvt_pk_bf16(s[kt][8 * s2 + 2] * inv, s[kt][8 * s2 + 3] * inv);
                    pw.z = cvt_pk_bf16(s[kt][8 * s2 + 4] * inv, s[kt][8 * s2 + 5] * inv); pw.w = cvt_pk_bf16(s[kt][8 * s2 + 6] * inv, s[kt][8 * s2 + 7] * inv);
                    const bf16x8 pf = __builtin_bit_cast(bf16x8, pw);
#pragma unroll
                    for (int dh = 0; dh < 2; ++dh) {
                        const LAS u64* vp = (const LAS u64*)(lds + AT_V_OFF + (dh * 32 + r32) * AT_VROW + (32 * (kt + qsub) + 16 * s2 + 4 * hi) * 2);
                        const u64 lo = vp[0], hi8 = vp[2];
                        const v4u vw = (v4u){(unsigned)lo, (unsigned)(lo >> 32), (unsigned)hi8, (unsigned)(hi8 >> 32)};
                        o[dh] = __builtin_amdgcn_mfma_f32_32x32x16_bf16(__builtin_bit_cast(bf16x8, vw), pf, o[dh], 0, 0, 0);
                    }
                }
            }
        }
        {
            float ssq = 0.f;
#pragma unroll
            for (int dh = 0; dh < 2; ++dh)
#pragma unroll
                for (int r = 0; r < 16; ++r) ssq += o[dh][r] * o[dh][r];
            ssq += __shfl_xor(ssq, 32);
            ssq_acc += ssq;
        }
        bf16* orow = AO + (tok0 + q0 + 32 * qsub + r32) * (size_t)ldo + h * HD + 4 * hi;
#pragma unroll
        for (int dh = 0; dh < 2; ++dh)
#pragma unroll
            for (int g4 = 0; g4 < 4; ++g4) { v2u w; w.x = cvt_pk_bf16(o[dh][4 * g4], o[dh][4 * g4 + 1]); w.y = cvt_pk_bf16(o[dh][4 * g4 + 2], o[dh][4 * g4 + 3]);
                *(v2u*)(orow + dh * 32 + 8 * g4) = w; }
        LDS_WAIT(); __syncthreads();
    }
    {
        LAS float* Xs = (LAS float*)lds;
        if (hi == 0) Xs[(qsub * 4 + hq) * 32 + r32] = ssq_acc;
        LDS_WAIT(); __syncthreads();
        if (hq == 0 && hi == 0) { const float tot = (Xs[(qsub * 4 + 0) * 32 + r32] + Xs[(qsub * 4 + 1) * 32 + r32]) + (Xs[(qsub * 4 + 2) * 32 + r32] + Xs[(qsub * 4 + 3) * 32 + r32]);
            st[(size_t)(vcu >> 5) * SEQ + 64 * (vcu & 31) + 32 * qsub + r32] = tot; }
        LDS_WAIT(); __syncthreads();
    }
}

__global__ void __launch_bounds__(NWAVES * 64, 2) hymba_fwd(Args a) {
    extern __shared__ __attribute__((aligned(16))) unsigned char lds_raw[];
    LAS unsigned char* lds = (LAS unsigned char*)lds_raw;
    volatile LAS unsigned* MISC = (volatile LAS unsigned*)(lds + MISC_OFF);
    const int tid = threadIdx.x;
    const int G = gridDim.x; const int bx = blockIdx.x; const int vcu = (G % 8 == 0) ? (bx % 8) * (G / 8) + bx / 8 : bx;
    unsigned char* ws = a.ws;
    unsigned* ctl = (unsigned*)(ws + WS_CTL);
    for (int u = tid; u < (LDS_BYTES - LDSCTL_OFF) / 4; u += NWAVES * 64) ((LAS unsigned*)(lds + LDSCTL_OFF))[u] = 0u;
    __syncthreads();
    XcdBarrier bar = xcd_barrier_post(ctl + CW_BAR, MISC + 8);
#define GRID_BAR() xcd_barrier(bar)
    const int team_pm = 8 * (bx & 7) + ((bx >> 3) & 7), team_k = bx >> 6;
    unsigned team_epoch = 1u;
#define TEAM_BAR() team_barrier(ctl + CW_TEAM + 64 * team_pm, ctl + CW_BAR + XB_TMO, team_epoch, MISC + 12)
    if (tid == 0) __hip_atomic_store(ctl + CW_TEAM + 64 * team_pm + 8 + team_k, 0x100u | bar.x, __ATOMIC_RELAXED, __HIP_MEMORY_SCOPE_AGENT);
    const int NGW = G * NWAVES;
#define PHASE_IDS() int tid_l = threadIdx.x; asm volatile("" : "+v"(tid_l)); const int lane = tid_l & 63, wave = __builtin_amdgcn_readfirstlane(tid_l >> 6), gw = vcu * NWAVES + wave; (void)lane; (void)gw
    bf16* Win_t = (bf16*)(ws + WS_WIN); bf16* Wglu_t = (bf16*)(ws + WS_WGLU); bf16* Wo_t = (bf16*)(ws + WS_WO); bf16* Wgu_t = (bf16*)(ws + WS_WGU); bf16* Wd_t = (bf16*)(ws + WS_WD);
    bf16* R1 = (bf16*)(ws + WS_R1); bf16* Qp = (bf16*)(ws + WS_Q); bf16* Kp = (bf16*)(ws + WS_K); bf16* Vt = (bf16*)(ws + WS_VT); bf16* MIX = (bf16*)(ws + WS_R2);
    bf16* A2 = (bf16*)(ws + WS_A2); float* Zst = (float*)(ws + WS_ZS); bf16* Zb = (bf16*)(ws + WS_Z); bf16* A3 = (bf16*)(ws + WS_A3); float* stat_a = (float*)(ctl + CW_STAT_A); float* stat_s = (float*)(ctl + CW_STAT_S); bf16* HID = (bf16*)(ws + WS_HID);

    {
        PHASE_IDS();
        if (bx < NG) ssm_precompute(a, bx, lds, tid_l);
        else {
            LAS float* scr = (LAS float*)(lds + wave * 16384);
            constexpr int I_IN = (DM / 64) * (D_IN / 32), I_GLU = (D_SSM / 64) * (D_SSM / 32), I_O = (DM / 64) * (DM / 32);
            constexpr int NITEMS = I_IN;
#define EARLY_DESC(D, IT) do { D = TrDesc{a.w_in, Win_t, a.g_pre_mix, DM, D_IN, MAP_WIN, (IT)}; } while (0)
            TrDesc dc, dn; TrRegs tc, tn;
            const int NCW = (G - NG) * NWAVES; int it = (bx - NG) * NWAVES + wave;
            if (it < NITEMS) { EARLY_DESC(dc, it); tr_load(dc, lane, tc); }
            while (it < NITEMS) {
                const int nx = it + NCW; const bool more = nx < NITEMS;
                if (more) { EARLY_DESC(dn, nx); tr_load(dn, lane, tn); }
                tr_finish(dc, tc, scr, lane);
                if (more) { dc = dn; tc = tn; }
                it = nx;
            }
#undef EARLY_DESC
        }
        for (int m = gw; m < M; m += 2 * NGW) {
            f32x4 v[2][8]; float s[2];
#pragma unroll
            for (int q = 0; q < 2; ++q) { const f32x4* xr = (const f32x4*)(a.x + (size_t)(m + q * NGW) * DM);
#pragma unroll
                for (int j = 0; j < 4; ++j) { v[q][2 * j] = xr[128 * j + 2 * lane]; v[q][2 * j + 1] = xr[128 * j + 2 * lane + 1]; } }
#pragma unroll
            for (int q = 0; q < 2; ++q) { float t = 0.f;
#pragma unroll
                for (int j = 0; j < 8; ++j) t += (v[q][j].x * v[q][j].x + v[q][j].y * v[q][j].y) + (v[q][j].z * v[q][j].z + v[q][j].w * v[q][j].w);
                s[q] = t; }
#pragma unroll
            for (int q = 0; q < 2; ++q) { const int mm = m + q * NGW;
                const float ms = wave_sum(s[q]) * (1.0f / DM) + RMS_EPS; const float r = 1.0f / sqrtf(ms);
                if (lane == 0) ((float*)(ws + WS_RX))[mm] = sqrtf(ms);
                v4u* o = (v4u*)(R1 + (size_t)mm * DM);
#pragma unroll
                for (int j = 0; j < 4; ++j) { v4u w; w.x = cvt_pk_bf16(v[q][2 * j].x * r, v[q][2 * j].y * r); w.y = cvt_pk_bf16(v[q][2 * j].z * r, v[q][2 * j].w * r);
                    w.z = cvt_pk_bf16(v[q][2 * j + 1].x * r, v[q][2 * j + 1].y * r); w.w = cvt_pk_bf16(v[q][2 * j + 1].z * r, v[q][2 * j + 1].w * r); o[64 * j + lane] = w; } }
        }
    }
    GRID_BAR();

    {
        PHASE_IDS();
        pg8::Gemm g{R1, Win_t, DM, DM, DM}; pg8::StaticOrder S; S.init(M, 2304, G, bx);
        LAS int* posl = (LAS int*)(lds + LDSCTL_OFF + 1024);
        if (tid_l < 256) posl[tid_l] = a.pos[team_pm * 256 + tid_l];
        LDS_WAIT(); __syncthreads();
        pg8::EpiQKU E{Qp, Kp, A2, posl};
        pg8::gemm_phase<pg8::EpiQKU, pg8::StaticOrder, true>(lds, g, S, E);
        pg8::Gemm g2{Win_t + (size_t)2304 * DM, R1, DM, DM, DM}; pg8::StaticOrder S2; S2.init(256, M, G, (bx + 192) % G);
        pg8::EpiBf16P E2{Vt, M};
        pg8::gemm_phase<pg8::EpiBf16P, pg8::StaticOrder, true>(lds, g2, S2, E2);
        {
            int tid_c = threadIdx.x; asm volatile("" : "+v"(tid_c)); const int lane = tid_c & 63, wave = __builtin_amdgcn_readfirstlane(tid_c >> 6);
            LAS float* scr = (LAS float*)(lds + wave * 16384);
            constexpr int I_G = (DM / 64) * (D_FF / 32), I_D = (D_FF / 64) * (DM / 32);
            const int cw = (bx & (G / 2 - 1)) * NWAVES + wave, NCW = (G / 2) * NWAVES;
            constexpr int I_GLU = (D_SSM / 64) * (D_SSM / 32), I_O = (DM / 64) * (DM / 32);
            constexpr int NIT = I_GLU + I_O + 2 * I_G + I_D;
#define FFN_DESC(D, IT) do { int r_ = (IT); if (r_ < I_GLU) { D = TrDesc{a.w_glu, Wglu_t, nullptr, D_SSM, D_SSM, MAP_PLAIN, r_}; } \
                else if (r_ < I_GLU + I_O) { r_ -= I_GLU; D = TrDesc{a.w_o, Wo_t, (r_ / (DM / 32) < 16) ? a.g_attn_out : (a.g_ssm_out - 1024), DM, DM, MAP_PLAIN, r_}; } \
                else if ((r_ -= I_GLU + I_O) < I_G) { D = TrDesc{a.w_gate, Wgu_t, a.g_pre_ffn, DM, D_FF, MAP_GATE, r_}; } else if (r_ < 2 * I_G) { D = TrDesc{a.w_up, Wgu_t, a.g_pre_ffn, DM, D_FF, MAP_UP, r_ - I_G}; } \
                else { D = TrDesc{a.w_down, Wd_t, nullptr, D_FF, DM, MAP_PLAIN, r_ - 2 * I_G}; } } while (0)
            TrDesc dc, dn; TrRegs tc, tn;
            const int it_hi = (bx >= G / 2) ? NIT : (bx < G / 4 ? 1536 : (I_GLU + I_O));
            int it = (bx >= G / 2) ? (I_GLU + I_O) + cw : (bx < G / 4 ? cw : 1536 + (cw - 512));
            const int NCWx = (bx >= G / 2) ? NCW : 512;
            if (it < it_hi) { FFN_DESC(dc, it); tr_load(dc, lane, tc); }
            while (it < it_hi) {
                const int nx = it + NCWx; const bool more = nx < it_hi;
                if (more) { FFN_DESC(dn, nx); tr_load(dn, lane, tn); }
                tr_finish(dc, tc, scr, lane);
                if (more) { dc = dn; tc = tn; }
                it = nx;
            }
#undef FFN_DESC
        }
    }
    GRID_BAR();

    {
        PHASE_IDS();
        {
            pg8::Gemm g{A2, (const bf16*)(ws + WS_BZ), A2LD, 256, 256}; pg8::DiagOrder S{G, bx, 256};
            pg8::EpiZ E{Zst};
            pg8::gemm_phase<pg8::EpiZ, pg8::DiagOrder, true>(lds, g, S, E);
        }
        asm volatile("s_waitcnt vmcnt(0)" ::: "memory"); __syncthreads();
        {
            typedef float f32x2v __attribute__((ext_vector_type(2)));
            const int seq = wave >> 2, seg = wave & 3, g = bx >> 2, b = 2 * (bx & 3) + seq;
            const float lr = ((const float*)(ws + WS_LAM))[(g * 64 + lane) * 2], li = ((const float*)(ws + WS_LAM))[(g * 64 + lane) * 2 + 1];
            const size_t row0 = (size_t)g * 1024 + b * 128 + 32 * seg;
            const f32x2v* zp = (const f32x2v*)Zst + row0 * 64 + lane;
            f32x2v zz[32];
#pragma unroll
            for (int i = 0; i < 32; ++i) zz[i] = zp[(size_t)i * 64];
            float tr = 0.f, ti = 0.f;
#pragma unroll
            for (int i = 0; i < 32; ++i) { const float nr = lr * tr - li * ti + zz[i].x, ni = lr * ti + li * tr + zz[i].y; tr = nr; ti = ni; }
            float pr = lr, pi = li;
#pragma unroll
            for (int q = 0; q < 5; ++q) { const float nr = pr * pr - pi * pi, ni = 2.f * pr * pi; pr = nr; pi = ni; }
            LAS f32x2v* X = (LAS f32x2v*)lds;
            X[wave * 64 + lane] = (f32x2v){tr, ti};
            LDS_WAIT(); __syncthreads();
            float sr = 0.f, si = 0.f;
            for (int s = 0; s < seg; ++s) { const f32x2v t = X[(seq * 4 + s) * 64 + lane]; const float nr = pr * sr - pi * si + t.x, ni = pr * si + pi * sr + t.y; sr = nr; si = ni; }
            unsigned* sp = (unsigned*)(A2 + row0 * A2LD + 256) + lane;
#pragma unroll
            for (int i = 0; i < 32; ++i) {
                sp[(size_t)i * (A2LD / 2)] = cvt_pk_bf16(sr, si);
                const float nr = lr * sr - li * si + zz[i].x, ni = lr * si + li * sr + zz[i].y; sr = nr; si = ni;
            }
        }
        asm volatile("s_waitcnt vmcnt(0)" ::: "memory"); __syncthreads();
        {
            pg8::Gemm g{A2, (const bf16*)(ws + WS_TC), A2LD, A2LD, A2LD}; pg8::DiagOrder S{G, bx, 256};
            pg8::EpiY E{Zb};
            pg8::gemm_phase<pg8::EpiY, pg8::DiagOrder, true>(lds, g, S, E);
        }
        attn_phase(lds, vcu, G, Qp, Kp, Vt, a.sinks, A3, DM, stat_a);
    }
    GRID_BAR();

    if (tid == 0) { unsigned same = 1u; const unsigned me = 0x100u | bar.x;
        for (int k = 0; k < 4; ++k) same &= (xb_ld(ctl + CW_TEAM + 64 * team_pm + 8 + k) == me) ? 1u : 0u;
        MISC[12] = same; }
    __syncthreads();
    {
        PHASE_IDS();
        pg8::Gemm g{Zb, Wglu_t, D_SSM, D_SSM, D_SSM}; pg8::StaticOrder S; S.init(M, D_SSM, G, bx);
        pg8::EpiGlu E{Zb, a.b_glu, A3 + D_ATTN, DM, stat_s};
        pg8::gemm_phase<pg8::EpiGlu, pg8::StaticOrder, true>(lds, g, S, E);
    }
    TEAM_BAR();

    {
        PHASE_IDS();
        pg8::Gemm g{A3, Wo_t, DM, DM, DM}; pg8::StaticOrder S; S.init(M, DM, G, bx);
        LAS float* ratl = (LAS float*)(lds + LDSCTL_OFF + 2048); LAS float* rsl = ratl + 256;
        if (tid_l < 256) { const int row = team_pm * 256 + tid_l;
            const float sa = __uint_as_float(__hip_atomic_load((const unsigned*)(stat_a + row), __ATOMIC_RELAXED, __HIP_MEMORY_SCOPE_AGENT)), ss = __uint_as_float(__hip_atomic_load((const unsigned*)(stat_s + row), __ATOMIC_RELAXED, __HIP_MEMORY_SCOPE_AGENT));
            const float ra = 1.0f / sqrtf(sa * (1.0f / 1024.0f) + RMS_EPS), rsi = sqrtf(ss * (1.0f / 1024.0f) + RMS_EPS);
            ratl[tid_l] = ra * rsi; rsl[tid_l] = 1.0f / rsi; }
        LDS_WAIT(); __syncthreads();
        pg8::EpiMix E{MIX, DM, ratl, rsl};
        pg8::gemm_phase<pg8::EpiMix, pg8::StaticOrder, true>(lds, g, S, E);
    }
    TEAM_BAR();

    {
        PHASE_IDS();
        float* RH = (float*)(ws + WS_RH); const float* RX = (const float*)(ws + WS_RX);
        f32x4 gq[8];
#pragma unroll
        for (int j = 0; j < 4; ++j) { gq[2 * j] = ((const f32x4*)a.g_post_mix)[128 * j + 2 * lane]; gq[2 * j + 1] = ((const f32x4*)a.g_post_mix)[128 * j + 2 * lane + 1]; }
        for (int it = 0; it < 4; ++it) { const int mb = team_pm * 256 + team_k * 64 + wave * 8 + it * 2;
            v4u mv[2][4], xv[2][4]; float rxi[2], sm[2];
#pragma unroll
            for (int q = 0; q < 2; ++q) { const v4u* mr = (const v4u*)(MIX + (size_t)(mb + q) * DM); const v4u* xr = (const v4u*)(R1 + (size_t)(mb + q) * DM); rxi[q] = RX[mb + q];
#pragma unroll
                for (int j = 0; j < 4; ++j) { mv[q][j] = mr[64 * j + lane]; xv[q][j] = xr[64 * j + lane]; } }
#pragma unroll
            for (int q = 0; q < 2; ++q) { float t = 0.f;
#pragma unroll
                for (int j = 0; j < 4; ++j)
#pragma unroll
                    for (int e = 0; e < 4; ++e) { const float m0 = bf_lo(mv[q][j][e]), m1 = bf_hi(mv[q][j][e]); t += m0 * m0 + m1 * m1; }
                sm[q] = t; }
#pragma unroll
            for (int q = 0; q < 2; ++q) {
                const float rm = 1.0f / sqrtf(wave_sum(sm[q]) * (1.0f / DM) + RMS_EPS), rx = rxi[q];
                float sh = 0.f; v4u* xo = (v4u*)(R1 + (size_t)(mb + q) * DM); f32x4 hq[8];
#pragma unroll
                for (int j = 0; j < 4; ++j) {
                    const f32x4 g0 = gq[2 * j], g1 = gq[2 * j + 1]; const v4u mj = mv[q][j], xj = xv[q][j];
                    f32x4 h0, h1;
                    h0.x = bf_lo(xj.x) * rx + bf_lo(mj.x) * rm * g0.x; h0.y = bf_hi(xj.x) * rx + bf_hi(mj.x) * rm * g0.y; h0.z = bf_lo(xj.y) * rx + bf_lo(mj.y) * rm * g0.z; h0.w = bf_hi(xj.y) * rx + bf_hi(mj.y) * rm * g0.w;
                    h1.x = bf_lo(xj.z) * rx + bf_lo(mj.z) * rm * g1.x; h1.y = bf_hi(xj.z) * rx + bf_hi(mj.z) * rm * g1.y; h1.z = bf_lo(xj.w) * rx + bf_lo(mj.w) * rm * g1.z; h1.w = bf_hi(xj.w) * rx + bf_hi(mj.w) * rm * g1.w;
                    sh += (h0.x * h0.x + h0.y * h0.y) + (h0.z * h0.z + h0.w * h0.w) + (h1.x * h1.x + h1.y * h1.y) + (h1.z * h1.z + h1.w * h1.w);
                    hq[2 * j] = h0; hq[2 * j + 1] = h1;
                }
                const float msh = wave_sum(sh) * (1.0f / DM) + RMS_EPS, rh = 1.0f / sqrtf(msh);
                if (lane == 0) RH[mb + q] = sqrtf(msh);
#pragma unroll
                for (int j = 0; j < 4; ++j) { const f32x4 h0 = hq[2 * j] * rh, h1 = hq[2 * j + 1] * rh;
                    v4u w; w.x = cvt_pk_bf16(h0.x, h0.y); w.y = cvt_pk_bf16(h0.z, h0.w); w.z = cvt_pk_bf16(h1.x, h1.y); w.w = cvt_pk_bf16(h1.z, h1.w); xo[64 * j + lane] = w; }
            }
        }
    }
    TEAM_BAR();

    {
        PHASE_IDS();
        pg8::Gemm g{R1, Wgu_t, DM, DM, DM}; pg8::StaticOrder S; S.init(M, 2 * D_FF, G, bx);
        pg8::EpiSwiGLU E{HID, D_FF, (const float*)(ws + WS_RH)};
        pg8::gemm_phase<pg8::EpiSwiGLU, pg8::StaticOrder, true>(lds, g, S, E);
    }
    TEAM_BAR();

    {
        PHASE_IDS();
        pg8::Gemm g{HID, Wd_t, D_FF, D_FF, D_FF}; pg8::StaticOrder S; S.init(M, DM, G, bx);
        pg8::EpiBf16P E{MIX, DM};
        pg8::gemm_phase<pg8::EpiBf16P, pg8::StaticOrder, true>(lds, g, S, E);
    }
    TEAM_BAR();

    {
        PHASE_IDS();
        f32x4 gq[8];
#pragma unroll
        for (int j = 0; j < 4; ++j) { gq[2 * j] = ((const f32x4*)a.g_post_ffn)[128 * j + 2 * lane]; gq[2 * j + 1] = ((const f32x4*)a.g_post_ffn)[128 * j + 2 * lane + 1]; }
        for (int it = 0; it < 4; ++it) { const int mb = team_pm * 256 + team_k * 64 + wave * 8 + it * 2;
            v4u fv[2][4], hv[2][4]; float sf[2], rhi[2];
#pragma unroll
            for (int q = 0; q < 2; ++q) { const v4u* fr = (const v4u*)(MIX + (size_t)(mb + q) * DM); const v4u* hr = (const v4u*)(R1 + (size_t)(mb + q) * DM); rhi[q] = ((const float*)(ws + WS_RH))[mb + q];
#pragma unroll
                for (int j = 0; j < 4; ++j) { fv[q][j] = fr[64 * j + lane]; hv[q][j] = hr[64 * j + lane]; } }
#pragma unroll
            for (int q = 0; q < 2; ++q) { float t = 0.f;
#pragma unroll
                for (int j = 0; j < 4; ++j)
#pragma unroll
                    for (int e = 0; e < 4; ++e) { const float f0 = bf_lo(fv[q][j][e]), f1 = bf_hi(fv[q][j][e]); t += f0 * f0 + f1 * f1; }
                sf[q] = t; }
#pragma unroll
            for (int q = 0; q < 2; ++q) {
                const float rf = 1.0f / sqrtf(wave_sum(sf[q]) * (1.0f / DM) + RMS_EPS), rx = rhi[q]; f32x4* ho = (f32x4*)(a.out + (size_t)(mb + q) * DM);
#pragma unroll
                for (int j = 0; j < 4; ++j) {
                    const f32x4 g0 = gq[2 * j], g1 = gq[2 * j + 1]; const v4u fj = fv[q][j], hj = hv[q][j]; f32x4 h0, h1;
                    h0.x = bf_lo(hj.x) * rx + bf_lo(fj.x) * rf * g0.x; h0.y = bf_hi(hj.x) * rx + bf_hi(fj.x) * rf * g0.y; h0.z = bf_lo(hj.y) * rx + bf_lo(fj.y) * rf * g0.z; h0.w = bf_hi(hj.y) * rx + bf_hi(fj.y) * rf * g0.w;
                    h1.x = bf_lo(hj.z) * rx + bf_lo(fj.z) * rf * g1.x; h1.y = bf_hi(hj.z) * rx + bf_hi(fj.z) * rf * g1.y; h1.z = bf_lo(hj.w) * rx + bf_lo(fj.w) * rf * g1.z; h1.w = bf_hi(hj.w) * rx + bf_hi(fj.w) * rf * g1.w;
                    ho[128 * j + 2 * lane] = h0; ho[128 * j + 2 * lane + 1] = h1;
                }
            }
        }
    }
}

extern "C" void kernel_launch(void* const* d_in, const int* in_sizes, int n_in, void* d_out, int out_size, void* d_ws, size_t ws_size, hipStream_t stream) {
    static int grid = 0;
    if (grid == 0) {
        if (n_in != 24 || in_sizes[0] != M * DM || out_size != M * DM || ws_size < WS_END) { fprintf(stderr, "kernel_launch: unexpected shapes (n_in %d, in0 %d, out %d, ws %zu)\n", n_in, n_in > 0 ? in_sizes[0] : -1, out_size, ws_size); grid = -1; return; }
        int dev = 0, cus = 0;
        if (hipGetDevice(&dev) != hipSuccess || hipDeviceGetAttribute(&cus, hipDeviceAttributeMultiprocessorCount, dev) != hipSuccess) { grid = -1; return; }
        if (hipFuncSetAttribute((const void*)hymba_fwd, hipFuncAttributeMaxDynamicSharedMemorySize, LDS_BYTES) != hipSuccess) { fprintf(stderr, "kernel_launch: hipFuncSetAttribute failed\n"); grid = -1; return; }
        int per_cu = 0;
        (void)hipOccupancyMaxActiveBlocksPerMultiprocessor(&per_cu, (const void*)hymba_fwd, NWAVES * 64, LDS_BYTES);
        (void)hipGetLastError();
        grid = cus;
        if (grid != 256) { fprintf(stderr, "kernel_launch: built for a 256-CU device (team structure, SSM unit map); found %d CUs\n", cus); grid = -1; return; }
    }
    if (grid < 0) return;
    (void)hipMemsetAsync((char*)d_ws + WS_CTL, 0, CTL_ZERO_BYTES, stream);
    Args a{};
    a.x = (const float*)d_in[0]; a.pos = (const int*)d_in[1]; a.g_pre_mix = (const float*)d_in[2]; a.w_in = (const float*)d_in[3]; a.sinks = (const float*)d_in[4];
    a.a_re = (const float*)d_in[5]; a.a_im = (const float*)d_in[6]; a.log_dt = (const float*)d_in[7]; a.b_re = (const float*)d_in[8]; a.b_im = (const float*)d_in[9];
    a.c_re = (const float*)d_in[10]; a.c_im = (const float*)d_in[11]; a.d_skip = (const float*)d_in[12]; a.w_glu = (const float*)d_in[13]; a.b_glu = (const float*)d_in[14];
    a.g_attn_out = (const float*)d_in[15]; a.g_ssm_out = (const float*)d_in[16]; a.w_o = (const float*)d_in[17]; a.g_post_mix = (const float*)d_in[18]; a.g_pre_ffn = (const float*)d_in[19];
    a.w_gate = (const float*)d_in[20]; a.w_up = (const float*)d_in[21]; a.w_down = (const float*)d_in[22]; a.g_post_ffn = (const float*)d_in[23];
    a.out = (float*)d_out; a.ws = (unsigned char*)d_ws;
    hipLaunchKernelGGL(hymba_fwd, dim3(grid), dim3(NWAVES * 64), LDS_BYTES, stream, a);
}
```

```cpp
#include <hip/hip_runtime.h>
#include <cstdio>
#include <cstdint>

namespace pg8 {
#define PG8_LAS __attribute__((address_space(3)))
typedef unsigned short bf16_t;
typedef short bf16x8 __attribute__((ext_vector_type(8)));
typedef float f32x4 __attribute__((ext_vector_type(4)));
typedef unsigned u32x4 __attribute__((ext_vector_type(4)));
constexpr int BM = 256, BK = 64, HALF = 128, HTB = HALF * BK * 2, STAGE_BYTES = 8 * HTB, NXCD = 8, WGM = 8;

__host__ __device__ __forceinline__ int lds_byte(int r, int c) { const int st = (r >> 4) * 2 + (c >> 5), rr = r & 15, cc = c & 31, ob = rr * 64 + cc * 2; return st * 1024 + (ob ^ (((ob >> 9) & 1) << 5)); }
__host__ __device__ __forceinline__ void stage_rc(int b, int& R, int& C) { const int st = b / 1024, sb = b % 1024, swz = sb ^ (((sb >> 9) & 1) << 5); R = (st >> 1) * 16 + swz / 64; C = (st & 1) * 32 + (swz % 64) / 2; }
__host__ __device__ __forceinline__ int perm32(int rho) { const int n = rho >> 4, i = rho & 15; return 8 * (i >> 2) + 4 * n + (i & 3); }

struct Unit { int pm, pn; };
struct Gemm { const bf16_t* A; const bf16_t* Bt; int lda, ldb, K; };

struct StaticOrder {
    int nM, nN, nwg, G, c;
    __host__ __device__ void init(int M, int N, int G_, int c_) { nM = M / BM; nN = N / BM; nwg = nM * nN; G = G_; c = c_; }
    __host__ __device__ bool next(int i, Unit& u) const {
        const long L = (long)i * G + c; if (L >= nwg) return false;
        int wgid = (int)L; { const int q = nwg / NXCD, r = nwg % NXCD, xcd = wgid % NXCD, off = wgid / NXCD; wgid = (xcd < r ? xcd * (q + 1) : r * (q + 1) + (xcd - r) * q) + off; }
        const int nig = WGM * nN, gid = wgid / nig, fm = gid * WGM, gsz = (nM - fm) < WGM ? (nM - fm) : WGM;
        u.pm = fm + ((wgid % nig) % gsz); u.pn = (wgid % nig) / gsz; return true;
    }
};
struct DiagOrder {
    int G, c, n;
    __host__ __device__ bool next(int i, Unit& u) const { const int L = i * G + c; if (L >= n) return false; u.pm = L; u.pn = L >> 2; return true; }
};

__device__ __forceinline__ unsigned cvt_pk_bf16(float lo, float hi) { unsigned r; asm volatile("v_cvt_pk_bf16_f32 %0, %1, %2" : "=v"(r) : "v"(lo), "v"(hi)); return r; }
__device__ __forceinline__ float bf_lo(unsigned w) { return __uint_as_float(w << 16); }
__device__ __forceinline__ float bf_hi(unsigned w) { return __uint_as_float(w & 0xffff0000u); }
__device__ __forceinline__ float sigmoidf_(float x) { return __builtin_amdgcn_rcpf(1.0f + __builtin_amdgcn_exp2f(-1.4426950408889634f * x)); }
__device__ __forceinline__ float gelu_tanh(float x) { const float u = 1.5957691216057308f * (x + 0.044715f * x * x * x); return x * sigmoidf_(u); }

constexpr float ATT_C2 = 0.125f * 1.4426950408889634f;

struct EpiBf16P {
    static constexpr bool PERM = true, MIDK = false;
    bf16_t* O; int ldc;
    __device__ __forceinline__ void operator()(const f32x4 (&acc)[2][2][4][2], const Unit& u, int wr, int wc, int fr, int fq) const {
        const int row0 = u.pm * BM + wr * 64 + fr, col0 = u.pn * BM + wc * 32 + 8 * fq;
#pragma unroll
        for (int ai = 0; ai < 2; ++ai)
#pragma unroll
            for (int m = 0; m < 4; ++m) { bf16_t* rowp = O + (size_t)(row0 + ai * HALF + m * 16) * ldc + col0;
#pragma unroll
                for (int bj = 0; bj < 2; ++bj) { const f32x4 v0 = acc[ai][bj][m][0], v1 = acc[ai][bj][m][1];
                    u32x4 w; w.x = cvt_pk_bf16(v0[0], v0[1]); w.y = cvt_pk_bf16(v0[2], v0[3]); w.z = cvt_pk_bf16(v1[0], v1[1]); w.w = cvt_pk_bf16(v1[2], v1[3]);
                    *(u32x4*)(rowp + bj * HALF) = w; } }
    }
};
struct EpiMix {
    static constexpr bool PERM = true, MIDK = true;
    bf16_t* O; int ldc; const PG8_LAS float* ratio; const PG8_LAS float* rsl;
    __device__ __forceinline__ void midk(f32x4 (&acc)[2][2][4][2], const Unit& u, int wr, int fr) const {
#pragma unroll
        for (int ai = 0; ai < 2; ++ai)
#pragma unroll
            for (int m = 0; m < 4; ++m) { const float rt = ratio[wr * 64 + fr + ai * HALF + m * 16];
#pragma unroll
                for (int bj = 0; bj < 2; ++bj)
#pragma unroll
                    for (int n = 0; n < 2; ++n) acc[ai][bj][m][n] *= rt; }
    }
    __device__ __forceinline__ void operator()(const f32x4 (&acc)[2][2][4][2], const Unit& u, int wr, int wc, int fr, int fq) const {
        const int row0 = u.pm * BM + wr * 64 + fr, col0 = u.pn * BM + wc * 32 + 8 * fq;
#pragma unroll
        for (int ai = 0; ai < 2; ++ai)
#pragma unroll
            for (int m = 0; m < 4; ++m) { const int row = row0 + ai * HALF + m * 16; bf16_t* rowp = O + (size_t)row * ldc + col0;
                const float rs = rsl[wr * 64 + fr + ai * HALF + m * 16];
#pragma unroll
                for (int bj = 0; bj < 2; ++bj) { const f32x4 v0 = acc[ai][bj][m][0] * rs, v1 = acc[ai][bj][m][1] * rs;
                    u32x4 w; w.x = cvt_pk_bf16(v0[0], v0[1]); w.y = cvt_pk_bf16(v0[2], v0[3]); w.z = cvt_pk_bf16(v1[0], v1[1]); w.w = cvt_pk_bf16(v1[2], v1[3]);
                    *(u32x4*)(rowp + bj * HALF) = w; } }
    }
};
struct EpiQKU {
    static constexpr bool PERM = true, MIDK = false;
    bf16_t* Q; bf16_t* Kp; bf16_t* A2; const PG8_LAS int* posl;
    __device__ __forceinline__ void operator()(const f32x4 (&acc)[2][2][4][2], const Unit& u, int wr, int wc, int fr, int fq) const {
        const int row0 = u.pm * BM + wr * 64 + fr, cw = wc * 32 + 8 * fq;
        if (u.pn < 5) {
            const bool isq = u.pn < 4; const float sc = isq ? ATT_C2 : 1.0f;
            const int i0 = (cw & 63) >> 1;
            float invf[4];
#pragma unroll
            for (int t = 0; t < 4; ++t) invf[t] = __builtin_amdgcn_exp2f(-(float)(i0 + t) * (13.287712379549449f / 32.0f));
            bf16_t* base = isq ? (Q + u.pn * 256) : Kp; const int ld = isq ? 1024 : 256;
#pragma unroll
            for (int ai = 0; ai < 2; ++ai)
#pragma unroll
                for (int m = 0; m < 4; ++m) { const int row = row0 + ai * HALF + m * 16; const float p = (float)posl[wr * 64 + fr + ai * HALF + m * 16];
                    float cs[4], sn[4];
#pragma unroll
                    for (int t = 0; t < 4; ++t) { const float ang = p * invf[t]; const float fr_ = __builtin_amdgcn_fractf(ang * 0.15915494309189535f); sn[t] = __builtin_amdgcn_sinf(fr_) * sc; cs[t] = __builtin_amdgcn_cosf(fr_) * sc; }
#pragma unroll
                    for (int bj = 0; bj < 2; ++bj) { const f32x4 v0 = acc[ai][bj][m][0], v1 = acc[ai][bj][m][1];
                        u32x4 w;
                        w.x = cvt_pk_bf16(v0[0] * cs[0] - v0[1] * sn[0], v0[1] * cs[0] + v0[0] * sn[0]);
                        w.y = cvt_pk_bf16(v0[2] * cs[1] - v0[3] * sn[1], v0[3] * cs[1] + v0[2] * sn[1]);
                        w.z = cvt_pk_bf16(v1[0] * cs[2] - v1[1] * sn[2], v1[1] * cs[2] + v1[0] * sn[2]);
                        w.w = cvt_pk_bf16(v1[2] * cs[3] - v1[3] * sn[3], v1[3] * cs[3] + v1[2] * sn[3]);
                        *(u32x4*)(base + (size_t)row * ld + bj * HALF + cw) = w; } }
        } else {
#pragma unroll
            for (int ai = 0; ai < 2; ++ai)
#pragma unroll
                for (int m = 0; m < 4; ++m) { const int row = row0 + ai * HALF + m * 16;
#pragma unroll
                    for (int bj = 0; bj < 2; ++bj) { const f32x4 v0 = acc[ai][bj][m][0], v1 = acc[ai][bj][m][1];
                        const int gcol = (u.pn - 5) * 256 + bj * HALF + cw, g = gcol >> 4, q0 = gcol & 15;
                        u32x4 w; w.x = cvt_pk_bf16(v0[0], v0[1]); w.y = cvt_pk_bf16(v0[2], v0[3]); w.z = cvt_pk_bf16(v1[0], v1[1]); w.w = cvt_pk_bf16(v1[2], v1[3]);
                        *(u32x4*)(A2 + (size_t)g * (1024 * 384) + (size_t)(row >> 4) * 384 + (row & 15) * 16 + q0) = w; } }
        }
    }
};
struct EpiZ {
    static constexpr bool PERM = false, MIDK = false;
    float* Z;
    __device__ __forceinline__ void operator()(const f32x4 (&acc)[2][2][4][2], const Unit& u, int wr, int wc, int fr, int fq) const {
        const int row0 = u.pm * BM + wr * 64 + fr, col0 = wc * 32 + 4 * fq;
#pragma unroll
        for (int ai = 0; ai < 2; ++ai)
#pragma unroll
            for (int m = 0; m < 4; ++m) { float* rowp = Z + (size_t)(row0 + ai * HALF + m * 16) * 128 + col0;
#pragma unroll
                for (int n = 0; n < 2; ++n) *(f32x4*)(rowp + n * 16) = acc[ai][0][m][n]; }
    }
};
struct EpiY {
    static constexpr bool PERM = true, MIDK = false;
    bf16_t* Zb;
    __device__ __forceinline__ void operator()(const f32x4 (&acc)[2][2][4][2], const Unit& u, int wr, int wc, int fr, int fq) const {
        const int row0 = u.pm * BM + wr * 64 + fr, g = u.pn;
#pragma unroll
        for (int ai = 0; ai < 2; ++ai)
#pragma unroll
            for (int m = 0; m < 4; ++m) { const int bc = (row0 + ai * HALF + m * 16) & 1023;
#pragma unroll
                for (int bj = 0; bj < 2; ++bj) { const f32x4 v0 = acc[ai][bj][m][0], v1 = acc[ai][bj][m][1];
                    const int j = 8 * bj + 2 * wc + (fq >> 1), p0 = 8 * (fq & 1);
                    u32x4 w; w.x = cvt_pk_bf16(gelu_tanh(v0[0]), gelu_tanh(v0[1])); w.y = cvt_pk_bf16(gelu_tanh(v0[2]), gelu_tanh(v0[3]));
                    w.z = cvt_pk_bf16(gelu_tanh(v1[0]), gelu_tanh(v1[1])); w.w = cvt_pk_bf16(gelu_tanh(v1[2]), gelu_tanh(v1[3]));
                    *(u32x4*)(Zb + (size_t)(bc * 16 + j) * 1024 + g * 16 + p0) = w; asm volatile("" ::: "memory"); } }
    }
};
struct EpiGlu {
    static constexpr bool PERM = true, MIDK = false;
    const bf16_t* Zb; const float* bias; bf16_t* O; int ldo; float* st;
    __device__ __forceinline__ void operator()(const f32x4 (&acc)[2][2][4][2], const Unit& u, int wr, int wc, int fr, int fq) const {
        const int row0 = u.pm * BM + wr * 64 + fr, col0 = u.pn * BM + wc * 32 + 8 * fq;
        float part[2][4];
#pragma unroll
        for (int ai = 0; ai < 2; ++ai)
#pragma unroll
            for (int m = 0; m < 4; ++m) part[ai][m] = 0.f;
#pragma unroll
        for (int bj = 0; bj < 2; ++bj) { const f32x4 b0 = *(const f32x4*)(bias + col0 + bj * HALF), b1 = *(const f32x4*)(bias + col0 + bj * HALF + 4);
#pragma unroll
            for (int ai = 0; ai < 2; ++ai)
#pragma unroll
                for (int m = 0; m < 4; ++m) { const int row = row0 + ai * HALF + m * 16;
                    const u32x4 zi = *(const u32x4*)(Zb + (size_t)row * 1024 + col0 + bj * HALF); const f32x4 v0 = acc[ai][bj][m][0] + b0, v1 = acc[ai][bj][m][1] + b1;
                    float e[8];
                    e[0] = bf_lo(zi.x) * sigmoidf_(v0[0]); e[1] = bf_hi(zi.x) * sigmoidf_(v0[1]); e[2] = bf_lo(zi.y) * sigmoidf_(v0[2]); e[3] = bf_hi(zi.y) * sigmoidf_(v0[3]);
                    e[4] = bf_lo(zi.z) * sigmoidf_(v1[0]); e[5] = bf_hi(zi.z) * sigmoidf_(v1[1]); e[6] = bf_lo(zi.w) * sigmoidf_(v1[2]); e[7] = bf_hi(zi.w) * sigmoidf_(v1[3]);
                    part[ai][m] += (e[0] * e[0] + e[1] * e[1]) + (e[2] * e[2] + e[3] * e[3]) + (e[4] * e[4] + e[5] * e[5]) + (e[6] * e[6] + e[7] * e[7]);
                    u32x4 w; w.x = cvt_pk_bf16(e[0], e[1]); w.y = cvt_pk_bf16(e[2], e[3]); w.z = cvt_pk_bf16(e[4], e[5]); w.w = cvt_pk_bf16(e[6], e[7]);
                    *(u32x4*)(O + (size_t)row * ldo + col0 + bj * HALF) = w; } }
#pragma unroll
        for (int ai = 0; ai < 2; ++ai)
#pragma unroll
            for (int m = 0; m < 4; ++m) { float p = part[ai][m]; p += __shfl_xor(p, 16); p += __shfl_xor(p, 32);
                if (fq == 0) (void)__hip_atomic_fetch_add(st + row0 + ai * HALF + m * 16, p, __ATOMIC_RELAXED, __HIP_MEMORY_SCOPE_AGENT); }
    }
};
struct EpiSwiGLU {
    static constexpr bool PERM = true, MIDK = false;
    bf16_t* O; int ldc; const float* rs;
    __device__ __forceinline__ void operator()(const f32x4 (&acc)[2][2][4][2], const Unit& u, int wr, int wc, int fr, int fq) const {
        const int row0 = u.pm * BM + wr * 64 + fr, col0 = u.pn * HALF + wc * 32 + 8 * fq;
#pragma unroll
        for (int ai = 0; ai < 2; ++ai)
#pragma unroll
            for (int m = 0; m < 4; ++m) {
                const f32x4 g0 = acc[ai][0][m][0], g1 = acc[ai][0][m][1], u0 = acc[ai][1][m][0], u1 = acc[ai][1][m][1];
                u32x4 w;
                w.x = cvt_pk_bf16(g0[0] * sigmoidf_(g0[0]) * u0[0], g0[1] * sigmoidf_(g0[1]) * u0[1]); w.y = cvt_pk_bf16(g0[2] * sigmoidf_(g0[2]) * u0[2], g0[3] * sigmoidf_(g0[3]) * u0[3]);
                w.z = cvt_pk_bf16(g1[0] * sigmoidf_(g1[0]) * u1[0], g1[1] * sigmoidf_(g1[1]) * u1[1]); w.w = cvt_pk_bf16(g1[2] * sigmoidf_(g1[2]) * u1[2], g1[3] * sigmoidf_(g1[3]) * u1[3]);
                *(u32x4*)(O + (size_t)(row0 + ai * HALF + m * 16) * ldc + col0) = w; }
    }
};

template <class Epi, class Sched, bool ALIGN_EPI>
__device__ __forceinline__ void gemm_phase(PG8_LAS unsigned char* lds, const Gemm g, const Sched& S, const Epi& E) {
    int tid_ = threadIdx.x; asm volatile("" : "+v"(tid_));
    const int tid = tid_, wid = __builtin_amdgcn_readfirstlane(tid >> 6), lane = tid & 63, wr = wid >> 2, wc = wid & 3, fr = lane & 15, fq = lane >> 4;
    const int nt = g.K / BK;
    unsigned voffA[2], voffB[2];
#pragma unroll
    for (int i = 0; i < 2; ++i) { int R, C; stage_rc(tid * 16 + i * 8192, R, C); const int Rb = Epi::PERM ? ((R & ~31) + perm32(R & 31)) : R;
        voffA[i] = (unsigned)(R * g.lda + C) * 2u; voffB[i] = (unsigned)(Rb * g.ldb + C) * 2u; }
    const size_t kstep = (size_t)(BK * 2);
    const size_t hstepA = (size_t)HALF * g.lda * 2, hstepB = (size_t)HALF * g.ldb * 2;
    const size_t tstepA = 2 * hstepA, tstepB = 2 * hstepB;
    const unsigned ldsw = (unsigned)wid * 1024u;
    const size_t tailoff = (size_t)(nt - 2) * (size_t)(BK * 2);
    const int aoff = lds_byte(wr * 64 + fr, fq * 8), boff = lds_byte(wc * 32 + fr, fq * 8);
#define PG8_SA(b, h) (((b) * 2 + (h)) * HTB)
#define PG8_SB(b, h) ((4 + (b) * 2 + (h)) * HTB)
#define PG8_STAGE(bufoff, gbase, voff) do { _Pragma("unroll") for (int _i = 0; _i < 2; ++_i) \
        __builtin_amdgcn_global_load_lds((const unsigned*)((const char*)(gbase) + (voff)[_i]), (PG8_LAS unsigned*)(lds + (bufoff) + ldsw + _i * 8192), 16, 0, 0); } while (0)
#define PG8_LDA(dst, b, h) do { _Pragma("unroll") for (int m = 0; m < 4; ++m) _Pragma("unroll") for (int k = 0; k < 2; ++k) dst[m][k] = *(const PG8_LAS bf16x8*)(lds + PG8_SA(b, h) + aoff + m * 2048 + k * 1024); } while (0)
#define PG8_LDB(dst, b, h) do { _Pragma("unroll") for (int n = 0; n < 2; ++n) _Pragma("unroll") for (int k = 0; k < 2; ++k) dst[n][k] = *(const PG8_LAS bf16x8*)(lds + PG8_SB(b, h) + boff + n * 2048 + k * 1024); } while (0)
#define PG8_MMA(ai, bj, At, Bt) do { __builtin_amdgcn_s_setprio(1); _Pragma("unroll") for (int m = 0; m < 4; ++m) _Pragma("unroll") for (int n = 0; n < 2; ++n) _Pragma("unroll") for (int k = 0; k < 2; ++k) \
        acc[ai][bj][m][n] = __builtin_amdgcn_mfma_f32_16x16x32_bf16(Bt[n][k], At[m][k], acc[ai][bj][m][n], 0, 0, 0); __builtin_amdgcn_s_setprio(0); } while (0)
#define PG8_WAIT_V(n) asm volatile("s_waitcnt vmcnt(" #n ")" ::: "memory")
#define PG8_WAIT_L(n) asm volatile("s_waitcnt lgkmcnt(" #n ")" ::: "memory")
#define PG8_BAR __builtin_amdgcn_s_barrier()
#define PG8_SCHED __builtin_amdgcn_sched_barrier(0)
    Unit cur, nxt; int ui = 0;
    if (!S.next(0, cur)) return;
    f32x4 acc[2][2][4][2];
#pragma unroll
    for (int a = 0; a < 2; ++a)
#pragma unroll
        for (int b = 0; b < 2; ++b)
#pragma unroll
            for (int m = 0; m < 4; ++m)
#pragma unroll
                for (int n = 0; n < 2; ++n) acc[a][b][m][n] = (f32x4){0.f, 0.f, 0.f, 0.f};
    bf16x8 At[4][2], B0[2][2], B1[2][2];
    const char* cA = (const char*)g.A + (size_t)cur.pm * tstepA; const char* cB = (const char*)g.Bt + (size_t)cur.pn * tstepB;
    PG8_STAGE(PG8_SB(0, 0), cB, voffB); PG8_STAGE(PG8_SB(0, 1), cB + hstepB, voffB); PG8_STAGE(PG8_SA(0, 0), cA, voffA); PG8_STAGE(PG8_SA(0, 1), cA + hstepA, voffA);
    if (wr == 1) PG8_BAR;
    PG8_WAIT_V(2); PG8_BAR;
    PG8_STAGE(PG8_SB(1, 0), cB + kstep, voffB); PG8_STAGE(PG8_SA(1, 0), cA + kstep, voffA); PG8_STAGE(PG8_SB(1, 1), cB + hstepB + kstep, voffB);
    PG8_WAIT_V(6); PG8_BAR;
    for (;;) {
        const bool has_next = S.next(ui + 1, nxt);
        const size_t tail_ = has_next ? 0 : tailoff; const char* nA = (has_next ? (const char*)g.A + (size_t)nxt.pm * tstepA : cA) + tail_; const char* nB = (has_next ? (const char*)g.Bt + (size_t)nxt.pn * tstepB : cB) + tail_;
        for (int t = 0; t < nt; t += 2) {
            if constexpr (Epi::MIDK) { if (t == (nt >> 1)) E.midk(acc, cur, wr, fr); }
            const bool last = (t == nt - 2);
            const char* a1 = cA + (size_t)(t + 1) * kstep;
            const char* a2 = last ? nA : cA + (size_t)(t + 2) * kstep; const char* b2 = last ? nB : cB + (size_t)(t + 2) * kstep;
            const char* a3 = a2 + kstep; const char* b3 = b2 + kstep;
            PG8_LDB(B0, 0, 0); PG8_LDB(B1, 0, 1); PG8_SCHED; PG8_LDA(At, 0, 0); PG8_STAGE(PG8_SA(1, 1), a1 + hstepA, voffA);
            PG8_WAIT_V(8); PG8_WAIT_L(0); PG8_BAR; PG8_MMA(0, 0, At, B0); PG8_MMA(0, 1, At, B1); PG8_BAR; PG8_SCHED;
            PG8_LDA(At, 0, 1); PG8_STAGE(PG8_SB(0, 0), b2, voffB); PG8_STAGE(PG8_SB(0, 1), b2 + hstepB, voffB); PG8_STAGE(PG8_SA(0, 0), a2, voffA);
            PG8_WAIT_V(8); PG8_WAIT_L(0); PG8_BAR; PG8_MMA(1, 0, At, B0); PG8_MMA(1, 1, At, B1); PG8_BAR; PG8_SCHED;
            PG8_LDB(B0, 1, 0); PG8_LDB(B1, 1, 1); PG8_SCHED; PG8_LDA(At, 1, 0); PG8_STAGE(PG8_SA(0, 1), a2 + hstepA, voffA);
            PG8_WAIT_V(8); PG8_WAIT_L(0); PG8_BAR; PG8_MMA(0, 0, At, B0); PG8_MMA(0, 1, At, B1); PG8_BAR; PG8_SCHED;
            PG8_LDA(At, 1, 1); PG8_STAGE(PG8_SB(1, 0), b3, voffB); PG8_STAGE(PG8_SB(1, 1), b3 + hstepB, voffB); PG8_STAGE(PG8_SA(1, 0), a3, voffA);
            PG8_WAIT_V(8); PG8_WAIT_L(0); PG8_BAR; PG8_MMA(1, 0, At, B0); PG8_MMA(1, 1, At, B1); PG8_BAR; PG8_SCHED;
        }
        if constexpr (ALIGN_EPI) { if (wr == 0) PG8_BAR; }
        E(acc, cur, wr, wc, fr, fq);
        if (!has_next) break;
#pragma unroll
        for (int a = 0; a < 2; ++a)
#pragma unroll
            for (int b = 0; b < 2; ++b)
#pragma unroll
                for (int m = 0; m < 4; ++m)
#pragma unroll
                    for (int n = 0; n < 2; ++n) acc[a][b][m][n] = (f32x4){0.f, 0.f, 0.f, 0.f};
        cur = nxt; cA = nA; cB = nB; ++ui;
        if constexpr (ALIGN_EPI) { if (wr == 1) PG8_BAR; }
    }
    PG8_WAIT_V(0);
    if constexpr (!ALIGN_EPI) { if (wr == 0) PG8_BAR; }
    PG8_BAR;
#undef PG8_SA
#undef PG8_SB
#undef PG8_STAGE
#undef PG8_LDA
#undef PG8_LDB
#undef PG8_MMA
#undef PG8_WAIT_V
#undef PG8_WAIT_L
#undef PG8_BAR
#undef PG8_SCHED
}
}

constexpr int NWAVES = 8;
constexpr int BATCH = 8, SEQ = 2048, DM = 2048, M = BATCH * SEQ;
constexpr int D_ATTN = 1024, D_KV = 256, D_SSM = 1024, D_IN = 2560, D_FF = 5632, NQH = 16, NKVH = 4, HD = 64;
constexpr int NG = 64, NST = 64, PCH = 16, CH = 16, NCH = SEQ / CH;
constexpr int A2LD = 384;
constexpr float RMS_EPS = 1e-6f;

constexpr size_t MiB = 1u << 20;
constexpr size_t WS_CTL = 0, CTL_ZERO_BYTES = 1 * MiB;
constexpr size_t WS_WIN = 2 * MiB, WS_WGLU = 12 * MiB, WS_WO = 14 * MiB, WS_WGU = 22 * MiB, WS_WD = 66 * MiB;
constexpr size_t WS_TC = 88 * MiB, WS_BZ = 100 * MiB, WS_LAM = 108 * MiB, WS_RH = 109 * MiB, WS_RX = 110 * MiB;
constexpr size_t WS_R1 = 112 * MiB;
constexpr size_t WS_R2 = 176 * MiB;
constexpr size_t WS_Q = WS_R2, WS_K = WS_R2 + 32 * MiB, WS_VT = WS_R2 + 40 * MiB;
constexpr size_t WS_A3 = 240 * MiB, WS_Z = 304 * MiB;
constexpr size_t WS_A2 = 336 * MiB;
constexpr size_t WS_ZS = 384 * MiB;
constexpr size_t WS_HID = 336 * MiB;
constexpr size_t WS_END = 512 * MiB;
constexpr int CW_BAR = 4096, CW_TEAM = 16384, CW_STAT_A = 65536, CW_STAT_S = 81920;

constexpr int RING_BYTES = 131072, LDSCTL_OFF = RING_BYTES, MISC_OFF = LDSCTL_OFF + 320, LDS_BYTES = 147456;

#define GAS __attribute__((address_space(1)))
#define LAS __attribute__((address_space(3)))
typedef unsigned short bf16;
typedef unsigned v4u __attribute__((ext_vector_type(4)));
typedef unsigned v2u __attribute__((ext_vector_type(2)));
typedef float f32x4 __attribute__((ext_vector_type(4)));
typedef float f32x16 __attribute__((ext_vector_type(16)));
typedef short bf16x8 __attribute__((ext_vector_type(8)));
#define LDS_WAIT() asm volatile("s_waitcnt lgkmcnt(0)" ::: "memory")
using pg8::cvt_pk_bf16; using pg8::bf_lo; using pg8::bf_hi;

#define XB_TMO      128
#define XB_XCNT(j)  (256  + 64 * (j))
#define XB_XSUB(j)  (1280 + 64 * (j))
#define XB_XGEN(j)  (2304 + 64 * (j))
#define XB_TOP      3328
#define XB_TOPGEN   3392
#define XCD_BAR_WORDS 3456
#define XB_SPIN_CAP (1u << 18)
__device__ __forceinline__ unsigned xb_ld(unsigned* p)              { return __hip_atomic_load(p, __ATOMIC_RELAXED, __HIP_MEMORY_SCOPE_AGENT); }
__device__ __forceinline__ unsigned xb_add(unsigned* p, unsigned v) { return __hip_atomic_fetch_add(p, v, __ATOMIC_RELAXED, __HIP_MEMORY_SCOPE_AGENT); }
__device__ __forceinline__ unsigned xb_xcc_id() { return (unsigned)__builtin_amdgcn_s_getreg((3 << 11) | 20) & 0xFu; }
#define XB_SPIN(cond, bar) do { unsigned _sp = 0; while (cond) { __builtin_amdgcn_s_sleep(1); \
    if ((++_sp & 255u) == 0u) { if (xb_ld(&(bar)[XB_TMO])) break; if (_sp > XB_SPIN_CAP) { atomicAdd(&(bar)[XB_TMO], 1u); break; } } } } while (0)
struct XcdBarrier { unsigned* bar; unsigned x; volatile LAS unsigned* st; };
__device__ __forceinline__ XcdBarrier xcd_barrier_post(unsigned* bar, volatile LAS unsigned* st) {
    XcdBarrier b; b.bar = bar; b.x = xb_xcc_id(); b.st = st;
    if (threadIdx.x == 0) (void)xb_add(&bar[XB_XCNT(b.x)], 1u);
    return b;
}
__device__ __forceinline__ void xcd_barrier_complete(unsigned* bar, unsigned x, unsigned& nloc, unsigned& nx) {
    const unsigned G = gridDim.x * gridDim.y * gridDim.z;
    unsigned sum, cnt, mine, sp = 0u;
    for (;;) {
        sum = 0u; cnt = 0u; mine = 0u;
#pragma unroll
        for (unsigned j = 0; j < 16; ++j) { const unsigned c = xb_ld(&bar[XB_XCNT(j)]); sum += c; cnt += (c > 0u) ? 1u : 0u; mine = (j == x) ? c : mine; }
        if (sum == G) break;
        __builtin_amdgcn_s_sleep(1);
        if ((++sp & 255u) == 0u) { if (xb_ld(&bar[XB_TMO])) break; if (sp > XB_SPIN_CAP) { atomicAdd(&bar[XB_TMO], 1u); break; } }
    }
    nloc = mine > 0u ? mine : 1u; nx = cnt > 0u ? cnt : 1u;
}
__device__ __forceinline__ void xcd_barrier(const XcdBarrier& b) {
    asm volatile("s_waitcnt vmcnt(0)" ::: "memory");
    __syncthreads();
    if (threadIdx.x == 0) {
        unsigned* bar = b.bar;
        __builtin_amdgcn_s_waitcnt(0);
        unsigned nloc = b.st[0], nx = b.st[1];
        if (nloc == 0u) { xcd_barrier_complete(bar, b.x, nloc, nx); b.st[0] = nloc; b.st[1] = nx; }
        const unsigned old = xb_add(&bar[XB_XSUB(b.x)], 1u);
        const unsigned gen = old / nloc;
        if (old + 1u == (gen + 1u) * nloc) {
            __builtin_amdgcn_fence(__ATOMIC_RELEASE, "agent");
            asm volatile("s_waitcnt vmcnt(0)" ::: "memory");
            const unsigned og = xb_add(&bar[XB_TOP], 1u);
            const unsigned tg = og / nx;
            if (og + 1u == (tg + 1u) * nx) xb_add(&bar[XB_TOPGEN], 1u);
            else XB_SPIN(xb_ld(&bar[XB_TOPGEN]) == tg, bar);
            __builtin_amdgcn_fence(__ATOMIC_ACQUIRE, "agent");
            xb_add(&bar[XB_XGEN(b.x)], 1u);
            asm volatile("s_waitcnt vmcnt(0)" ::: "memory");
        } else {
            XB_SPIN(xb_ld(&bar[XB_XGEN(b.x)]) == gen, bar);
            __builtin_amdgcn_fence(__ATOMIC_ACQUIRE, "agent");
            asm volatile("s_waitcnt vmcnt(0)" ::: "memory");
        }
    }
    __syncthreads();
}

__device__ __forceinline__ void team_barrier(unsigned* cnt, unsigned* tmo, unsigned& epoch, volatile LAS unsigned* same_xcd) {
    asm volatile("s_waitcnt vmcnt(0)" ::: "memory");
    __syncthreads();
    if (threadIdx.x == 0) {
        if (*same_xcd != 1u) { __builtin_amdgcn_fence(__ATOMIC_RELEASE, "agent"); }
        asm volatile("s_waitcnt vmcnt(0)" ::: "memory");
        (void)xb_add(cnt, 1u);
        const unsigned want = 4u * epoch; unsigned sp = 0u;
        while (xb_ld(cnt) < want) { __builtin_amdgcn_s_sleep(1); if ((++sp & 255u) == 0u) { if (xb_ld(tmo)) break; if (sp > XB_SPIN_CAP) { atomicAdd(tmo, 1u); break; } } }
        __builtin_amdgcn_fence(__ATOMIC_ACQUIRE, "agent");
        asm volatile("s_waitcnt vmcnt(0)" ::: "memory");
    }
    __syncthreads();
    ++epoch;
}

__device__ __forceinline__ float wave_sum(float v) {
#pragma unroll
    for (int o = 1; o < 64; o <<= 1) v += __shfl_xor(v, o);
    return v;
}
__device__ __forceinline__ void sincos_rev(double rev, float& s, float& c) {
    const double fr = rev - __builtin_rint(rev); const float f = (float)fr;
    s = __builtin_amdgcn_sinf(f); c = __builtin_amdgcn_cosf(f);
}
enum { MAP_PLAIN = 0, MAP_WIN = 1, MAP_GATE = 2, MAP_UP = 3 };
template <int MODE> __device__ __forceinline__ int map_row(int n) {
    if (MODE == MAP_WIN) {
        if (n < 1280) { const int d = n & 63; return (n & ~63) + (d < 32 ? 2 * d : 2 * (d - 32) + 1); }
        if (n < 1536) return 2304 + (n - 1280);
        return 1280 + (n - 1536);
    }
    if (MODE == MAP_GATE) return ((n >> 7) << 8) + (n & 127);
    if (MODE == MAP_UP) return ((n >> 7) << 8) + 128 + (n & 127);
    return n;
}
template <int MODE> __device__ __forceinline__ void transpose_item(const float* W, int K, int N, bf16* WT, const float* gs, LAS float* scr, int item, int lane) {
    const int nblk = N / 32, kb = item / nblk, nb = item % nblk, k0 = 64 * kb, n0 = 32 * nb;
    const float* src = W + (size_t)(k0 + (lane >> 5)) * N + n0 + (lane & 31);
    float v[32];
#pragma unroll
    for (int i = 0; i < 32; ++i) v[i] = src[(size_t)(2 * i) * N];
    const int c = lane & 7;
    f32x4 g0 = (f32x4){1.f, 1.f, 1.f, 1.f}, g1 = g0;
    if (gs) { g0 = *(const f32x4*)(gs + k0 + 8 * c); g1 = *(const f32x4*)(gs + k0 + 8 * c + 4); }
    LAS float* sw = scr + (lane >> 5) * 33 + (lane & 31);
#pragma unroll
    for (int i = 0; i < 32; ++i) sw[(2 * i) * 33] = v[i];
    LDS_WAIT(); asm volatile("" ::: "memory");
#pragma unroll
    for (int j = 0; j < 4; ++j) { const int n = (lane >> 3) + 8 * j; const LAS float* s = scr + (8 * c) * 33 + n;
        v4u o; o.x = cvt_pk_bf16(s[0 * 33] * g0.x, s[1 * 33] * g0.y); o.y = cvt_pk_bf16(s[2 * 33] * g0.z, s[3 * 33] * g0.w); o.z = cvt_pk_bf16(s[4 * 33] * g1.x, s[5 * 33] * g1.y); o.w = cvt_pk_bf16(s[6 * 33] * g1.z, s[7 * 33] * g1.w);
        *(v4u*)(WT + (size_t)map_row<MODE>(n0 + n) * K + k0 + 8 * c) = o; }
    LDS_WAIT(); asm volatile("" ::: "memory");
}

struct TrDesc { const float* W; bf16* WT; const float* gs; int K, N, mode, item; };
struct TrRegs { float v[32]; f32x4 g0, g1; };
__device__ __forceinline__ int map_row_rt(int mode, int n) {
    if (mode == MAP_WIN) return map_row<MAP_WIN>(n);
    if (mode == MAP_GATE) return map_row<MAP_GATE>(n);
    if (mode == MAP_UP) return map_row<MAP_UP>(n);
    return n;
}
__device__ __forceinline__ void tr_load(const TrDesc& d, int lane, TrRegs& t) {
    const int nblk = d.N / 32, kb = d.item / nblk, nb = d.item - kb * nblk, k0 = 64 * kb, n0 = 32 * nb;
    const float* src = d.W + (size_t)(k0 + (lane >> 5)) * d.N + n0 + (lane & 31);
#pragma unroll
    for (int i = 0; i < 32; ++i) t.v[i] = __builtin_nontemporal_load(src + (size_t)(2 * i) * d.N);
    const int c = lane & 7;
    t.g0 = (f32x4){1.f, 1.f, 1.f, 1.f}; t.g1 = t.g0;
    if (d.gs) { t.g0 = *(const f32x4*)(d.gs + k0 + 8 * c); t.g1 = *(const f32x4*)(d.gs + k0 + 8 * c + 4); }
}
__device__ __forceinline__ void tr_finish(const TrDesc& d, const TrRegs& t, LAS float* scr, int lane) {
    const int nblk = d.N / 32, kb = d.item / nblk, nb = d.item - kb * nblk, k0 = 64 * kb, n0 = 32 * nb, c = lane & 7;
    LAS float* sw = scr + (lane >> 5) * 33 + (lane & 31);
#pragma unroll
    for (int i = 0; i < 32; ++i) sw[(2 * i) * 33] = t.v[i];
    LDS_WAIT(); asm volatile("" ::: "memory");
#pragma unroll
    for (int j = 0; j < 4; ++j) { const int n = (lane >> 3) + 8 * j; const LAS float* s = scr + (8 * c) * 33 + n;
        v4u o; o.x = cvt_pk_bf16(s[0 * 33] * t.g0.x, s[1 * 33] * t.g0.y); o.y = cvt_pk_bf16(s[2 * 33] * t.g0.z, s[3 * 33] * t.g0.w); o.z = cvt_pk_bf16(s[4 * 33] * t.g1.x, s[5 * 33] * t.g1.y); o.w = cvt_pk_bf16(s[6 * 33] * t.g1.z, s[7 * 33] * t.g1.w);
        *(v4u*)(d.WT + (size_t)map_row_rt(d.mode, n0 + n) * d.K + k0 + 8 * c) = o; }
    LDS_WAIT(); asm volatile("" ::: "memory");
}

struct Args {
    const float* x; const int* pos; const float* g_pre_mix; const float* w_in; const float* sinks; const float* a_re; const float* a_im; const float* log_dt;
    const float* b_re; const float* b_im; const float* c_re; const float* c_im; const float* d_skip; const float* w_glu; const float* b_glu;
    const float* g_attn_out; const float* g_ssm_out; const float* w_o; const float* g_post_mix; const float* g_pre_ffn; const float* w_gate; const float* w_up;
    const float* w_down; const float* g_post_ffn; float* out; unsigned char* ws;
};

__device__ __forceinline__ void ssm_precompute(const Args& a, int g, LAS unsigned char* lds, int tid) {
    typedef float f32x2v __attribute__((ext_vector_type(2)));
    LAS f32x2v* P = (LAS f32x2v*)lds;
    LAS f32x2v* Bb = (LAS f32x2v*)(lds + 8704);
    LAS f32x2v* Cc = (LAS f32x2v*)(lds + 8704 + 8192);
    LAS float* Kk = (LAS float*)(lds + 8704 + 16384);
    const float dt = __builtin_amdgcn_exp2f(a.log_dt[g] * 1.4426950408889634f);
    for (int e = tid; e < 17 * 64; e += 512) { const int k = e >> 6, n = e & 63; const float ar = a.a_re[g * 64 + n], ai = a.a_im[g * 64 + n];
        const float mag = __builtin_amdgcn_exp2f((float)k * ar * dt * 1.4426950408889634f); float s, c; sincos_rev((double)k * (double)ai * (double)dt * 0.15915494309189535, s, c);
        P[e] = (f32x2v){mag * c, mag * s}; }
    for (int e = tid; e < 1024; e += 512) { const int n = e >> 4; const float ar = a.a_re[g * 64 + n], ai = a.a_im[g * 64 + n];
        const float mag = __builtin_amdgcn_exp2f(ar * dt * 1.4426950408889634f); float s, c; sincos_rev((double)ai * (double)dt * 0.15915494309189535, s, c);
        const float lr = mag * c, li = mag * s, den = ar * ar + ai * ai, nr = lr - 1.0f, ni = li;
        const float fre = (nr * ar + ni * ai) / den, fim = (ni * ar - nr * ai) / den;
        const float br = a.b_re[(size_t)g * 1024 + e], bi = a.b_im[(size_t)g * 1024 + e];
        Bb[e] = (f32x2v){fre * br - fim * bi, fre * bi + fim * br};
        Cc[e] = (f32x2v){a.c_re[(size_t)g * 1024 + e], a.c_im[(size_t)g * 1024 + e]}; }
    LDS_WAIT(); __syncthreads();
    for (int e = tid; e < 4096; e += 512) { const int k = e >> 8, p = (e >> 4) & 15, q = e & 15; float s = 0.f;
        for (int n = 0; n < 64; ++n) { const f32x2v c = Cc[p * 64 + n], l = P[k * 64 + n], b = Bb[n * 16 + q];
            const float tr = c.x * l.x - c.y * l.y, ti = c.x * l.y + c.y * l.x; s += tr * b.x - ti * b.y; }
        Kk[e] = s; }
    LDS_WAIT(); __syncthreads();
    bf16* TC = (bf16*)(a.ws + WS_TC) + (size_t)g * 256 * A2LD;
    bf16* BZ = (bf16*)(a.ws + WS_BZ) + (size_t)g * 256 * 256;
    {
        const int row = tid >> 1, j = row >> 4, p = row & 15; const float dp = a.d_skip[g * 16 + p];
        for (int ci = 0; ci < 16; ++ci) { const int col0 = 128 * (tid & 1) + 8 * ci, i = col0 >> 4, q0 = col0 & 15; float v[8];
#pragma unroll
            for (int e = 0; e < 8; ++e) { float t = 0.f; if (i <= j) { t = Kk[((j - i) * 16 + p) * 16 + q0 + e]; if (i == j && q0 + e == p) t += dp; } v[e] = t; }
            v4u o; o.x = cvt_pk_bf16(v[0], v[1]); o.y = cvt_pk_bf16(v[2], v[3]); o.z = cvt_pk_bf16(v[4], v[5]); o.w = cvt_pk_bf16(v[6], v[7]);
            *(v4u*)(TC + (size_t)row * A2LD + col0) = o; }
        for (int ci = 0; ci < 8; ++ci) { const int n0 = 32 * (tid & 1) + 4 * ci; float v[8];
#pragma unroll
            for (int e = 0; e < 4; ++e) { const f32x2v c = Cc[p * 64 + n0 + e], l = P[(j + 1) * 64 + n0 + e]; v[2 * e] = c.x * l.x - c.y * l.y; v[2 * e + 1] = -(c.x * l.y + c.y * l.x); }
            v4u o; o.x = cvt_pk_bf16(v[0], v[1]); o.y = cvt_pk_bf16(v[2], v[3]); o.z = cvt_pk_bf16(v[4], v[5]); o.w = cvt_pk_bf16(v[6], v[7]);
            *(v4u*)(TC + (size_t)row * A2LD + 256 + 2 * n0) = o; }
    }
    {
        const int row = tid >> 2, n = row >> 1, ri = row & 1;
        for (int ci = 0; ci < 8; ++ci) { const int col0 = 64 * (tid & 3) + 8 * ci, i = col0 >> 4, q0 = col0 & 15; float v[8];
#pragma unroll
            for (int e = 0; e < 8; ++e) { const f32x2v l = P[(15 - i) * 64 + n], b = Bb[n * 16 + q0 + e]; v[e] = ri ? (l.x * b.y + l.y * b.x) : (l.x * b.x - l.y * b.y); }
            v4u o; o.x = cvt_pk_bf16(v[0], v[1]); o.y = cvt_pk_bf16(v[2], v[3]); o.z = cvt_pk_bf16(v[4], v[5]); o.w = cvt_pk_bf16(v[6], v[7]);
            *(v4u*)(BZ + (size_t)row * 256 + col0) = o;
            *(v4u*)(BZ + (size_t)(128 + row) * 256 + col0) = (v4u){0u, 0u, 0u, 0u}; }
    }
    if (tid < 64) { const f32x2v l = P[16 * 64 + tid]; ((float*)(a.ws + WS_LAM))[(g * 64 + tid) * 2] = l.x; ((float*)(a.ws + WS_LAM))[(g * 64 + tid) * 2 + 1] = l.y; }
    LDS_WAIT(); __syncthreads();
}

constexpr int AT_KROW = 144, AT_VROW = 392, AT_V_OFF = 192 * AT_KROW, AT_LDS_BYTES = AT_V_OFF + 64 * AT_VROW;
__device__ __forceinline__ int crow(int r, int hi) { return (r & 3) + 8 * (r >> 2) + 4 * hi; }
__device__ __forceinline__ void attn_phase(LAS unsigned char* lds, int vcu, int G, const bf16* Qp, const bf16* Kp, const bf16* Vt, const float* sinks, bf16* AO, int ldo, float* st) {
    typedef unsigned long long u64;
    int tid = threadIdx.x; asm volatile("" : "+v"(tid));
    const int lane = tid & 63, wave = __builtin_amdgcn_readfirstlane(tid >> 6), r32 = lane & 31, hi = lane >> 5, hq = wave & 3, qsub = wave >> 2;
    const float NEG = -INFINITY;
    float ssq_acc = 0.f;
    for (int it = 0; it < 4; ++it) { const int id = ((vcu >> 5) << 7) | (it << 5) | (vcu & 31);
        const int b = id >> 7, kvh = (id >> 5) & 3, q0 = 64 * (id & 31), h = kvh * 4 + hq;
        const size_t tok0 = (size_t)b * SEQ;
        const int jt0 = (q0 >= 128) ? 0 : (128 - q0) / 32;
        v4u kv[3], vv[3];
#pragma unroll
        for (int i = 0; i < 3; ++i) { const int c = tid + 512 * i, row = c >> 3, ch = c & 7, key = q0 - 128 + row;
            if (key >= 0) kv[i] = *(const v4u*)(Kp + (tok0 + key) * D_KV + kvh * HD + ch * 8); }
#pragma unroll
        for (int i = 0; i < 3; ++i) { const int c = tid + 512 * i, d = c / 24, ch = c - d * 24, key0 = q0 - 128 + 8 * ch;
            if (key0 >= 0) vv[i] = *(const v4u*)(Vt + (size_t)(kvh * HD + d) * M + tok0 + key0); }
        const bf16* qrow = Qp + (tok0 + q0 + 32 * qsub + r32) * D_ATTN + h * HD + 32 * hi;
        bf16x8 qf[4];
#pragma unroll
        for (int kk = 0; kk < 4; ++kk) qf[kk] = *(const bf16x8*)(qrow + 8 * kk);
#pragma unroll
        for (int i = 0; i < 3; ++i) { const int c = tid + 512 * i, row = c >> 3, ch = c & 7, key = q0 - 128 + row;
            if (key >= 0) *(LAS v4u*)(lds + row * AT_KROW + ch * 16) = kv[i]; }
#pragma unroll
        for (int i = 0; i < 3; ++i) { const int c = tid + 512 * i, d = c / 24, ch = c - d * 24, key0 = q0 - 128 + 8 * ch;
            if (key0 >= 0) { LAS u64* p = (LAS u64*)(lds + AT_V_OFF + d * AT_VROW + ch * 16); p[0] = ((u64)vv[i].y << 32) | vv[i].x; p[1] = ((u64)vv[i].w << 32) | vv[i].z; } }
        LDS_WAIT(); __syncthreads();
        f32x16 s[5];
#pragma unroll
        for (int kt = 0; kt < 5; ++kt) {
            if (kt + qsub >= jt0) {
                const LAS unsigned char* kp = lds + (32 * (kt + qsub) + r32) * AT_KROW + 64 * hi;
                f32x16 acc = {0.f, 0.f, 0.f, 0.f, 0.f, 0.f, 0.f, 0.f, 0.f, 0.f, 0.f, 0.f, 0.f, 0.f, 0.f, 0.f};
#pragma unroll
                for (int kk = 0; kk < 4; ++kk) acc = __builtin_amdgcn_mfma_f32_32x32x16_bf16(*(const LAS bf16x8*)(kp + 16 * kk), qf[kk], acc, 0, 0, 0);
                s[kt] = acc;
            } else {
#pragma unroll
                for (int r = 0; r < 16; ++r) s[kt][r] = NEG;
            }
        }
#pragma unroll
        for (int r = 0; r < 16; ++r) { const int cr = crow(r, hi); if (!(cr > r32)) s[0][r] = NEG; if (!(cr <= r32)) s[4][r] = NEG; }
        const float sk = sinks[h] * 1.4426950408889634f;
        float mx = sk;
#pragma unroll
        for (int kt = 0; kt < 5; ++kt)
#pragma unroll
            for (int r = 0; r < 16; ++r) mx = fmaxf(mx, s[kt][r]);
        mx = fmaxf(mx, __shfl_xor(mx, 32));
        float l = 0.f;
#pragma unroll
        for (int kt = 0; kt < 5; ++kt)
#pragma unroll
            for (int r = 0; r < 16; ++r) { const float p = __builtin_amdgcn_exp2f(s[kt][r] - mx); s[kt][r] = p; l += p; }
        l += __shfl_xor(l, 32);
        l += __builtin_amdgcn_exp2f(sk - mx);
        const float inv = 1.0f / l;
        f32x16 o[2];
#pragma unroll
        for (int d = 0; d < 2; ++d)
#pragma unroll
            for (int r = 0; r < 16; ++r) o[d][r] = 0.f;
#pragma unroll
        for (int kt = 0; kt < 5; ++kt) {
            if (kt + qsub >= jt0) {
#pragma unroll
                for (int s2 = 0; s2 < 2; ++s2) {
                    v4u pw; pw.x = cvt_pk_bf16(s[kt][8 * s2 + 0] * inv, s[kt][8 * s2 + 1] * inv); pw.y = cvt_pk_bf16(s[kt][8 * s2 + 2] * inv, s[kt][8 * s2 + 3] * inv);
                    pw.z = cvt_pk_bf16(s[kt][8 * s2 + 4] * inv, s[kt][8 * s2 + 5] * inv); pw.w = cvt_pk_bf16(s[kt][8 * s2 + 6] * inv, s[kt][8 * s2 + 7] * inv);
                    const bf16x8 pf = __builtin_bit_cast(bf16x8, pw);
#pragma unroll
                    for (int dh = 0; dh < 2; ++dh) {
                        const LAS u64* vp = (const LAS u64*)(lds + AT_V_OFF + (dh * 32 + r32) * AT_VROW + (32 * (kt + qsub) + 16 * s2 + 4 * hi) * 2);
                        const u64 lo = vp[0], hi8 = vp[2];
                        const v4u vw = (v4u){(unsigned)lo, (unsigned)(lo >> 32), (unsigned)hi8, (unsigned)(hi8 >> 32)};
                        o[dh] = __builtin_amdgcn_mfma_f32_32x32x16_bf16(__builtin_bit_cast(bf16x8, vw), pf, o[dh], 0, 0, 0);
                    }
                }
            }
        }
        {
            float ssq = 0.f;
#pragma unroll
            for (int dh = 0; dh < 2; ++dh)
#pragma unroll
                for (int r = 0; r < 16; ++r) ssq += o[dh][r] * o[dh][r];
            ssq += __shfl_xor(ssq, 32);
            ssq_acc += ssq;
        }
        bf16* orow = AO + (tok0 + q0 + 32 * qsub + r32) * (size_t)ldo + h * HD + 4 * hi;
#pragma unroll
        for (int dh = 0; dh < 2; ++dh)
#pragma unroll
            for (int g4 = 0; g4 < 4; ++g4) { v2u w; w.x = cvt_pk_bf16(o[dh][4 * g4], o[dh][4 * g4 + 1]); w.y = cvt_pk_bf16(o[dh][4 * g4 + 2], o[dh][4 * g4 + 3]);
                *(v2u*)(orow + dh * 32 + 8 * g4) = w; }
        LDS_WAIT(); __syncthreads();
    }
    {
        LAS float* Xs = (LAS float*)lds;
        if (hi == 0) Xs[(qsub * 4 + hq) * 32 + r32] = ssq_acc;
        LDS_WAIT(); __syncthreads();
        if (hq == 0 && hi == 0) { const float tot = (Xs[(qsub * 4 + 0) * 32 + r32] + Xs[(qsub * 4 + 1) * 32 + r32]) + (Xs[(qsub * 4 + 2) * 32 + r32] + Xs[(qsub * 4 + 3) * 32 + r32]);
            st[(size_t)(vcu >> 5) * SEQ + 64 * (vcu & 31) + 32 * qsub + r32] = tot; }
        LDS_WAIT(); __syncthreads();
    }
}

__global__ void __launch_bounds__(NWAVES * 64, 2) hymba_fwd(Args a) {
    extern __shared__ __attribute__((aligned(16))) unsigned char lds_raw[];
    LAS unsigned char* lds = (LAS unsigned char*)lds_raw;
    volatile LAS unsigned* MISC = (volatile LAS unsigned*)(lds + MISC_OFF);
    const int tid = threadIdx.x;
    const int G = gridDim.x; const int bx = blockIdx.x; const int vcu = (G % 8 == 0) ? (bx % 8) * (G / 8) + bx / 8 : bx;
    unsigned char* ws = a.ws;
    unsigned* ctl = (unsigned*)(ws + WS_CTL);
    for (int u = tid; u < (LDS_BYTES - LDSCTL_OFF) / 4; u += NWAVES * 64) ((LAS unsigned*)(lds + LDSCTL_OFF))[u] = 0u;
    __syncthreads();
    XcdBarrier bar = xcd_barrier_post(ctl + CW_BAR, MISC + 8);
#define GRID_BAR() xcd_barrier(bar)
    const int team_pm = 8 * (bx & 7) + ((bx >> 3) & 7), team_k = bx >> 6;
    unsigned team_epoch = 1u;
#define TEAM_BAR() team_barrier(ctl + CW_TEAM + 64 * team_pm, ctl + CW_BAR + XB_TMO, team_epoch, MISC + 12)
    if (tid == 0) __hip_atomic_store(ctl + CW_TEAM + 64 * team_pm + 8 + team_k, 0x100u | bar.x, __ATOMIC_RELAXED, __HIP_MEMORY_SCOPE_AGENT);
    const int NGW = G * NWAVES;
#define PHASE_IDS() int tid_l = threadIdx.x; asm volatile("" : "+v"(tid_l)); const int lane = tid_l & 63, wave = __builtin_amdgcn_readfirstlane(tid_l >> 6), gw = vcu * NWAVES + wave; (void)lane; (void)gw
    bf16* Win_t = (bf16*)(ws + WS_WIN); bf16* Wglu_t = (bf16*)(ws + WS_WGLU); bf16* Wo_t = (bf16*)(ws + WS_WO); bf16* Wgu_t = (bf16*)(ws + WS_WGU); bf16* Wd_t = (bf16*)(ws + WS_WD);
    bf16* R1 = (bf16*)(ws + WS_R1); bf16* Qp = (bf16*)(ws + WS_Q); bf16* Kp = (bf16*)(ws + WS_K); bf16* Vt = (bf16*)(ws + WS_VT); bf16* MIX = (bf16*)(ws + WS_R2);
    bf16* A2 = (bf16*)(ws + WS_A2); float* Zst = (float*)(ws + WS_ZS); bf16* Zb = (bf16*)(ws + WS_Z); bf16* A3 = (bf16*)(ws + WS_A3); float* stat_a = (float*)(ctl + CW_STAT_A); float* stat_s = (float*)(ctl + CW_STAT_S); bf16* HID = (bf16*)(ws + WS_HID);

    {
        PHASE_IDS();
        if (bx < NG) ssm_precompute(a, bx, lds, tid_l);
        else {
            LAS float* scr = (LAS float*)(lds + wave * 16384);
            constexpr int I_IN = (DM / 64) * (D_IN / 32), I_GLU = (D_SSM / 64) * (D_SSM / 32), I_O = (DM / 64) * (DM / 32);
            constexpr int NITEMS = I_IN;
#define EARLY_DESC(D, IT) do { D = TrDesc{a.w_in, Win_t, a.g_pre_mix, DM, D_IN, MAP_WIN, (IT)}; } while (0)
            TrDesc dc, dn; TrRegs tc, tn;
            const int NCW = (G - NG) * NWAVES; int it = (bx - NG) * NWAVES + wave;
            if (it < NITEMS) { EARLY_DESC(dc, it); tr_load(dc, lane, tc); }
            while (it < NITEMS) {
                const int nx = it + NCW; const bool more = nx < NITEMS;
                if (more) { EARLY_DESC(dn, nx); tr_load(dn, lane, tn); }
                tr_finish(dc, tc, scr, lane);
                if (more) { dc = dn; tc = tn; }
                it = nx;
            }
#undef EARLY_DESC
        }
        for (int m = gw; m < M; m += 2 * NGW) {
            f32x4 v[2][8]; float s[2];
#pragma unroll
            for (int q = 0; q < 2; ++q) { const f32x4* xr = (const f32x4*)(a.x + (size_t)(m + q * NGW) * DM);
#pragma unroll
                for (int j = 0; j < 4; ++j) { v[q][2 * j] = xr[128 * j + 2 * lane]; v[q][2 * j + 1] = xr[128 * j + 2 * lane + 1]; } }
#pragma unroll
            for (int q = 0; q < 2; ++q) { float t = 0.f;
#pragma unroll
                for (int j = 0; j < 8; ++j) t += (v[q][j].x * v[q][j].x + v[q][j].y * v[q][j].y) + (v[q][j].z * v[q][j].z + v[q][j].w * v[q][j].w);
                s[q] = t; }
#pragma unroll
            for (int q = 0; q < 2; ++q) { const int mm = m + q * NGW;
                const float ms = wave_sum(s[q]) * (1.0f / DM) + RMS_EPS; const float r = 1.0f / sqrtf(ms);
                if (lane == 0) ((float*)(ws + WS_RX))[mm] = sqrtf(ms);
                v4u* o = (v4u*)(R1 + (size_t)mm * DM);
#pragma unroll
                for (int j = 0; j < 4; ++j) { v4u w; w.x = cvt_pk_bf16(v[q][2 * j].x * r, v[q][2 * j].y * r); w.y = cvt_pk_bf16(v[q][2 * j].z * r, v[q][2 * j].w * r);
                    w.z = cvt_pk_bf16(v[q][2 * j + 1].x * r, v[q][2 * j + 1].y * r); w.w = cvt_pk_bf16(v[q][2 * j + 1].z * r, v[q][2 * j + 1].w * r); o[64 * j + lane] = w; } }
        }
    }
    GRID_BAR();

    {
        PHASE_IDS();
        pg8::Gemm g{R1, Win_t, DM, DM, DM}; pg8::StaticOrder S; S.init(M, 2304, G, bx);
        LAS int* posl = (LAS int*)(lds + LDSCTL_OFF + 1024);
        if (tid_l < 256) posl[tid_l] = a.pos[team_pm * 256 + tid_l];
        LDS_WAIT(); __syncthreads();
        pg8::EpiQKU E{Qp, Kp, A2, posl};
        pg8::gemm_phase<pg8::EpiQKU, pg8::StaticOrder, true>(lds, g, S, E);
        pg8::Gemm g2{Win_t + (size_t)2304 * DM, R1, DM, DM, DM}; pg8::StaticOrder S2; S2.init(256, M, G, (bx + 192) % G);
        pg8::EpiBf16P E2{Vt, M};
        pg8::gemm_phase<pg8::EpiBf16P, pg8::StaticOrder, true>(lds, g2, S2, E2);
        {
            int tid_c = threadIdx.x; asm volatile("" : "+v"(tid_c)); const int lane = tid_c & 63, wave = __builtin_amdgcn_readfirstlane(tid_c >> 6);
            LAS float* scr = (LAS float*)(lds + wave * 16384);
            constexpr int I_G = (DM / 64) * (D_FF / 32), I_D = (D_FF / 64) * (DM / 32);
            const int cw = (bx & (G / 2 - 1)) * NWAVES + wave, NCW = (G / 2) * NWAVES;
            constexpr int I_GLU = (D_SSM / 64) * (D_SSM / 32), I_O = (DM / 64) * (DM / 32);
            constexpr int NIT = I_GLU + I_O + 2 * I_G + I_D;
#define FFN_DESC(D, IT) do { int r_ = (IT); if (r_ < I_GLU) { D = TrDesc{a.w_glu, Wglu_t, nullptr, D_SSM, D_SSM, MAP_PLAIN, r_}; } \
                else if (r_ < I_GLU + I_O) { r_ -= I_GLU; D = TrDesc{a.w_o, Wo_t, (r_ / (DM / 32) < 16) ? a.g_attn_out : (a.g_ssm_out - 1024), DM, DM, MAP_PLAIN, r_}; } \
                else if ((r_ -= I_GLU + I_O) < I_G) { D = TrDesc{a.w_gate, Wgu_t, a.g_pre_ffn, DM, D_FF, MAP_GATE, r_}; } else if (r_ < 2 * I_G) { D = TrDesc{a.w_up, Wgu_t, a.g_pre_ffn, DM, D_FF, MAP_UP, r_ - I_G}; } \
                else { D = TrDesc{a.w_down, Wd_t, nullptr, D_FF, DM, MAP_PLAIN, r_ - 2 * I_G}; } } while (0)
            TrDesc dc, dn; TrRegs tc, tn;
            const int it_hi = (bx >= G / 2) ? NIT : (bx < G / 4 ? 1536 : (I_GLU + I_O));
            int it = (bx >= G / 2) ? (I_GLU + I_O) + cw : (bx < G / 4 ? cw : 1536 + (cw - 512));
            const int NCWx = (bx >= G / 2) ? NCW : 512;
            if (it < it_hi) { FFN_DESC(dc, it); tr_load(dc, lane, tc); }
            while (it < it_hi) {
                const int nx = it + NCWx; const bool more = nx < it_hi;
                if (more) { FFN_DESC(dn, nx); tr_load(dn, lane, tn); }
                tr_finish(dc, tc, scr, lane);
                if (more) { dc = dn; tc = tn; }
                it = nx;
            }
#undef FFN_DESC
        }
    }
    GRID_BAR();

    {
        PHASE_IDS();
        {
            pg8::Gemm g{A2, (const bf16*)(ws + WS_BZ), A2LD, 256, 256}; pg8::DiagOrder S{G, bx, 256};
            pg8::EpiZ E{Zst};
            pg8::gemm_phase<pg8::EpiZ, pg8::DiagOrder, true>(lds, g, S, E);
        }
        asm volatile("s_waitcnt vmcnt(0)" ::: "memory"); __syncthreads();
        {
            typedef float f32x2v __attribute__((ext_vector_type(2)));
            const int seq = wave >> 2, seg = wave & 3, g = bx >> 2, b = 2 * (bx & 3) + seq;
            const float lr = ((const float*)(ws + WS_LAM))[(g * 64 + lane) * 2], li = ((const float*)(ws + WS_LAM))[(g * 64 + lane) * 2 + 1];
            const size_t row0 = (size_t)g * 1024 + b * 128 + 32 * seg;
            const f32x2v* zp = (const f32x2v*)Zst + row0 * 64 + lane;
            f32x2v zz[32];
#pragma unroll
            for (int i = 0; i < 32; ++i) zz[i] = zp[(size_t)i * 64];
            float tr = 0.f, ti = 0.f;
#pragma unroll
            for (int i = 0; i < 32; ++i) { const float nr = lr * tr - li * ti + zz[i].x, ni = lr * ti + li * tr + zz[i].y; tr = nr; ti = ni; }
            float pr = lr, pi = li;
#pragma unroll
            for (int q = 0; q < 5; ++q) { const float nr = pr * pr - pi * pi, ni = 2.f * pr * pi; pr = nr; pi = ni; }
            LAS f32x2v* X = (LAS f32x2v*)lds;
            X[wave * 64 + lane] = (f32x2v){tr, ti};
            LDS_WAIT(); __syncthreads();
            float sr = 0.f, si = 0.f;
            for (int s = 0; s < seg; ++s) { const f32x2v t = X[(seq * 4 + s) * 64 + lane]; const float nr = pr * sr - pi * si + t.x, ni = pr * si + pi * sr + t.y; sr = nr; si = ni; }
            unsigned* sp = (unsigned*)(A2 + row0 * A2LD + 256) + lane;
#pragma unroll
            for (int i = 0; i < 32; ++i) {
                sp[(size_t)i * (A2LD / 2)] = cvt_pk_bf16(sr, si);
                const float nr = lr * sr - li * si + zz[i].x, ni = lr * si + li * sr + zz[i].y; sr = nr; si = ni;
            }
        }
        asm volatile("s_waitcnt vmcnt(0)" ::: "memory"); __syncthreads();
        {
            pg8::Gemm g{A2, (const bf16*)(ws + WS_TC), A2LD, A2LD, A2LD}; pg8::DiagOrder S{G, bx, 256};
            pg8::EpiY E{Zb};
            pg8::gemm_phase<pg8::EpiY, pg8::DiagOrder, true>(lds, g, S, E);
        }
        attn_phase(lds, vcu, G, Qp, Kp, Vt, a.sinks, A3, DM, stat_a);
    }
    GRID_BAR();

    if (tid == 0) { unsigned same = 1u; const unsigned me = 0x100u | bar.x;
        for (int k = 0; k < 4; ++k) same &= (xb_ld(ctl + CW_TEAM + 64 * team_pm + 8 + k) == me) ? 1u : 0u;
        MISC[12] = same; }
    __syncthreads();
    {
        PHASE_IDS();
        pg8::Gemm g{Zb, Wglu_t, D_SSM, D_SSM, D_SSM}; pg8::StaticOrder S; S.init(M, D_SSM, G, bx);
        pg8::EpiGlu E{Zb, a.b_glu, A3 + D_ATTN, DM, stat_s};
        pg8::gemm_phase<pg8::EpiGlu, pg8::StaticOrder, true>(lds, g, S, E);
    }
    TEAM_BAR();

    {
        PHASE_IDS();
        pg8::Gemm g{A3, Wo_t, DM, DM, DM}; pg8::StaticOrder S; S.init(M, DM, G, bx);
        LAS float* ratl = (LAS float*)(lds + LDSCTL_OFF + 2048); LAS float* rsl = ratl + 256;
        if (tid_l < 256) { const int row = team_pm * 256 + tid_l;
            const float sa = __uint_as_float(__hip_atomic_load((const unsigned*)(stat_a + row), __ATOMIC_RELAXED, __HIP_MEMORY_SCOPE_AGENT)), ss = __uint_as_float(__hip_atomic_load((const unsigned*)(stat_s + row), __ATOMIC_RELAXED, __HIP_MEMORY_SCOPE_AGENT));
            const float ra = 1.0f / sqrtf(sa * (1.0f / 1024.0f) + RMS_EPS), rsi = sqrtf(ss * (1.0f / 1024.0f) + RMS_EPS);
            ratl[tid_l] = ra * rsi; rsl[tid_l] = 1.0f / rsi; }
        LDS_WAIT(); __syncthreads();
        pg8::EpiMix E{MIX, DM, ratl, rsl};
        pg8::gemm_phase<pg8::EpiMix, pg8::StaticOrder, true>(lds, g, S, E);
    }
    TEAM_BAR();

    {
        PHASE_IDS();
        float* RH = (float*)(ws + WS_RH); const float* RX = (const float*)(ws + WS_RX);
        f32x4 gq[8];
#pragma unroll
        for (int j = 0; j < 4; ++j) { gq[2 * j] = ((const f32x4*)a.g_post_mix)[128 * j + 2 * lane]; gq[2 * j + 1] = ((const f32x4*)a.g_post_mix)[128 * j + 2 * lane + 1]; }
        for (int it = 0; it < 4; ++it) { const int mb = team_pm * 256 + team_k * 64 + wave * 8 + it * 2;
            v4u mv[2][4], xv[2][4]; float rxi[2], sm[2];
#pragma unroll
            for (int q = 0; q < 2; ++q) { const v4u* mr = (const v4u*)(MIX + (size_t)(mb + q) * DM); const v4u* xr = (const v4u*)(R1 + (size_t)(mb + q) * DM); rxi[q] = RX[mb + q];
#pragma unroll
                for (int j = 0; j < 4; ++j) { mv[q][j] = mr[64 * j + lane]; xv[q][j] = xr[64 * j + lane]; } }
#pragma unroll
            for (int q = 0; q < 2; ++q) { float t = 0.f;
#pragma unroll
                for (int j = 0; j < 4; ++j)
#pragma unroll
                    for (int e = 0; e < 4; ++e) { const float m0 = bf_lo(mv[q][j][e]), m1 = bf_hi(mv[q][j][e]); t += m0 * m0 + m1 * m1; }
                sm[q] = t; }
#pragma unroll
            for (int q = 0; q < 2; ++q) {
                const float rm = 1.0f / sqrtf(wave_sum(sm[q]) * (1.0f / DM) + RMS_EPS), rx = rxi[q];
                float sh = 0.f; v4u* xo = (v4u*)(R1 + (size_t)(mb + q) * DM); f32x4 hq[8];
#pragma unroll
                for (int j = 0; j < 4; ++j) {
                    const f32x4 g0 = gq[2 * j], g1 = gq[2 * j + 1]; const v4u mj = mv[q][j], xj = xv[q][j];
                    f32x4 h0, h1;
                    h0.x = bf_lo(xj.x) * rx + bf_lo(mj.x) * rm * g0.x; h0.y = bf_hi(xj.x) * rx + bf_hi(mj.x) * rm * g0.y; h0.z = bf_lo(xj.y) * rx + bf_lo(mj.y) * rm * g0.z; h0.w = bf_hi(xj.y) * rx + bf_hi(mj.y) * rm * g0.w;
                    h1.x = bf_lo(xj.z) * rx + bf_lo(mj.z) * rm * g1.x; h1.y = bf_hi(xj.z) * rx + bf_hi(mj.z) * rm * g1.y; h1.z = bf_lo(xj.w) * rx + bf_lo(mj.w) * rm * g1.z; h1.w = bf_hi(xj.w) * rx + bf_hi(mj.w) * rm * g1.w;
                    sh += (h0.x * h0.x + h0.y * h0.y) + (h0.z * h0.z + h0.w * h0.w) + (h1.x * h1.x + h1.y * h1.y) + (h1.z * h1.z + h1.w * h1.w);
                    hq[2 * j] = h0; hq[2 * j + 1] = h1;
                }
                const float msh = wave_sum(sh) * (1.0f / DM) + RMS_EPS, rh = 1.0f / sqrtf(msh);
                if (lane == 0) RH[mb + q] = sqrtf(msh);
#pragma unroll
                for (int j = 0; j < 4; ++j) { const f32x4 h0 = hq[2 * j] * rh, h1 = hq[2 * j + 1] * rh;
                    v4u w; w.x = cvt_pk_bf16(h0.x, h0.y); w.y = cvt_pk_bf16(h0.z, h0.w); w.z = cvt_pk_bf16(h1.x, h1.y); w.w = cvt_pk_bf16(h1.z, h1.w); xo[64 * j + lane] = w; }
            }
        }
    }
    TEAM_BAR();

    {
        PHASE_IDS();
        pg8::Gemm g{R1, Wgu_t, DM, DM, DM}; pg8::StaticOrder S; S.init(M, 2 * D_FF, G, bx);
        pg8::EpiSwiGLU E{HID, D_FF, (const float*)(ws + WS_RH)};
        pg8::gemm_phase<pg8::EpiSwiGLU, pg8::StaticOrder, true>(lds, g, S, E);
    }
    TEAM_BAR();

    {
        PHASE_IDS();
        pg8::Gemm g{HID, Wd_t, D_FF, D_FF, D_FF}; pg8::StaticOrder S; S.init(M, DM, G, bx);
        pg8::EpiBf16P E{MIX, DM};
        pg8::gemm_phase<pg8::EpiBf16P, pg8::StaticOrder, true>(lds, g, S, E);
    }
    TEAM_BAR();

    {
        PHASE_IDS();
        f32x4 gq[8];
#pragma unroll
        for (int j = 0; j < 4; ++j) { gq[2 * j] = ((const f32x4*)a.g_post_ffn)[128 * j + 2 * lane]; gq[2 * j + 1] = ((const f32x4*)a.g_post_ffn)[128 * j + 2 * lane + 1]; }
        for (int it = 0; it < 4; ++it) { const int mb = team_pm * 256 + team_k * 64 + wave * 8 + it * 2;
            v4u fv[2][4], hv[2][4]; float sf[2], rhi[2];
#pragma unroll
            for (int q = 0; q < 2; ++q) { const v4u* fr = (const v4u*)(MIX + (size_t)(mb + q) * DM); const v4u* hr = (const v4u*)(R1 + (size_t)(mb + q) * DM); rhi[q] = ((const float*)(ws + WS_RH))[mb + q];
#pragma unroll
                for (int j = 0; j < 4; ++j) { fv[q][j] = fr[64 * j + lane]; hv[q][j] = hr[64 * j + lane]; } }
#pragma unroll
            for (int q = 0; q < 2; ++q) { float t = 0.f;
#pragma unroll
                for (int j = 0; j < 4; ++j)
#pragma unroll
                    for (int e = 0; e < 4; ++e) { const float f0 = bf_lo(fv[q][j][e]), f1 = bf_hi(fv[q][j][e]); t += f0 * f0 + f1 * f1; }
                sf[q] = t; }
#pragma unroll
            for (int q = 0; q < 2; ++q) {
                const float rf = 1.0f / sqrtf(wave_sum(sf[q]) * (1.0f / DM) + RMS_EPS), rx = rhi[q]; f32x4* ho = (f32x4*)(a.out + (size_t)(mb + q) * DM);
#pragma unroll
                for (int j = 0; j < 4; ++j) {
                    const f32x4 g0 = gq[2 * j], g1 = gq[2 * j + 1]; const v4u fj = fv[q][j], hj = hv[q][j]; f32x4 h0, h1;
                    h0.x = bf_lo(hj.x) * rx + bf_lo(fj.x) * rf * g0.x; h0.y = bf_hi(hj.x) * rx + bf_hi(fj.x) * rf * g0.y; h0.z = bf_lo(hj.y) * rx + bf_lo(fj.y) * rf * g0.z; h0.w = bf_hi(hj.y) * rx + bf_hi(fj.y) * rf * g0.w;
                    h1.x = bf_lo(hj.z) * rx + bf_lo(fj.z) * rf * g1.x; h1.y = bf_hi(hj.z) * rx + bf_hi(fj.z) * rf * g1.y; h1.z = bf_lo(hj.w) * rx + bf_lo(fj.w) * rf * g1.z; h1.w = bf_hi(hj.w) * rx + bf_hi(fj.w) * rf * g1.w;
                    ho[128 * j + 2 * lane] = h0; ho[128 * j + 2 * lane + 1] = h1;
                }
            }
        }
    }
}

extern "C" void kernel_launch(void* const* d_in, const int* in_sizes, int n_in, void* d_out, int out_size, void* d_ws, size_t ws_size, hipStream_t stream) {
    static int grid = 0;
    if (grid == 0) {
        if (n_in != 24 || in_sizes[0] != M * DM || out_size != M * DM || ws_size < WS_END) { fprintf(stderr, "kernel_launch: unexpected shapes (n_in %d, in0 %d, out %d, ws %zu)\n", n_in, n_in > 0 ? in_sizes[0] : -1, out_size, ws_size); grid = -1; return; }
        int dev = 0, cus = 0;
        if (hipGetDevice(&dev) != hipSuccess || hipDeviceGetAttribute(&cus, hipDeviceAttributeMultiprocessorCount, dev) != hipSuccess) { grid = -1; return; }
        if (hipFuncSetAttribute((const void*)hymba_fwd, hipFuncAttributeMaxDynamicSharedMemorySize, LDS_BYTES) != hipSuccess) { fprintf(stderr, "kernel_launch: hipFuncSetAttribute failed\n"); grid = -1; return; }
        int per_cu = 0;
        (void)hipOccupancyMaxActiveBlocksPerMultiprocessor(&per_cu, (const void*)hymba_fwd, NWAVES * 64, LDS_BYTES);
        (void)hipGetLastError();
        grid = cus;
        if (grid != 256) { fprintf(stderr, "kernel_launch: built for a 256-CU device (team structure, SSM unit map); found %d CUs\n", cus); grid = -1; return; }
    }
    if (grid < 0) return;
    (void)hipMemsetAsync((char*)d_ws + WS_CTL, 0, CTL_ZERO_BYTES, stream);
    Args a{};
    a.x = (const float*)d_in[0]; a.pos = (const int*)d_in[1]; a.g_pre_mix = (const float*)d_in[2]; a.w_in = (const float*)d_in[3]; a.sinks = (const float*)d_in[4];
    a.a_re = (const float*)d_in[5]; a.a_im = (const float*)d_in[6]; a.log_dt = (const float*)d_in[7]; a.b_re = (const float*)d_in[8]; a.b_im = (const float*)d_in[9];
    a.c_re = (const float*)d_in[10]; a.c_im = (const float*)d_in[11]; a.d_skip = (const float*)d_in[12]; a.w_glu = (const float*)d_in[13]; a.b_glu = (const float*)d_in[14];
    a.g_attn_out = (const float*)d_in[15]; a.g_ssm_out = (const float*)d_in[16]; a.w_o = (const float*)d_in[17]; a.g_post_mix = (const float*)d_in[18]; a.g_pre_ffn = (const float*)d_in[19];
    a.w_gate = (const float*)d_in[20]; a.w_up = (const float*)d_in[21]; a.w_down = (const float*)d_in[22]; a.g_post_ffn = (const float*)d_in[23];
    a.out = (float*)d_out; a.ws = (unsigned char*)d_ws;
    hipLaunchKernelGGL(hymba_fwd, dim3(grid), dim3(NWAVES * 64), LDS_BYTES, stream, a);
}
```

```cpp
#include <hip/hip_runtime.h>
#include <cstdio>
#include <cstdint>

namespace pg8 {
#define PG8_LAS __attribute__((address_space(3)))
typedef unsigned short bf16_t;
typedef short bf16x8 __attribute__((ext_vector_type(8)));
typedef float f32x4 __attribute__((ext_vector_type(4)));
typedef unsigned u32x4 __attribute__((ext_vector_type(4)));
constexpr int BM = 256, BK = 64, HALF = 128, HTB = HALF * BK * 2, STAGE_BYTES = 8 * HTB, NXCD = 8, WGM = 8;

__host__ __device__ __forceinline__ int lds_byte(int r, int c) { const int st = (r >> 4) * 2 + (c >> 5), rr = r & 15, cc = c & 31, ob = rr * 64 + cc * 2; return st * 1024 + (ob ^ (((ob >> 9) & 1) << 5)); }
__host__ __device__ __forceinline__ void stage_rc(int b, int& R, int& C) { const int st = b / 1024, sb = b % 1024, swz = sb ^ (((sb >> 9) & 1) << 5); R = (st >> 1) * 16 + swz / 64; C = (st & 1) * 32 + (swz % 64) / 2; }
__host__ __device__ __forceinline__ int perm32(int rho) { const int n = rho >> 4, i = rho & 15; return 8 * (i >> 2) + 4 * n + (i & 3); }

struct Unit { int pm, pn; };
struct Gemm { const bf16_t* A; const bf16_t* Bt; int lda, ldb, K; };

struct StaticOrder {
    int nM, nN, nwg, G, c;
    __host__ __device__ void init(int M, int N, int G_, int c_) { nM = M / BM; nN = N / BM; nwg = nM * nN; G = G_; c = c_; }
    __host__ __device__ bool next(int i, Unit& u) const {
        const long L = (long)i * G + c; if (L >= nwg) return false;
        int wgid = (int)L; { const int q = nwg / NXCD, r = nwg % NXCD, xcd = wgid % NXCD, off = wgid / NXCD; wgid = (xcd < r ? xcd * (q + 1) : r * (q + 1) + (xcd - r) * q) + off; }
        const int nig = WGM * nN, gid = wgid / nig, fm = gid * WGM, gsz = (nM - fm) < WGM ? (nM - fm) : WGM;
        u.pm = fm + ((wgid % nig) % gsz); u.pn = (wgid % nig) / gsz; return true;
    }
};
struct DiagOrder {
    int G, c, n;
    __host__ __device__ bool next(int i, Unit& u) const { const int L = i * G + c; if (L >= n) return false; u.pm = L; u.pn = L >> 2; return true; }
};

__device__ __forceinline__ unsigned cvt_pk_bf16(float lo, float hi) { unsigned r; asm volatile("v_cvt_pk_bf16_f32 %0, %1, %2" : "=v"(r) : "v"(lo), "v"(hi)); return r; }
__device__ __forceinline__ float bf_lo(unsigned w) { return __uint_as_float(w << 16); }
__device__ __forceinline__ float bf_hi(unsigned w) { return __uint_as_float(w & 0xffff0000u); }
__device__ __forceinline__ float sigmoidf_(float x) { return __builtin_amdgcn_rcpf(1.0f + __builtin_amdgcn_exp2f(-1.4426950408889634f * x)); }
__device__ __forceinline__ float gelu_tanh(float x) { const float u = 1.5957691216057308f * (x + 0.044715f * x * x * x); return x * sigmoidf_(u); }

constexpr float ATT_C2 = 0.125f * 1.4426950408889634f;

struct EpiBf16P {
    static constexpr bool PERM = true, MIDK = false;
    bf16_t* O; int ldc;
    __device__ __forceinline__ void operator()(const f32x4 (&acc)[2][2][4][2], const Unit& u, int wr, int wc, int fr, int fq) const {
        const int row0 = u.pm * BM + wr * 64 + fr, col0 = u.pn * BM + wc * 32 + 8 * fq;
#pragma unroll
        for (int ai = 0; ai < 2; ++ai)
#pragma unroll
            for (int m = 0; m < 4; ++m) { bf16_t* rowp = O + (size_t)(row0 + ai * HALF + m * 16) * ldc + col0;
#pragma unroll
                for (int bj = 0; bj < 2; ++bj) { const f32x4 v0 = acc[ai][bj][m][0], v1 = acc[ai][bj][m][1];
                    u32x4 w; w.x = cvt_pk_bf16(v0[0], v0[1]); w.y = cvt_pk_bf16(v0[2], v0[3]); w.z = cvt_pk_bf16(v1[0], v1[1]); w.w = cvt_pk_bf16(v1[2], v1[3]);
                    *(u32x4*)(rowp + bj * HALF) = w; } }
    }
};
struct EpiMix {
    static constexpr bool PERM = true, MIDK = true;
    bf16_t* O; int ldc; const PG8_LAS float* ratio; const PG8_LAS float* rsl;
    __device__ __forceinline__ void midk(f32x4 (&acc)[2][2][4][2], const Unit& u, int wr, int fr) const {
#pragma unroll
        for (int ai = 0; ai < 2; ++ai)
#pragma unroll
            for (int m = 0; m < 4; ++m) { const float rt = ratio[wr * 64 + fr + ai * HALF + m * 16];
#pragma unroll
                for (int bj = 0; bj < 2; ++bj)
#pragma unroll
                    for (int n = 0; n < 2; ++n) acc[ai][bj][m][n] *= rt; }
    }
    __device__ __forceinline__ void operator()(const f32x4 (&acc)[2][2][4][2], const Unit& u, int wr, int wc, int fr, int fq) const {
        const int row0 = u.pm * BM + wr * 64 + fr, col0 = u.pn * BM + wc * 32 + 8 * fq;
#pragma unroll
        for (int ai = 0; ai < 2; ++ai)
#pragma unroll
            for (int m = 0; m < 4; ++m) { const int row = row0 + ai * HALF + m * 16; bf16_t* rowp = O + (size_t)row * ldc + col0;
                const float rs = rsl[wr * 64 + fr + ai * HALF + m * 16];
#pragma unroll
                for (int bj = 0; bj < 2; ++bj) { const f32x4 v0 = acc[ai][bj][m][0] * rs, v1 = acc[ai][bj][m][1] * rs;
                    u32x4 w; w.x = cvt_pk_bf16(v0[0], v0[1]); w.y = cvt_pk_bf16(v0[2], v0[3]); w.z = cvt_pk_bf16(v1[0], v1[1]); w.w = cvt_pk_bf16(v1[2], v1[3]);
                    *(u32x4*)(rowp + bj * HALF) = w; } }
    }
};
struct EpiQKU {
    static constexpr bool PERM = true, MIDK = false;
    bf16_t* Q; bf16_t* Kp; bf16_t* A2; const PG8_LAS int* posl;
    __device__ __forceinline__ void operator()(const f32x4 (&acc)[2][2][4][2], const Unit& u, int wr, int wc, int fr, int fq) const {
        const int row0 = u.pm * BM + wr * 64 + fr, cw = wc * 32 + 8 * fq;
        if (u.pn < 5) {
            const bool isq = u.pn < 4; const float sc = isq ? ATT_C2 : 1.0f;
            const int i0 = (cw & 63) >> 1;
            float invf[4];
#pragma unroll
            for (int t = 0; t < 4; ++t) invf[t] = __builtin_amdgcn_exp2f(-(float)(i0 + t) * (13.287712379549449f / 32.0f));
            bf16_t* base = isq ? (Q + u.pn * 256) : Kp; const int ld = isq ? 1024 : 256;
#pragma unroll
            for (int ai = 0; ai < 2; ++ai)
#pragma unroll
                for (int m = 0; m < 4; ++m) { const int row = row0 + ai * HALF + m * 16; const float p = (float)posl[wr * 64 + fr + ai * HALF + m * 16];
                    float cs[4], sn[4];
#pragma unroll
                    for (int t = 0; t < 4; ++t) { const float ang = p * invf[t]; const float fr_ = __builtin_amdgcn_fractf(ang * 0.15915494309189535f); sn[t] = __builtin_amdgcn_sinf(fr_) * sc; cs[t] = __builtin_amdgcn_cosf(fr_) * sc; }
#pragma unroll
                    for (int bj = 0; bj < 2; ++bj) { const f32x4 v0 = acc[ai][bj][m][0], v1 = acc[ai][bj][m][1];
                        u32x4 w;
                        w.x = cvt_pk_bf16(v0[0] * cs[0] - v0[1] * sn[0], v0[1] * cs[0] + v0[0] * sn[0]);
                        w.y = cvt_pk_bf16(v0[2] * cs[1] - v0[3] * sn[1], v0[3] * cs[1] + v0[2] * sn[1]);
                        w.z = cvt_pk_bf16(v1[0] * cs[2] - v1[1] * sn[2], v1[1] * cs[2] + v1[0] * sn[2]);
                        w.w = cvt_pk_bf16(v1[2] * cs[3] - v1[3] * sn[3], v1[3] * cs[3] + v1[2] * sn[3]);
                        *(u32x4*)(base + (size_t)row * ld + bj * HALF + cw) = w; } }
        } else {
#pragma unroll
            for (int ai = 0; ai < 2; ++ai)
#pragma unroll
                for (int m = 0; m < 4; ++m) { const int row = row0 + ai * HALF + m * 16;
#pragma unroll
                    for (int bj = 0; bj < 2; ++bj) { const f32x4 v0 = acc[ai][bj][m][0], v1 = acc[ai][bj][m][1];
                        const int gcol = (u.pn - 5) * 256 + bj * HALF + cw, g = gcol >> 4, q0 = gcol & 15;
                        u32x4 w; w.x = cvt_pk_bf16(v0[0], v0[1]); w.y = cvt_pk_bf16(v0[2], v0[3]); w.z = cvt_pk_bf16(v1[0], v1[1]); w.w = cvt_pk_bf16(v1[2], v1[3]);
                        *(u32x4*)(A2 + (size_t)g * (1024 * 384) + (size_t)(row >> 4) * 384 + (row & 15) * 16 + q0) = w; } }
        }
    }
};
struct EpiZ {
    static constexpr bool PERM = false, MIDK = false;
    float* Z;
    __device__ __forceinline__ void operator()(const f32x4 (&acc)[2][2][4][2], const Unit& u, int wr, int wc, int fr, int fq) const {
        const int row0 = u.pm * BM + wr * 64 + fr, col0 = wc * 32 + 4 * fq;
#pragma unroll
        for (int ai = 0; ai < 2; ++ai)
#pragma unroll
            for (int m = 0; m < 4; ++m) { float* rowp = Z + (size_t)(row0 + ai * HALF + m * 16) * 128 + col0;
#pragma unroll
                for (int n = 0; n < 2; ++n) *(f32x4*)(rowp + n * 16) = acc[ai][0][m][n]; }
    }
};
struct EpiY {
    static constexpr bool PERM = true, MIDK = false;
    bf16_t* Zb;
    __device__ __forceinline__ void operator()(const f32x4 (&acc)[2][2][4][2], const Unit& u, int wr, int wc, int fr, int fq) const {
        const int row0 = u.pm * BM + wr * 64 + fr, g = u.pn;
#pragma unroll
        for (int ai = 0; ai < 2; ++ai)
#pragma unroll
            for (int m = 0; m < 4; ++m) { const int bc = (row0 + ai * HALF + m * 16) & 1023;
#pragma unroll
                for (int bj = 0; bj < 2; ++bj) { const f32x4 v0 = acc[ai][bj][m][0], v1 = acc[ai][bj][m][1];
                    const int j = 8 * bj + 2 * wc + (fq >> 1), p0 = 8 * (fq & 1);
                    u32x4 w; w.x = cvt_pk_bf16(gelu_tanh(v0[0]), gelu_tanh(v0[1])); w.y = cvt_pk_bf16(gelu_tanh(v0[2]), gelu_tanh(v0[3]));
                    w.z = cvt_pk_bf16(gelu_tanh(v1[0]), gelu_tanh(v1[1])); w.w = cvt_pk_bf16(gelu_tanh(v1[2]), gelu_tanh(v1[3]));
                    *(u32x4*)(Zb + (size_t)(bc * 16 + j) * 1024 + g * 16 + p0) = w; asm volatile("" ::: "memory"); } }
    }
};
struct EpiGlu {
    static constexpr bool PERM = true, MIDK = false;
    const bf16_t* Zb; const float* bias; bf16_t* O; int ldo; float* st;
    __device__ __forceinline__ void operator()(const f32x4 (&acc)[2][2][4][2], const Unit& u, int wr, int wc, int fr, int fq) const {
        const int row0 = u.pm * BM + wr * 64 + fr, col0 = u.pn * BM + wc * 32 + 8 * fq;
        float part[2][4];
#pragma unroll
        for (int ai = 0; ai < 2; ++ai)
#pragma unroll
            for (int m = 0; m < 4; ++m) part[ai][m] = 0.f;
#pragma unroll
        for (int bj = 0; bj < 2; ++bj) { const f32x4 b0 = *(const f32x4*)(bias + col0 + bj * HALF), b1 = *(const f32x4*)(bias + col0 + bj * HALF + 4);
#pragma unroll
            for (int ai = 0; ai < 2; ++ai)
#pragma unroll
                for (int m = 0; m < 4; ++m) { const int row = row0 + ai * HALF + m * 16;
                    const u32x4 zi = *(const u32x4*)(Zb + (size_t)row * 1024 + col0 + bj * HALF); const f32x4 v0 = acc[ai][bj][m][0] + b0, v1 = acc[ai][bj][m][1] + b1;
                    float e[8];
                    e[0] = bf_lo(zi.x) * sigmoidf_(v0[0]); e[1] = bf_hi(zi.x) * sigmoidf_(v0[1]); e[2] = bf_lo(zi.y) * sigmoidf_(v0[2]); e[3] = bf_hi(zi.y) * sigmoidf_(v0[3]);
                    e[4] = bf_lo(zi.z) * sigmoidf_(v1[0]); e[5] = bf_hi(zi.z) * sigmoidf_(v1[1]); e[6] = bf_lo(zi.w) * sigmoidf_(v1[2]); e[7] = bf_hi(zi.w) * sigmoidf_(v1[3]);
                    part[ai][m] += (e[0] * e[0] + e[1] * e[1]) + (e[2] * e[2] + e[3] * e[3]) + (e[4] * e[4] + e[5] * e[5]) + (e[6] * e[6] + e[7] * e[7]);
                    u32x4 w; w.x = cvt_pk_bf16(e[0], e[1]); w.y = cvt_pk_bf16(e[2], e[3]); w.z = cvt_pk_bf16(e[4], e[5]); w.w = cvt_pk_bf16(e[6], e[7]);
                    *(u32x4*)(O + (size_t)row * ldo + col0 + bj * HALF) = w; } }
#pragma unroll
        for (int ai = 0; ai < 2; ++ai)
#pragma unroll
            for (int m = 0; m < 4; ++m) { float p = part[ai][m]; p += __shfl_xor(p, 16); p += __shfl_xor(p, 32);
                if (fq == 0) (void)__hip_atomic_fetch_add(st + row0 + ai * HALF + m * 16, p, __ATOMIC_RELAXED, __HIP_MEMORY_SCOPE_AGENT); }
    }
};
struct EpiSwiGLU {
    static constexpr bool PERM = true, MIDK = false;
    bf16_t* O; int ldc; const float* rs;
    __device__ __forceinline__ void operator()(const f32x4 (&acc)[2][2][4][2], const Unit& u, int wr, int wc, int fr, int fq) const {
        const int row0 = u.pm * BM + wr * 64 + fr, col0 = u.pn * HALF + wc * 32 + 8 * fq;
#pragma unroll
        for (int ai = 0; ai < 2; ++ai)
#pragma unroll
            for (int m = 0; m < 4; ++m) {
                const f32x4 g0 = acc[ai][0][m][0], g1 = acc[ai][0][m][1], u0 = acc[ai][1][m][0], u1 = acc[ai][1][m][1];
                u32x4 w;
                w.x = cvt_pk_bf16(g0[0] * sigmoidf_(g0[0]) * u0[0], g0[1] * sigmoidf_(g0[1]) * u0[1]); w.y = cvt_pk_bf16(g0[2] * sigmoidf_(g0[2]) * u0[2], g0[3] * sigmoidf_(g0[3]) * u0[3]);
                w.z = cvt_pk_bf16(g1[0] * sigmoidf_(g1[0]) * u1[0], g1[1] * sigmoidf_(g1[1]) * u1[1]); w.w = cvt_pk_bf16(g1[2] * sigmoidf_(g1[2]) * u1[2], g1[3] * sigmoidf_(g1[3]) * u1[3]);
                *(u32x4*)(O + (size_t)(row0 + ai * HALF + m * 16) * ldc + col0) = w; }
    }
};

template <class Epi, class Sched, bool ALIGN_EPI>
__device__ __forceinline__ void gemm_phase(PG8_LAS unsigned char* lds, const Gemm g, const Sched& S, const Epi& E) {
    int tid_ = threadIdx.x; asm volatile("" : "+v"(tid_));
    const int tid = tid_, wid = __builtin_amdgcn_readfirstlane(tid >> 6), lane = tid & 63, wr = wid >> 2, wc = wid & 3, fr = lane & 15, fq = lane >> 4;
    const int nt = g.K / BK;
    unsigned voffA[2], voffB[2];
#pragma unroll
    for (int i = 0; i < 2; ++i) { int R, C; stage_rc(tid * 16 + i * 8192, R, C); const int Rb = Epi::PERM ? ((R & ~31) + perm32(R & 31)) : R;
        voffA[i] = (unsigned)(R * g.lda + C) * 2u; voffB[i] = (unsigned)(Rb * g.ldb + C) * 2u; }
    const size_t kstep = (size_t)(BK * 2);
    const size_t hstepA = (size_t)HALF * g.lda * 2, hstepB = (size_t)HALF * g.ldb * 2;
    const size_t tstepA = 2 * hstepA, tstepB = 2 * hstepB;
    const unsigned ldsw = (unsigned)wid * 1024u;
    const size_t tailoff = (size_t)(nt - 2) * (size_t)(BK * 2);
    const int aoff = lds_byte(wr * 64 + fr, fq * 8), boff = lds_byte(wc * 32 + fr, fq * 8);
#define PG8_SA(b, h) (((b) * 2 + (h)) * HTB)
#define PG8_SB(b, h) ((4 + (b) * 2 + (h)) * HTB)
#define PG8_STAGE(bufoff, gbase, voff) do { _Pragma("unroll") for (int _i = 0; _i < 2; ++_i) \
        __builtin_amdgcn_global_load_lds((const unsigned*)((const char*)(gbase) + (voff)[_i]), (PG8_LAS unsigned*)(lds + (bufoff) + ldsw + _i * 8192), 16, 0, 0); } while (0)
#define PG8_LDA(dst, b, h) do { _Pragma("unroll") for (int m = 0; m < 4; ++m) _Pragma("unroll") for (int k = 0; k < 2; ++k) dst[m][k] = *(const PG8_LAS bf16x8*)(lds + PG8_SA(b, h) + aoff + m * 2048 + k * 1024); } while (0)
#define PG8_LDB(dst, b, h) do { _Pragma("unroll") for (int n = 0; n < 2; ++n) _Pragma("unroll") for (int k = 0; k < 2; ++k) dst[n][k] = *(const PG8_LAS bf16x8*)(lds + PG8_SB(b, h) + boff + n * 2048 + k * 1024); } while (0)
#define PG8_MMA(ai, bj, At, Bt) do { __builtin_amdgcn_s_setprio(1); _Pragma("unroll") for (int m = 0; m < 4; ++m) _Pragma("unroll") for (int n = 0; n < 2; ++n) _Pragma("unroll") for (int k = 0; k < 2; ++k) \
        acc[ai][bj][m][n] = __builtin_amdgcn_mfma_f32_16x16x32_bf16(Bt[n][k], At[m][k], acc[ai][bj][m][n], 0, 0, 0); __builtin_amdgcn_s_setprio(0); } while (0)
#define PG8_WAIT_V(n) asm volatile("s_waitcnt vmcnt(" #n ")" ::: "memory")
#define PG8_WAIT_L(n) asm volatile("s_waitcnt lgkmcnt(" #n ")" ::: "memory")
#define PG8_BAR __builtin_amdgcn_s_barrier()
#define PG8_SCHED __builtin_amdgcn_sched_barrier(0)
    Unit cur, nxt; int ui = 0;
    if (!S.next(0, cur)) return;
    f32x4 acc[2][2][4][2];
#pragma unroll
    for (int a = 0; a < 2; ++a)
#pragma unroll
        for (int b = 0; b < 2; ++b)
#pragma unroll
            for (int m = 0; m < 4; ++m)
#pragma unroll
                for (int n = 0; n < 2; ++n) acc[a][b][m][n] = (f32x4){0.f, 0.f, 0.f, 0.f};
    bf16x8 At[4][2], B0[2][2], B1[2][2];
    const char* cA = (const char*)g.A + (size_t)cur.pm * tstepA; const char* cB = (const char*)g.Bt + (size_t)cur.pn * tstepB;
    PG8_STAGE(PG8_SB(0, 0), cB, voffB); PG8_STAGE(PG8_SB(0, 1), cB + hstepB, voffB); PG8_STAGE(PG8_SA(0, 0), cA, voffA); PG8_STAGE(PG8_SA(0, 1), cA + hstepA, voffA);
    if (wr == 1) PG8_BAR;
    PG8_WAIT_V(2); PG8_BAR;
    PG8_STAGE(PG8_SB(1, 0), cB + kstep, voffB); PG8_STAGE(PG8_SA(1, 0), cA + kstep, voffA); PG8_STAGE(PG8_SB(1, 1), cB + hstepB + kstep, voffB);
    PG8_WAIT_V(6); PG8_BAR;
    for (;;) {
        const bool has_next = S.next(ui + 1, nxt);
        const size_t tail_ = has_next ? 0 : tailoff; const char* nA = (has_next ? (const char*)g.A + (size_t)nxt.pm * tstepA : cA) + tail_; const char* nB = (has_next ? (const char*)g.Bt + (size_t)nxt.pn * tstepB : cB) + tail_;
        for (int t = 0; t < nt; t += 2) {
            if constexpr (Epi::MIDK) { if (t == (nt >> 1)) E.midk(acc, cur, wr, fr); }
            const bool last = (t == nt - 2);
            const char* a1 = cA + (size_t)(t + 1) * kstep;
            const char* a2 = last ? nA : cA + (size_t)(t + 2) * kstep; const char* b2 = last ? nB : cB + (size_t)(t + 2) * kstep;
            const char* a3 = a2 + kstep; const char* b3 = b2 + kstep;
            PG8_LDB(B0, 0, 0); PG8_LDB(B1, 0, 1); PG8_SCHED; PG8_LDA(At, 0, 0); PG8_STAGE(PG8_SA(1, 1), a1 + hstepA, voffA);
            PG8_WAIT_V(8); PG8_WAIT_L(0); PG8_BAR; PG8_MMA(0, 0, At, B0); PG8_MMA(0, 1, At, B1); PG8_BAR; PG8_SCHED;
            PG8_LDA(At, 0, 1); PG8_STAGE(PG8_SB(0, 0), b2, voffB); PG8_STAGE(PG8_SB(0, 1), b2 + hstepB, voffB); PG8_STAGE(PG8_SA(0, 0), a2, voffA);
            PG8_WAIT_V(8); PG8_WAIT_L(0); PG8_BAR; PG8_MMA(1, 0, At, B0); PG8_MMA(1, 1, At, B1); PG8_BAR; PG8_SCHED;
            PG8_LDB(B0, 1, 0); PG8_LDB(B1, 1, 1); PG8_SCHED; PG8_LDA(At, 1, 0); PG8_STAGE(PG8_SA(0, 1), a2 + hstepA, voffA);
            PG8_WAIT_V(8); PG8_WAIT_L(0); PG8_BAR; PG8_MMA(0, 0, At, B0); PG8_MMA(0, 1, At, B1); PG8_BAR; PG8_SCHED;
            PG8_LDA(At, 1, 1); PG8_STAGE(PG8_SB(1, 0), b3, voffB); PG8_STAGE(PG8_SB(1, 1), b3 + hstepB, voffB); PG8_STAGE(PG8_SA(1, 0), a3, voffA);
            PG8_WAIT_V(8); PG8_WAIT_L(0); PG8_BAR; PG8_MMA(1, 0, At, B0); PG8_MMA(1, 1, At, B1); PG8_BAR; PG8_SCHED;
        }
        if constexpr (ALIGN_EPI) { if (wr == 0) PG8_BAR; }
        E(acc, cur, wr, wc, fr, fq);
        if (!has_next) break;
#pragma unroll
        for (int a = 0; a < 2; ++a)
#pragma unroll
            for (int b = 0; b < 2; ++b)
#pragma unroll
                for (int m = 0; m < 4; ++m)
#pragma unroll
                    for (int n = 0; n < 2; ++n) acc[a][b][m][n] = (f32x4){0.f, 0.f, 0.f, 0.f};
        cur = nxt; cA = nA; cB = nB; ++ui;
        if constexpr (ALIGN_EPI) { if (wr == 1) PG8_BAR; }
    }
    PG8_WAIT_V(0);
    if constexpr (!ALIGN_EPI) { if (wr == 0) PG8_BAR; }
    PG8_BAR;
#undef PG8_SA
#undef PG8_SB
#undef PG8_STAGE
#undef PG8_LDA
#undef PG8_LDB
#undef PG8_MMA
#undef PG8_WAIT_V
#undef PG8_WAIT_L
#undef PG8_BAR
#undef PG8_SCHED
}
}

constexpr int NWAVES = 8;
constexpr int BATCH = 8, SEQ = 2048, DM = 2048, M = BATCH * SEQ;
constexpr int D_ATTN = 1024, D_KV = 256, D_SSM = 1024, D_IN = 2560, D_FF = 5632, NQH = 16, NKVH = 4, HD = 64;
constexpr int NG = 64, NST = 64, PCH = 16, CH = 16, NCH = SEQ / CH;
constexpr int A2LD = 384;
constexpr float RMS_EPS = 1e-6f;

constexpr size_t MiB = 1u << 20;
constexpr size_t WS_CTL = 0, CTL_ZERO_BYTES = 1 * MiB;
constexpr size_t WS_WIN = 2 * MiB, WS_WGLU = 12 * MiB, WS_WO = 14 * MiB, WS_WGU = 22 * MiB, WS_WD = 66 * MiB;
constexpr size_t WS_TC = 88 * MiB, WS_BZ = 100 * MiB, WS_LAM = 108 * MiB, WS_RH = 109 * MiB, WS_RX = 110 * MiB;
constexpr size_t WS_R1 = 112 * MiB;
constexpr size_t WS_R2 = 176 * MiB;
constexpr size_t WS_Q = WS_R2, WS_K = WS_R2 + 32 * MiB, WS_VT = WS_R2 + 40 * MiB;
constexpr size_t WS_A3 = 240 * MiB, WS_Z = 304 * MiB;
constexpr size_t WS_A2 = 336 * MiB;
constexpr size_t WS_ZS = 384 * MiB;
constexpr size_t WS_HID = 336 * MiB;
constexpr size_t WS_END = 512 * MiB;
constexpr int CW_BAR = 4096, CW_TEAM = 16384, CW_STAT_A = 65536, CW_STAT_S = 81920;

constexpr int RING_BYTES = 131072, LDSCTL_OFF = RING_BYTES, MISC_OFF = LDSCTL_OFF + 320, LDS_BYTES = 147456;

#define GAS __attribute__((address_space(1)))
#define LAS __attribute__((address_space(3)))
typedef unsigned short bf16;
typedef unsigned v4u __attribute__((ext_vector_type(4)));
typedef unsigned v2u __attribute__((ext_vector_type(2)));
typedef float f32x4 __attribute__((ext_vector_type(4)));
typedef float f32x16 __attribute__((ext_vector_type(16)));
typedef short bf16x8 __attribute__((ext_vector_type(8)));
#define LDS_WAIT() asm volatile("s_waitcnt lgkmcnt(0)" ::: "memory")
using pg8::cvt_pk_bf16; using pg8::bf_lo; using pg8::bf_hi;

#define XB_TMO      128
#define XB_XCNT(j)  (256  + 64 * (j))
#define XB_XSUB(j)  (1280 + 64 * (j))
#define XB_XGEN(j)  (2304 + 64 * (j))
#define XB_TOP      3328
#define XB_TOPGEN   3392
#define XCD_BAR_WORDS 3456
#define XB_SPIN_CAP (1u << 18)
__device__ __forceinline__ unsigned xb_ld(unsigned* p)              { return __hip_atomic_load(p, __ATOMIC_RELAXED, __HIP_MEMORY_SCOPE_AGENT); }
__device__ __forceinline__ unsigned xb_add(unsigned* p, unsigned v) { return __hip_atomic_fetch_add(p, v, __ATOMIC_RELAXED, __HIP_MEMORY_SCOPE_AGENT); }
__device__ __forceinline__ unsigned xb_xcc_id() { return (unsigned)__builtin_amdgcn_s_getreg((3 << 11) | 20) & 0xFu; }
#define XB_SPIN(cond, bar) do { unsigned _sp = 0; while (cond) { __builtin_amdgcn_s_sleep(1); \
    if ((++_sp & 255u) == 0u) { if (xb_ld(&(bar)[XB_TMO])) break; if (_sp > XB_SPIN_CAP) { atomicAdd(&(bar)[XB_TMO], 1u); break; } } } } while (0)
struct XcdBarrier { unsigned* bar; unsigned x; volatile LAS unsigned* st; };
__device__ __forceinline__ XcdBarrier xcd_barrier_post(unsigned* bar, volatile LAS unsigned* st) {
    XcdBarrier b; b.bar = bar; b.x = xb_xcc_id(); b.st = st;
    if (threadIdx.x == 0) (void)xb_add(&bar[XB_XCNT(b.x)], 1u);
    return b;
}
__device__ __forceinline__ void xcd_barrier_complete(unsigned* bar, unsigned x, unsigned& nloc, unsigned& nx) {
    const unsigned G = gridDim.x * gridDim.y * gridDim.z;
    unsigned sum, cnt, mine, sp = 0u;
    for (;;) {
        sum = 0u; cnt = 0u; mine = 0u;
#pragma unroll
        for (unsigned j = 0; j < 16; ++j) { const unsigned c = xb_ld(&bar[XB_XCNT(j)]); sum += c; cnt += (c > 0u) ? 1u : 0u; mine = (j == x) ? c : mine; }
        if (sum == G) break;
        __builtin_amdgcn_s_sleep(1);
        if ((++sp & 255u) == 0u) { if (xb_ld(&bar[XB_TMO])) break; if (sp > XB_SPIN_CAP) { atomicAdd(&bar[XB_TMO], 1u); break; } }
    }
    nloc = mine > 0u ? mine : 1u; nx = cnt > 0u ? cnt : 1u;
}
__device__ __forceinline__ void xcd_barrier(const XcdBarrier& b) {
    asm volatile("s_waitcnt vmcnt(0)" ::: "memory");
    __syncthreads();
    if (threadIdx.x == 0) {
        unsigned* bar = b.bar;
        __builtin_amdgcn_s_waitcnt(0);
        unsigned nloc = b.st[0], nx = b.st[1];
        if (nloc == 0u) { xcd_barrier_complete(bar, b.x, nloc, nx); b.st[0] = nloc; b.st[1] = nx; }
        const unsigned old = xb_add(&bar[XB_XSUB(b.x)], 1u);
        const unsigned gen = old / nloc;
        if (old + 1u == (gen + 1u) * nloc) {
            __builtin_amdgcn_fence(__ATOMIC_RELEASE, "agent");
            asm volatile("s_waitcnt vmcnt(0)" ::: "memory");
            const unsigned og = xb_add(&bar[XB_TOP], 1u);
            const unsigned tg = og / nx;
            if (og + 1u == (tg + 1u) * nx) xb_add(&bar[XB_TOPGEN], 1u);
            else XB_SPIN(xb_ld(&bar[XB_TOPGEN]) == tg, bar);
            __builtin_amdgcn_fence(__ATOMIC_ACQUIRE, "agent");
            xb_add(&bar[XB_XGEN(b.x)], 1u);
            asm volatile("s_waitcnt vmcnt(0)" ::: "memory");
        } else {
            XB_SPIN(xb_ld(&bar[XB_XGEN(b.x)]) == gen, bar);
            __builtin_amdgcn_fence(__ATOMIC_ACQUIRE, "agent");
            asm volatile("s_waitcnt vmcnt(0)" ::: "memory");
        }
    }
    __syncthreads();
}

__device__ __forceinline__ void team_barrier(unsigned* cnt, unsigned* tmo, unsigned& epoch, volatile LAS unsigned* same_xcd) {
    asm volatile("s_waitcnt vmcnt(0)" ::: "memory");
    __syncthreads();
    if (threadIdx.x == 0) {
        if (*same_xcd != 1u) { __builtin_amdgcn_fence(__ATOMIC_RELEASE, "agent"); }
        asm volatile("s_waitcnt vmcnt(0)" ::: "memory");
        (void)xb_add(cnt, 1u);
        const unsigned want = 4u * epoch; unsigned sp = 0u;
        while (xb_ld(cnt) < want) { __builtin_amdgcn_s_sleep(1); if ((++sp & 255u) == 0u) { if (xb_ld(tmo)) break; if (sp > XB_SPIN_CAP) { atomicAdd(tmo, 1u); break; } } }
        __builtin_amdgcn_fence(__ATOMIC_ACQUIRE, "agent");
        asm volatile("s_waitcnt vmcnt(0)" ::: "memory");
    }
    __syncthreads();
    ++epoch;
}

__device__ __forceinline__ float wave_sum(float v) {
#pragma unroll
    for (int o = 1; o < 64; o <<= 1) v += __shfl_xor(v, o);
    return v;
}
__device__ __forceinline__ void sincos_rev(double rev, float& s, float& c) {
    const double fr = rev - __builtin_rint(rev); const float f = (float)fr;
    s = __builtin_amdgcn_sinf(f); c = __builtin_amdgcn_cosf(f);
}
enum { MAP_PLAIN = 0, MAP_WIN = 1, MAP_GATE = 2, MAP_UP = 3 };
template <int MODE> __device__ __forceinline__ int map_row(int n) {
    if (MODE == MAP_WIN) {
        if (n < 1280) { const int d = n & 63; return (n & ~63) + (d < 32 ? 2 * d : 2 * (d - 32) + 1); }
        if (n < 1536) return 2304 + (n - 1280);
        return 1280 + (n - 1536);
    }
    if (MODE == MAP_GATE) return ((n >> 7) << 8) + (n & 127);
    if (MODE == MAP_UP) return ((n >> 7) << 8) + 128 + (n & 127);
    return n;
}
template <int MODE> __device__ __forceinline__ void transpose_item(const float* W, int K, int N, bf16* WT, const float* gs, LAS float* scr, int item, int lane) {
    const int nblk = N / 32, kb = item / nblk, nb = item % nblk, k0 = 64 * kb, n0 = 32 * nb;
    const float* src = W + (size_t)(k0 + (lane >> 5)) * N + n0 + (lane & 31);
    float v[32];
#pragma unroll
    for (int i = 0; i < 32; ++i) v[i] = src[(size_t)(2 * i) * N];
    const int c = lane & 7;
    f32x4 g0 = (f32x4){1.f, 1.f, 1.f, 1.f}, g1 = g0;
    if (gs) { g0 = *(const f32x4*)(gs + k0 + 8 * c); g1 = *(const f32x4*)(gs + k0 + 8 * c + 4); }
    LAS float* sw = scr + (lane >> 5) * 33 + (lane & 31);
#pragma unroll
    for (int i = 0; i < 32; ++i) sw[(2 * i) * 33] = v[i];
    LDS_WAIT(); asm volatile("" ::: "memory");
#pragma unroll
    for (int j = 0; j < 4; ++j) { const int n = (lane >> 3) + 8 * j; const LAS float* s = scr + (8 * c) * 33 + n;
        v4u o; o.x = cvt_pk_bf16(s[0 * 33] * g0.x, s[1 * 33] * g0.y); o.y = cvt_pk_bf16(s[2 * 33] * g0.z, s[3 * 33] * g0.w); o.z = cvt_pk_bf16(s[4 * 33] * g1.x, s[5 * 33] * g1.y); o.w = cvt_pk_bf16(s[6 * 33] * g1.z, s[7 * 33] * g1.w);
        *(v4u*)(WT + (size_t)map_row<MODE>(n0 + n) * K + k0 + 8 * c) = o; }
    LDS_WAIT(); asm volatile("" ::: "memory");
}

struct TrDesc { const float* W; bf16* WT; const float* gs; int K, N, mode, item; };
struct TrRegs { float v[32]; f32x4 g0, g1; };
__device__ __forceinline__ int map_row_rt(int mode, int n) {
    if (mode == MAP_WIN) return map_row<MAP_WIN>(n);
    if (mode == MAP_GATE) return map_row<MAP_GATE>(n);
    if (mode == MAP_UP) return map_row<MAP_UP>(n);
    return n;
}
__device__ __forceinline__ void tr_load(const TrDesc& d, int lane, TrRegs& t) {
    const int nblk = d.N / 32, kb = d.item / nblk, nb = d.item - kb * nblk, k0 = 64 * kb, n0 = 32 * nb;
    const float* src = d.W + (size_t)(k0 + (lane >> 5)) * d.N + n0 + (lane & 31);
#pragma unroll
    for (int i = 0; i < 32; ++i) t.v[i] = __builtin_nontemporal_load(src + (size_t)(2 * i) * d.N);
    const int c = lane & 7;
    t.g0 = (f32x4){1.f, 1.f, 1.f, 1.f}; t.g1 = t.g0;
    if (d.gs) { t.g0 = *(const f32x4*)(d.gs + k0 + 8 * c); t.g1 = *(const f32x4*)(d.gs + k0 + 8 * c + 4); }
}
__device__ __forceinline__ void tr_finish(const TrDesc& d, const TrRegs& t, LAS float* scr, int lane) {
    const int nblk = d.N / 32, kb = d.item / nblk, nb = d.item - kb * nblk, k0 = 64 * kb, n0 = 32 * nb, c = lane & 7;
    LAS float* sw = scr + (lane >> 5) * 33 + (lane & 31);
#pragma unroll
    for (int i = 0; i < 32; ++i) sw[(2 * i) * 33] = t.v[i];
    LDS_WAIT(); asm volatile("" ::: "memory");
#pragma unroll
    for (int j = 0; j < 4; ++j) { const int n = (lane >> 3) + 8 * j; const LAS float* s = scr + (8 * c) * 33 + n;
        v4u o; o.x = cvt_pk_bf16(s[0 * 33] * t.g0.x, s[1 * 33] * t.g0.y); o.y = cvt_pk_bf16(s[2 * 33] * t.g0.z, s[3 * 33] * t.g0.w); o.z = cvt_pk_bf16(s[4 * 33] * t.g1.x, s[5 * 33] * t.g1.y); o.w = cvt_pk_bf16(s[6 * 33] * t.g1.z, s[7 * 33] * t.g1.w);
        *(v4u*)(d.WT + (size_t)map_row_rt(d.mode, n0 + n) * d.K + k0 + 8 * c) = o; }
    LDS_WAIT(); asm volatile("" ::: "memory");
}

struct Args {
    const float* x; const int* pos; const float* g_pre_mix; const float* w_in; const float* sinks; const float* a_re; const float* a_im; const float* log_dt;
    const float* b_re; const float* b_im; const float* c_re; const float* c_im; const float* d_skip; const float* w_glu; const float* b_glu;
    const float* g_attn_out; const float* g_ssm_out; const float* w_o; const float* g_post_mix; const float* g_pre_ffn; const float* w_gate; const float* w_up;
    const float* w_down; const float* g_post_ffn; float* out; unsigned char* ws;
};

__device__ __forceinline__ void ssm_precompute(const Args& a, int g, LAS unsigned char* lds, int tid) {
    typedef float f32x2v __attribute__((ext_vector_type(2)));
    LAS f32x2v* P = (LAS f32x2v*)lds;
    LAS f32x2v* Bb = (LAS f32x2v*)(lds + 8704);
    LAS f32x2v* Cc = (LAS f32x2v*)(lds + 8704 + 8192);
    LAS float* Kk = (LAS float*)(lds + 8704 + 16384);
    const float dt = __builtin_amdgcn_exp2f(a.log_dt[g] * 1.4426950408889634f);
    for (int e = tid; e < 17 * 64; e += 512) { const int k = e >> 6, n = e & 63; const float ar = a.a_re[g * 64 + n], ai = a.a_im[g * 64 + n];
        const float mag = __builtin_amdgcn_exp2f((float)k * ar * dt * 1.4426950408889634f); float s, c; sincos_rev((double)k * (double)ai * (double)dt * 0.15915494309189535, s, c);
        P[e] = (f32x2v){mag * c, mag * s}; }
    for (int e = tid; e < 1024; e += 512) { const int n = e >> 4; const float ar = a.a_re[g * 64 + n], ai = a.a_im[g * 64 + n];
        const float mag = __builtin_amdgcn_exp2f(ar * dt * 1.4426950408889634f); float s, c; sincos_rev((double)ai * (double)dt * 0.15915494309189535, s, c);
        const float lr = mag * c, li = mag * s, den = ar * ar + ai * ai, nr = lr - 1.0f, ni = li;
        const float fre = (nr * ar + ni * ai) / den, fim = (ni * ar - nr * ai) / den;
        const float br = a.b_re[(size_t)g * 1024 + e], bi = a.b_im[(size_t)g * 1024 + e];
        Bb[e] = (f32x2v){fre * br - fim * bi, fre * bi + fim * br};
        Cc[e] = (f32x2v){a.c_re[(size_t)g * 1024 + e], a.c_im[(size_t)g * 1024 + e]}; }
    LDS_WAIT(); __syncthreads();
    for (int e = tid; e < 4096; e += 512) { const int k = e >> 8, p = (e >> 4) & 15, q = e & 15; float s = 0.f;
        for (int n = 0; n < 64; ++n) { const f32x2v c = Cc[p * 64 + n], l = P[k * 64 + n], b = Bb[n * 16 + q];
            const float tr = c.x * l.x - c.y * l.y, ti = c.x * l.y + c.y * l.x; s += tr * b.x - ti * b.y; }
        Kk[e] = s; }
    LDS_WAIT(); __syncthreads();
    bf16* TC = (bf16*)(a.ws + WS_TC) + (size_t)g * 256 * A2LD;
    bf16* BZ = (bf16*)(a.ws + WS_BZ) + (size_t)g * 256 * 256;
    {
        const int row = tid >> 1, j = row >> 4, p = row & 15; const float dp = a.d_skip[g * 16 + p];
        for (int ci = 0; ci < 16; ++ci) { const int col0 = 128 * (tid & 1) + 8 * ci, i = col0 >> 4, q0 = col0 & 15; float v[8];
#pragma unroll
            for (int e = 0; e < 8; ++e) { float t = 0.f; if (i <= j) { t = Kk[((j - i) * 16 + p) * 16 + q0 + e]; if (i == j && q0 + e == p) t += dp; } v[e] = t; }
            v4u o; o.x = cvt_pk_bf16(v[0], v[1]); o.y = cvt_pk_bf16(v[2], v[3]); o.z = cvt_pk_bf16(v[4], v[5]); o.w = cvt_pk_bf16(v[6], v[7]);
            *(v4u*)(TC + (size_t)row * A2LD + col0) = o; }
        for (int ci = 0; ci < 8; ++ci) { const int n0 = 32 * (tid & 1) + 4 * ci; float v[8];
#pragma unroll
            for (int e = 0; e < 4; ++e) { const f32x2v c = Cc[p * 64 + n0 + e], l = P[(j + 1) * 64 + n0 + e]; v[2 * e] = c.x * l.x - c.y * l.y; v[2 * e + 1] = -(c.x * l.y + c.y * l.x); }
            v4u o; o.x = cvt_pk_bf16(v[0], v[1]); o.y = cvt_pk_bf16(v[2], v[3]); o.z = cvt_pk_bf16(v[4], v[5]); o.w = cvt_pk_bf16(v[6], v[7]);
            *(v4u*)(TC + (size_t)row * A2LD + 256 + 2 * n0) = o; }
    }
    {
        const int row = tid >> 2, n = row >> 1, ri = row & 1;
        for (int ci = 0; ci < 8; ++ci) { const int col0 = 64 * (tid & 3) + 8 * ci, i = col0 >> 4, q0 = col0 & 15; float v[8];
#pragma unroll
            for (int e = 0; e < 8; ++e) { const f32x2v l = P[(15 - i) * 64 + n], b = Bb[n * 16 + q0 + e]; v[e] = ri ? (l.x * b.y + l.y * b.x) : (l.x * b.x - l.y * b.y); }
            v4u o; o.x = cvt_pk_bf16(v[0], v[1]); o.y = cvt_pk_bf16(v[2], v[3]); o.z = cvt_pk_bf16(v[4], v[5]); o.w = cvt_pk_bf16(v[6], v[7]);
            *(v4u*)(BZ + (size_t)row * 256 + col0) = o;
            *(v4u*)(BZ + (size_t)(128 + row) * 256 + col0) = (v4u){0u, 0u, 0u, 0u}; }
    }
    if (tid < 64) { const f32x2v l = P[16 * 64 + tid]; ((float*)(a.ws + WS_LAM))[(g * 64 + tid) * 2] = l.x; ((float*)(a.ws + WS_LAM))[(g * 64 + tid) * 2 + 1] = l.y; }
    LDS_WAIT(); __syncthreads();
}

constexpr int AT_KROW = 144, AT_VROW = 392, AT_V_OFF = 192 * AT_KROW, AT_LDS_BYTES = AT_V_OFF + 64 * AT_VROW;
__device__ __forceinline__ int crow(int r, int hi) { return (r & 3) + 8 * (r >> 2) + 4 * hi; }
__device__ __forceinline__ void attn_phase(LAS unsigned char* lds, int vcu, int G, const bf16* Qp, const bf16* Kp, const bf16* Vt, const float* sinks, bf16* AO, int ldo, float* st) {
    typedef unsigned long long u64;
    int tid = threadIdx.x; asm volatile("" : "+v"(tid));
    const int lane = tid & 63, wave = __builtin_amdgcn_readfirstlane(tid >> 6), r32 = lane & 31, hi = lane >> 5, hq = wave & 3, qsub = wave >> 2;
    const float NEG = -INFINITY;
    float ssq_acc = 0.f;
    for (int it = 0; it < 4; ++it) { const int id = ((vcu >> 5) << 7) | (it << 5) | (vcu & 31);
        const int b = id >> 7, kvh = (id >> 5) & 3, q0 = 64 * (id & 31), h = kvh * 4 + hq;
        const size_t tok0 = (size_t)b * SEQ;
        const int jt0 = (q0 >= 128) ? 0 : (128 - q0) / 32;
        v4u kv[3], vv[3];
#pragma unroll
        for (int i = 0; i < 3; ++i) { const int c = tid + 512 * i, row = c >> 3, ch = c & 7, key = q0 - 128 + row;
            if (key >= 0) kv[i] = *(const v4u*)(Kp + (tok0 + key) * D_KV + kvh * HD + ch * 8); }
#pragma unroll
        for (int i = 0; i < 3; ++i) { const int c = tid + 512 * i, d = c / 24, ch = c - d * 24, key0 = q0 - 128 + 8 * ch;
            if (key0 >= 0) vv[i] = *(const v4u*)(Vt + (size_t)(kvh * HD + d) * M + tok0 + key0); }
        const bf16* qrow = Qp + (tok0 + q0 + 32 * qsub + r32) * D_ATTN + h * HD + 32 * hi;
        bf16x8 qf[4];
#pragma unroll
        for (int kk = 0; kk < 4; ++kk) qf[kk] = *(const bf16x8*)(qrow + 8 * kk);
#pragma unroll
        for (int i = 0; i < 3; ++i) { const int c = tid + 512 * i, row = c >> 3, ch = c & 7, key = q0 - 128 + row;
            if (key >= 0) *(LAS v4u*)(lds + row * AT_KROW + ch * 16) = kv[i]; }
#pragma unroll
        for (int i = 0; i < 3; ++i) { const int c = tid + 512 * i, d = c / 24, ch = c - d * 24, key0 = q0 - 128 + 8 * ch;
            if (key0 >= 0) { LAS u64* p = (LAS u64*)(lds + AT_V_OFF + d * AT_VROW + ch * 16); p[0] = ((u64)vv[i].y << 32) | vv[i].x; p[1] = ((u64)vv[i].w << 32) | vv[i].z; } }
        LDS_WAIT(); __syncthreads();
        f32x16 s[5];
#pragma unroll
        for (int kt = 0; kt < 5; ++kt) {
            if (kt + qsub >= jt0) {
                const LAS unsigned char* kp = lds + (32 * (kt + qsub) + r32) * AT_KROW + 64 * hi;
                f32x16 acc = {0.f, 0.f, 0.f, 0.f, 0.f, 0.f, 0.f, 0.f, 0.f, 0.f, 0.f, 0.f, 0.f, 0.f, 0.f, 0.f};
#pragma unroll
                for (int kk = 0; kk < 4; ++kk) acc = __builtin_amdgcn_mfma_f32_32x32x16_bf16(*(const LAS bf16x8*)(kp + 16 * kk), qf[kk], acc, 0, 0, 0);
                s[kt] = acc;
            } else {
#pragma unroll
                for (int r = 0; r < 16; ++r) s[kt][r] = NEG;
            }
        }
#pragma unroll
        for (int r = 0; r < 16; ++r) { const int cr = crow(r, hi); if (!(cr > r32)) s[0][r] = NEG; if (!(cr <= r32)) s[4][r] = NEG; }
        const float sk = sinks[h] * 1.4426950408889634f;
        float mx = sk;
#pragma unroll
        for (int kt = 0; kt < 5; ++kt)
#pragma unroll
            for (int r = 0; r < 16; ++r) mx = fmaxf(mx, s[kt][r]);
        mx = fmaxf(mx, __shfl_xor(mx, 32));
        float l = 0.f;
#pragma unroll
        for (int kt = 0; kt < 5; ++kt)
#pragma unroll
            for (int r = 0; r < 16; ++r) { const float p = __builtin_amdgcn_exp2f(s[kt][r] - mx); s[kt][r] = p; l += p; }
        l += __shfl_xor(l, 32);
        l += __builtin_amdgcn_exp2f(sk - mx);
        const float inv = 1.0f / l;
        f32x16 o[2];
#pragma unroll
        for (int d = 0; d < 2; ++d)
#pragma unroll
            for (int r = 0; r < 16; ++r) o[d][r] = 0.f;
#pragma unroll
        for (int kt = 0; kt < 5; ++kt) {
            if (kt + qsub >= jt0) {
#pragma unroll
                for (int s2 = 0; s2 < 2; ++s2) {
                    v4u pw; pw.x = cvt_pk_bf16(s[kt][8 * s2 + 0] * inv, s[kt][8 * s2 + 1] * inv); pw.y = cvt_pk_bf16(s[kt][8 * s2 + 2] * inv, s[kt][8 * s2 + 3] * inv);
                    pw.z = cvt_pk_bf16(s[kt][8 * s2 + 4] * inv, s[kt][8 * s2 + 5] * inv); pw.w = cvt_pk_bf16(s[kt][8 * s2 + 6] * inv, s[kt][8 * s2 + 7] * inv);
                    const bf16x8 pf = __builtin_bit_cast(bf16x8, pw);
#pragma unroll
                    for (int dh = 0; dh < 2; ++dh) {
                        const LAS u64* vp = (const LAS u64*)(lds + AT_V_OFF + (dh * 32 + r32) * AT_VROW + (32 * (kt + qsub) + 16 * s2 + 4 * hi) * 2);
                        const u64 lo = vp[0], hi8 = vp[2];
                        const v4u vw = (v4u){(unsigned)lo, (unsigned)(lo >> 32), (unsigned)hi8, (unsigned)(hi8 >> 32)};
                        o[dh] = __builtin_amdgcn_mfma_f32_32x32x16_bf16(__builtin_bit_cast(bf16x8, vw), pf, o[dh], 0, 0, 0);
                    }
                }
            }
        }
        {
            float ssq = 0.f;
#pragma unroll
            for (int dh = 0; dh < 2; ++dh)
#pragma unroll
                for (int r = 0; r < 16; ++r) ssq += o[dh][r] * o[dh][r];
            ssq += __shfl_xor(ssq, 32);
            ssq_acc += ssq;
        }
        bf16* orow = AO + (tok0 + q0 + 32 * qsub + r32) * (size_t)ldo + h * HD + 4 * hi;
#pragma unroll
        for (int dh = 0; dh < 2; ++dh)
#pragma unroll
            for (int g4 = 0; g4 < 4; ++g4) { v2u w; w.x = cvt_pk_bf16(o[dh][4 * g4], o[dh][4 * g4 + 1]); w.y = cvt_pk_bf16(o[dh][4 * g4 + 2], o[dh][4 * g4 + 3]);
                *(v2u*)(orow + dh * 32 + 8 * g4) = w; }
        LDS_WAIT(); __syncthreads();
    }
    {
        LAS float* Xs = (LAS float*)lds;
        if (hi == 0) Xs[(qsub * 4 + hq) * 32 + r32] = ssq_acc;
        LDS_WAIT(); __syncthreads();
        if (hq == 0 && hi == 0) { const float tot = (Xs[(qsub * 4 + 0) * 32 + r32] + Xs[(qsub * 4 + 1) * 32 + r32]) + (Xs[(qsub * 4 + 2) * 32 + r32] + Xs[(qsub * 4 + 3) * 32 + r32]);
            st[(size_t)(vcu >> 5) * SEQ + 64 * (vcu & 31) + 32 * qsub + r32] = tot; }
        LDS_WAIT(); __syncthreads();
    }
}

__global__ void __launch_bounds__(NWAVES * 64, 2) hymba_fwd(Args a) {
    extern __shared__ __attribute__((aligned(16))) unsigned char lds_raw[];
    LAS unsigned char* lds = (LAS unsigned char*)lds_raw;
    volatile LAS unsigned* MISC = (volatile LAS unsigned*)(lds + MISC_OFF);
    const int tid = threadIdx.x;
    const int G = gridDim.x; const int bx = blockIdx.x; const int vcu = (G % 8 == 0) ? (bx % 8) * (G / 8) + bx / 8 : bx;
    unsigned char* ws = a.ws;
    unsigned* ctl = (unsigned*)(ws + WS_CTL);
    for (int u = tid; u < (LDS_BYTES - LDSCTL_OFF) / 4; u += NWAVES * 64) ((LAS unsigned*)(lds + LDSCTL_OFF))[u] = 0u;
    __syncthreads();
    XcdBarrier bar = xcd_barrier_post(ctl + CW_BAR, MISC + 8);
#define GRID_BAR() xcd_barrier(bar)
    const int team_pm = 8 * (bx & 7) + ((bx >> 3) & 7), team_k = bx >> 6;
    unsigned team_epoch = 1u;
#define TEAM_BAR() team_barrier(ctl + CW_TEAM + 64 * team_pm, ctl + CW_BAR + XB_TMO, team_epoch, MISC + 12)
    if (tid == 0) __hip_atomic_store(ctl + CW_TEAM + 64 * team_pm + 8 + team_k, 0x100u | bar.x, __ATOMIC_RELAXED, __HIP_MEMORY_SCOPE_AGENT);
    const int NGW = G * NWAVES;
#define PHASE_IDS() int tid_l = threadIdx.x; asm volatile("" : "+v"(tid_l)); const int lane = tid_l & 63, wave = __builtin_amdgcn_readfirstlane(tid_l >> 6), gw = vcu * NWAVES + wave; (void)lane; (void)gw
    bf16* Win_t = (bf16*)(ws + WS_WIN); bf16* Wglu_t = (bf16*)(ws + WS_WGLU); bf16* Wo_t = (bf16*)(ws + WS_WO); bf16* Wgu_t = (bf16*)(ws + WS_WGU); bf16* Wd_t = (bf16*)(ws + WS_WD);
    bf16* R1 = (bf16*)(ws + WS_R1); bf16* Qp = (bf16*)(ws + WS_Q); bf16* Kp = (bf16*)(ws + WS_K); bf16* Vt = (bf16*)(ws + WS_VT); bf16* MIX = (bf16*)(ws + WS_R2);
    bf16* A2 = (bf16*)(ws + WS_A2); float* Zst = (float*)(ws + WS_ZS); bf16* Zb = (bf16*)(ws + WS_Z); bf16* A3 = (bf16*)(ws + WS_A3); float* stat_a = (float*)(ctl + CW_STAT_A); float* stat_s = (float*)(ctl + CW_STAT_S); bf16* HID = (bf16*)(ws + WS_HID);

    {
        PHASE_IDS();
        if (bx < NG) ssm_precompute(a, bx, lds, tid_l);
        else {
            LAS float* scr = (LAS float*)(lds + wave * 16384);
            constexpr int I_IN = (DM / 64) * (D_IN / 32), I_GLU = (D_SSM / 64) * (D_SSM / 32), I_O = (DM / 64) * (DM / 32);
            constexpr int NITEMS = I_IN;
#define EARLY_DESC(D, IT) do { D = TrDesc{a.w_in, Win_t, a.g_pre_mix, DM, D_IN, MAP_WIN, (IT)}; } while (0)
            TrDesc dc, dn; TrRegs tc, tn;
            const int NCW = (G - NG) * NWAVES; int it = (bx - NG) * NWAVES + wave;
            if (it < NITEMS) { EARLY_DESC(dc, it); tr_load(dc, lane, tc); }
            while (it < NITEMS) {
                const int nx = it + NCW; const bool more = nx < NITEMS;
                if (more) { EARLY_DESC(dn, nx); tr_load(dn, lane, tn); }
                tr_finish(dc, tc, scr, lane);
                if (more) { dc = dn; tc = tn; }
                it = nx;
            }
#undef EARLY_DESC
        }
        const int NW2 = (G - NG) * NWAVES, gw2 = (bx - NG) * NWAVES + wave;
        if (bx >= NG)
        for (int m = gw2; m < M; m += 2 * NW2) {
            f32x4 v[2][8]; float s[2];
#pragma unroll
            for (int q = 0; q < 2; ++q) { const int mq = (m + q * NW2 < M) ? m + q * NW2 : m; const f32x4* xr = (const f32x4*)(a.x + (size_t)mq * DM);
#pragma unroll
                for (int j = 0; j < 4; ++j) { v[q][2 * j] = xr[128 * j + 2 * lane]; v[q][2 * j + 1] = xr[128 * j + 2 * lane + 1]; } }
#pragma unroll
            for (int q = 0; q < 2; ++q) { float t = 0.f;
#pragma unroll
                for (int j = 0; j < 8; ++j) t += (v[q][j].x * v[q][j].x + v[q][j].y * v[q][j].y) + (v[q][j].z * v[q][j].z + v[q][j].w * v[q][j].w);
                s[q] = t; }
#pragma unroll
            for (int q = 0; q < 2; ++q) { const int mm = m + q * NW2; if (mm >= M) continue;
                const float ms = wave_sum(s[q]) * (1.0f / DM) + RMS_EPS; const float r = 1.0f / sqrtf(ms);
                if (lane == 0) ((float*)(ws + WS_RX))[mm] = sqrtf(ms);
                v4u* o = (v4u*)(R1 + (size_t)mm * DM);
#pragma unroll
                for (int j = 0; j < 4; ++j) { v4u w; w.x = cvt_pk_bf16(v[q][2 * j].x * r, v[q][2 * j].y * r); w.y = cvt_pk_bf16(v[q][2 * j].z * r, v[q][2 * j].w * r);
                    w.z = cvt_pk_bf16(v[q][2 * j + 1].x * r, v[q][2 * j + 1].y * r); w.w = cvt_pk_bf16(v[q][2 * j + 1].z * r, v[q][2 * j + 1].w * r); o[64 * j + lane] = w; } }
        }
    }
    GRID_BAR();

    {
        PHASE_IDS();
        pg8::Gemm g{R1, Win_t, DM, DM, DM}; pg8::StaticOrder S; S.init(M, 2304, G, bx);
        LAS int* posl = (LAS int*)(lds + LDSCTL_OFF + 1024);
        if (tid_l < 256) posl[tid_l] = a.pos[team_pm * 256 + tid_l];
        LDS_WAIT(); __syncthreads();
        pg8::EpiQKU E{Qp, Kp, A2, posl};
        pg8::gemm_phase<pg8::EpiQKU, pg8::StaticOrder, true>(lds, g, S, E);
        pg8::Gemm g2{Win_t + (size_t)2304 * DM, R1, DM, DM, DM}; pg8::StaticOrder S2; S2.init(256, M, G, (bx + 192) % G);
        pg8::EpiBf16P E2{Vt, M};
        pg8::gemm_phase<pg8::EpiBf16P, pg8::StaticOrder, true>(lds, g2, S2, E2);
        {
            int tid_c = threadIdx.x; asm volatile("" : "+v"(tid_c)); const int lane = tid_c & 63, wave = __builtin_amdgcn_readfirstlane(tid_c >> 6);
            LAS float* scr = (LAS float*)(lds + wave * 16384);
            constexpr int I_G = (DM / 64) * (D_FF / 32), I_D = (D_FF / 64) * (DM / 32);
            const int cw = (bx & (G / 2 - 1)) * NWAVES + wave, NCW = (G / 2) * NWAVES;
            constexpr int I_GLU = (D_SSM / 64) * (D_SSM / 32), I_O = (DM / 64) * (DM / 32);
            constexpr int NIT = I_GLU + I_O + 2 * I_G + I_D;
#define FFN_DESC(D, IT) do { int r_ = (IT); if (r_ < I_GLU) { D = TrDesc{a.w_glu, Wglu_t, nullptr, D_SSM, D_SSM, MAP_PLAIN, r_}; } \
                else if (r_ < I_GLU + I_O) { r_ -= I_GLU; D = TrDesc{a.w_o, Wo_t, (r_ / (DM / 32) < 16) ? a.g_attn_out : (a.g_ssm_out - 1024), DM, DM, MAP_PLAIN, r_}; } \
                else if ((r_ -= I_GLU + I_O) < I_G) { D = TrDesc{a.w_gate, Wgu_t, a.g_pre_ffn, DM, D_FF, MAP_GATE, r_}; } else if (r_ < 2 * I_G) { D = TrDesc{a.w_up, Wgu_t, a.g_pre_ffn, DM, D_FF, MAP_UP, r_ - I_G}; } \
                else { D = TrDesc{a.w_down, Wd_t, nullptr, D_FF, DM, MAP_PLAIN, r_ - 2 * I_G}; } } while (0)
            TrDesc dc, dn; TrRegs tc, tn;
            const int it_hi = (bx >= G / 2) ? NIT : (bx < G / 4 ? 1536 : (I_GLU + I_O));
            int it = (bx >= G / 2) ? (I_GLU + I_O) + cw : (bx < G / 4 ? cw : 1536 + (cw - 512));
            const int NCWx = (bx >= G / 2) ? NCW : 512;
            if (it < it_hi) { FFN_DESC(dc, it); tr_load(dc, lane, tc); }
            while (it < it_hi) {
                const int nx = it + NCWx; const bool more = nx < it_hi;
                if (more) { FFN_DESC(dn, nx); tr_load(dn, lane, tn); }
                tr_finish(dc, tc, scr, lane);
                if (more) { dc = dn; tc = tn; }
                it = nx;
            }
#undef FFN_DESC
        }
    }
    GRID_BAR();

    {
        PHASE_IDS();
        {
            pg8::Gemm g{A2, (const bf16*)(ws + WS_BZ), A2LD, 256, 256}; pg8::DiagOrder S{G, bx, 256};
            pg8::EpiZ E{Zst};
            pg8::gemm_phase<pg8::EpiZ, pg8::DiagOrder, true>(lds, g, S, E);
        }
        asm volatile("s_waitcnt vmcnt(0)" ::: "memory"); __syncthreads();
        {
            typedef float f32x2v __attribute__((ext_vector_type(2)));
            const int seq = wave >> 2, seg = wave & 3, g = bx >> 2, b = 2 * (bx & 3) + seq;
            const float lr = ((const float*)(ws + WS_LAM))[(g * 64 + lane) * 2], li = ((const float*)(ws + WS_LAM))[(g * 64 + lane) * 2 + 1];
            const size_t row0 = (size_t)g * 1024 + b * 128 + 32 * seg;
            const f32x2v* zp = (const f32x2v*)Zst + row0 * 64 + lane;
            f32x2v zz[32];
#pragma unroll
            for (int i = 0; i < 32; ++i) zz[i] = zp[(size_t)i * 64];
            float tr = 0.f, ti = 0.f;
#pragma unroll
            for (int i = 0; i < 32; ++i) { const float nr = lr * tr - li * ti + zz[i].x, ni = lr * ti + li * tr + zz[i].y; tr = nr; ti = ni; }
            float pr = lr, pi = li;
#pragma unroll
            for (int q = 0; q < 5; ++q) { const float nr = pr * pr - pi * pi, ni = 2.f * pr * pi; pr = nr; pi = ni; }
            LAS f32x2v* X = (LAS f32x2v*)lds;
            X[wave * 64 + lane] = (f32x2v){tr, ti};
            LDS_WAIT(); __syncthreads();
            float sr = 0.f, si = 0.f;
            for (int s = 0; s < seg; ++s) { const f32x2v t = X[(seq * 4 + s) * 64 + lane]; const float nr = pr * sr - pi * si + t.x, ni = pr * si + pi * sr + t.y; sr = nr; si = ni; }
            unsigned* sp = (unsigned*)(A2 + row0 * A2LD + 256) + lane;
#pragma unroll
            for (int i = 0; i < 32; ++i) {
                sp[(size_t)i * (A2LD / 2)] = cvt_pk_bf16(sr, si);
                const float nr = lr * sr - li * si + zz[i].x, ni = lr * si + li * sr + zz[i].y; sr = nr; si = ni;
            }
        }
        asm volatile("s_waitcnt vmcnt(0)" ::: "memory"); __syncthreads();
        {
            pg8::Gemm g{A2, (const bf16*)(ws + WS_TC), A2LD, A2LD, A2LD}; pg8::DiagOrder S{G, bx, 256};
            pg8::EpiY E{Zb};
            pg8::gemm_phase<pg8::EpiY, pg8::DiagOrder, true>(lds, g, S, E);
        }
        attn_phase(lds, vcu, G, Qp, Kp, Vt, a.sinks, A3, DM, stat_a);
    }
    GRID_BAR();

    if (tid == 0) { unsigned same = 1u; const unsigned me = 0x100u | bar.x;
        for (int k = 0; k < 4; ++k) same &= (xb_ld(ctl + CW_TEAM + 64 * team_pm + 8 + k) == me) ? 1u : 0u;
        MISC[12] = same; }
    __syncthreads();
    {
        PHASE_IDS();
        pg8::Gemm g{Zb, Wglu_t, D_SSM, D_SSM, D_SSM}; pg8::StaticOrder S; S.init(M, D_SSM, G, bx);
        pg8::EpiGlu E{Zb, a.b_glu, A3 + D_ATTN, DM, stat_s};
        pg8::gemm_phase<pg8::EpiGlu, pg8::StaticOrder, true>(lds, g, S, E);
    }
    TEAM_BAR();

    {
        PHASE_IDS();
        pg8::Gemm g{A3, Wo_t, DM, DM, DM}; pg8::StaticOrder S; S.init(M, DM, G, bx);
        LAS float* ratl = (LAS float*)(lds + LDSCTL_OFF + 2048); LAS float* rsl = ratl + 256;
        if (tid_l < 256) { const int row = team_pm * 256 + tid_l;
            const float sa = __uint_as_float(__hip_atomic_load((const unsigned*)(stat_a + row), __ATOMIC_RELAXED, __HIP_MEMORY_SCOPE_AGENT)), ss = __uint_as_float(__hip_atomic_load((const unsigned*)(stat_s + row), __ATOMIC_RELAXED, __HIP_MEMORY_SCOPE_AGENT));
            const float ra = 1.0f / sqrtf(sa * (1.0f / 1024.0f) + RMS_EPS), rsi = sqrtf(ss * (1.0f / 1024.0f) + RMS_EPS);
            ratl[tid_l] = ra * rsi; rsl[tid_l] = 1.0f / rsi; }
        LDS_WAIT(); __syncthreads();
        pg8::EpiMix E{MIX, DM, ratl, rsl};
        pg8::gemm_phase<pg8::EpiMix, pg8::StaticOrder, true>(lds, g, S, E);
    }
    TEAM_BAR();

    {
        PHASE_IDS();
        float* RH = (float*)(ws + WS_RH); const float* RX = (const float*)(ws + WS_RX);
        f32x4 gq[8];
#pragma unroll
        for (int j = 0; j < 4; ++j) { gq[2 * j] = ((const f32x4*)a.g_post_mix)[128 * j + 2 * lane]; gq[2 * j + 1] = ((const f32x4*)a.g_post_mix)[128 * j + 2 * lane + 1]; }
        for (int it = 0; it < 4; ++it) { const int mb = team_pm * 256 + team_k * 64 + wave * 8 + it * 2;
            v4u mv[2][4], xv[2][4]; float rxi[2], sm[2];
#pragma unroll
            for (int q = 0; q < 2; ++q) { const v4u* mr = (const v4u*)(MIX + (size_t)(mb + q) * DM); const v4u* xr = (const v4u*)(R1 + (size_t)(mb + q) * DM); rxi[q] = RX[mb + q];
#pragma unroll
                for (int j = 0; j < 4; ++j) { mv[q][j] = mr[64 * j + lane]; xv[q][j] = xr[64 * j + lane]; } }
#pragma unroll
            for (int q = 0; q < 2; ++q) { float t = 0.f;
#pragma unroll
                for (int j = 0; j < 4; ++j)
#pragma unroll
                    for (int e = 0; e < 4; ++e) { const float m0 = bf_lo(mv[q][j][e]), m1 = bf_hi(mv[q][j][e]); t += m0 * m0 + m1 * m1; }
                sm[q] = t; }
#pragma unroll
            for (int q = 0; q < 2; ++q) {
                const float rm = 1.0f / sqrtf(wave_sum(sm[q]) * (1.0f / DM) + RMS_EPS), rx = rxi[q];
                float sh = 0.f; v4u* xo = (v4u*)(R1 + (size_t)(mb + q) * DM); f32x4 hq[8];
#pragma unroll
                for (int j = 0; j < 4; ++j) {
                    const f32x4 g0 = gq[2 * j], g1 = gq[2 * j + 1]; const v4u mj = mv[q][j], xj = xv[q][j];
                    f32x4 h0, h1;
                    h0.x = bf_lo(xj.x) * rx + bf_lo(mj.x) * rm * g0.x; h0.y = bf_hi(xj.x) * rx + bf_hi(mj.x) * rm * g0.y; h0.z = bf_lo(xj.y) * rx + bf_lo(mj.y) * rm * g0.z; h0.w = bf_hi(xj.y) * rx + bf_hi(mj.y) * rm * g0.w;
                    h1.x = bf_lo(xj.z) * rx + bf_lo(mj.z) * rm * g1.x; h1.y = bf_hi(xj.z) * rx + bf_hi(mj.z) * rm * g1.y; h1.z = bf_lo(xj.w) * rx + bf_lo(mj.w) * rm * g1.z; h1.w = bf_hi(xj.w) * rx + bf_hi(mj.w) * rm * g1.w;
                    sh += (h0.x * h0.x + h0.y * h0.y) + (h0.z * h0.z + h0.w * h0.w) + (h1.x * h1.x + h1.y * h1.y) + (h1.z * h1.z + h1.w * h1.w);
                    hq[2 * j] = h0; hq[2 * j + 1] = h1;
                }
                const float msh = wave_sum(sh) * (1.0f / DM) + RMS_EPS, rh = 1.0f / sqrtf(msh);
                if (lane == 0) RH[mb + q] = sqrtf(msh);
#pragma unroll
                for (int j = 0; j < 4; ++j) { const f32x4 h0 = hq[2 * j] * rh, h1 = hq[2 * j + 1] * rh;
                    v4u w; w.x = cvt_pk_bf16(h0.x, h0.y); w.y = cvt_pk_bf16(h0.z, h0.w); w.z = cvt_pk_bf16(h1.x, h1.y); w.w = cvt_pk_bf16(h1.z, h1.w); xo[64 * j + lane] = w; }
            }
        }
    }
    TEAM_BAR();

    {
        PHASE_IDS();
        pg8::Gemm g{R1, Wgu_t, DM, DM, DM}; pg8::StaticOrder S; S.init(M, 2 * D_FF, G, bx);
        pg8::EpiSwiGLU E{HID, D_FF, (const float*)(ws + WS_RH)};
        pg8::gemm_phase<pg8::EpiSwiGLU, pg8::StaticOrder, true>(lds, g, S, E);
    }
    TEAM_BAR();

    {
        PHASE_IDS();
        pg8::Gemm g{HID, Wd_t, D_FF, D_FF, D_FF}; pg8::StaticOrder S; S.init(M, DM, G, bx);
        pg8::EpiBf16P E{MIX, DM};
        pg8::gemm_phase<pg8::EpiBf16P, pg8::StaticOrder, true>(lds, g, S, E);
    }
    TEAM_BAR();

    {
        PHASE_IDS();
        f32x4 gq[8];
#pragma unroll
        for (int j = 0; j < 4; ++j) { gq[2 * j] = ((const f32x4*)a.g_post_ffn)[128 * j + 2 * lane]; gq[2 * j + 1] = ((const f32x4*)a.g_post_ffn)[128 * j + 2 * lane + 1]; }
        for (int it = 0; it < 4; ++it) { const int mb = team_pm * 256 + team_k * 64 + wave * 8 + it * 2;
            v4u fv[2][4], hv[2][4]; float sf[2], rhi[2];
#pragma unroll
            for (int q = 0; q < 2; ++q) { const v4u* fr = (const v4u*)(MIX + (size_t)(mb + q) * DM); const v4u* hr = (const v4u*)(R1 + (size_t)(mb + q) * DM); rhi[q] = ((const float*)(ws + WS_RH))[mb + q];
#pragma unroll
                for (int j = 0; j < 4; ++j) { fv[q][j] = fr[64 * j + lane]; hv[q][j] = hr[64 * j + lane]; } }
#pragma unroll
            for (int q = 0; q < 2; ++q) { float t = 0.f;
#pragma unroll
                for (int j = 0; j < 4; ++j)
#pragma unroll
                    for (int e = 0; e < 4; ++e) { const float f0 = bf_lo(fv[q][j][e]), f1 = bf_hi(fv[q][j][e]); t += f0 * f0 + f1 * f1; }
                sf[q] = t; }
#pragma unroll
            for (int q = 0; q < 2; ++q) {
                const float rf = 1.0f / sqrtf(wave_sum(sf[q]) * (1.0f / DM) + RMS_EPS), rx = rhi[q]; f32x4* ho = (f32x4*)(a.out + (size_t)(mb + q) * DM);
#pragma unroll
                for (int j = 0; j < 4; ++j) {
                    const f32x4 g0 = gq[2 * j], g1 = gq[2 * j + 1]; const v4u fj = fv[q][j], hj = hv[q][j]; f32x4 h0, h1;
                    h0.x = bf_lo(hj.x) * rx + bf_lo(fj.x) * rf * g0.x; h0.y = bf_hi(hj.x) * rx + bf_hi(fj.x) * rf * g0.y; h0.z = bf_lo(hj.y) * rx + bf_lo(fj.y) * rf * g0.z; h0.w = bf_hi(hj.y) * rx + bf_hi(fj.y) * rf * g0.w;
                    h1.x = bf_lo(hj.z) * rx + bf_lo(fj.z) * rf * g1.x; h1.y = bf_hi(hj.z) * rx + bf_hi(fj.z) * rf * g1.y; h1.z = bf_lo(hj.w) * rx + bf_lo(fj.w) * rf * g1.z; h1.w = bf_hi(hj.w) * rx + bf_hi(fj.w) * rf * g1.w;
                    ho[128 * j + 2 * lane] = h0; ho[128 * j + 2 * lane + 1] = h1;
                }
            }
        }
    }
}

extern "C" void kernel_launch(void* const* d_in, const int* in_sizes, int n_in, void* d_out, int out_size, void* d_ws, size_t ws_size, hipStream_t stream) {
    static int grid = 0;
    if (grid == 0) {
        if (n_in != 24 || in_sizes[0] != M * DM || out_size != M * DM || ws_size < WS_END) { fprintf(stderr, "kernel_launch: unexpected shapes (n_in %d, in0 %d, out %d, ws %zu)\n", n_in, n_in > 0 ? in_sizes[0] : -1, out_size, ws_size); grid = -1; return; }
        int dev = 0, cus = 0;
        if (hipGetDevice(&dev) != hipSuccess || hipDeviceGetAttribute(&cus, hipDeviceAttributeMultiprocessorCount, dev) != hipSuccess) { grid = -1; return; }
        if (hipFuncSetAttribute((const void*)hymba_fwd, hipFuncAttributeMaxDynamicSharedMemorySize, LDS_BYTES) != hipSuccess) { fprintf(stderr, "kernel_launch: hipFuncSetAttribute failed\n"); grid = -1; return; }
        int per_cu = 0;
        (void)hipOccupancyMaxActiveBlocksPerMultiprocessor(&per_cu, (const void*)hymba_fwd, NWAVES * 64, LDS_BYTES);
        (void)hipGetLastError();
        grid = cus;
        if (grid != 256) { fprintf(stderr, "kernel_launch: built for a 256-CU device (team structure, SSM unit map); found %d CUs\n", cus); grid = -1; return; }
    }
    if (grid < 0) return;
    (void)hipMemsetAsync((char*)d_ws + WS_CTL, 0, CTL_ZERO_BYTES, stream);
    Args a{};
    a.x = (const float*)d_in[0]; a.pos = (const int*)d_in[1]; a.g_pre_mix = (const float*)d_in[2]; a.w_in = (const float*)d_in[3]; a.sinks = (const float*)d_in[4];
    a.a_re = (const float*)d_in[5]; a.a_im = (const float*)d_in[6]; a.log_dt = (const float*)d_in[7]; a.b_re = (const float*)d_in[8]; a.b_im = (const float*)d_in[9];
    a.c_re = (const float*)d_in[10]; a.c_im = (const float*)d_in[11]; a.d_skip = (const float*)d_in[12]; a.w_glu = (const float*)d_in[13]; a.b_glu = (const float*)d_in[14];
    a.g_attn_out = (const float*)d_in[15]; a.g_ssm_out = (const float*)d_in[16]; a.w_o = (const float*)d_in[17]; a.g_post_mix = (const float*)d_in[18]; a.g_pre_ffn = (const float*)d_in[19];
    a.w_gate = (const float*)d_in[20]; a.w_up = (const float*)d_in[21]; a.w_down = (const float*)d_in[22]; a.g_post_ffn = (const float*)d_in[23];
    a.out = (float*)d_out; a.ws = (unsigned char*)d_ws;
    hipLaunchKernelGGL(hymba_fwd, dim3(grid), dim3(NWAVES * 64), LDS_BYTES, stream, a);
}
```

```cpp
#include <hip/hip_runtime.h>
#include <cstdio>
#include <cstdint>

namespace pg8 {
#define PG8_LAS __attribute__((address_space(3)))
typedef unsigned short bf16_t;
typedef short bf16x8 __attribute__((ext_vector_type(8)));
typedef float f32x4 __attribute__((ext_vector_type(4)));
typedef unsigned u32x4 __attribute__((ext_vector_type(4)));
constexpr int BM = 256, BK = 64, HALF = 128, HTB = HALF * BK * 2, STAGE_BYTES = 8 * HTB, NXCD = 8, WGM = 8;

__host__ __device__ __forceinline__ int lds_byte(int r, int c) { const int st = (r >> 4) * 2 + (c >> 5), rr = r & 15, cc = c & 31, ob = rr * 64 + cc * 2; return st * 1024 + (ob ^ (((ob >> 9) & 1) << 5)); }
__host__ __device__ __forceinline__ void stage_rc(int b, int& R, int& C) { const int st = b / 1024, sb = b % 1024, swz = sb ^ (((sb >> 9) & 1) << 5); R = (st >> 1) * 16 + swz / 64; C = (st & 1) * 32 + (swz % 64) / 2; }
__host__ __device__ __forceinline__ int perm32(int rho) { const int n = rho >> 4, i = rho & 15; return 8 * (i >> 2) + 4 * n + (i & 3); }

struct Unit { int pm, pn; };
struct Gemm { const bf16_t* A; const bf16_t* Bt; int lda, ldb, K; };

struct StaticOrder {
    int nM, nN, nwg, G, c;
    __host__ __device__ void init(int M, int N, int G_, int c_) { nM = M / BM; nN = N / BM; nwg = nM * nN; G = G_; c = c_; }
    __host__ __device__ bool next(int i, Unit& u) const {
        const long L = (long)i * G + c; if (L >= nwg) return false;
        int wgid = (int)L; { const int q = nwg / NXCD, r = nwg % NXCD, xcd = wgid % NXCD, off = wgid / NXCD; wgid = (xcd < r ? xcd * (q + 1) : r * (q + 1) + (xcd - r) * q) + off; }
        const int nig = WGM * nN, gid = wgid / nig, fm = gid * WGM, gsz = (nM - fm) < WGM ? (nM - fm) : WGM;
        u.pm = fm + ((wgid % nig) % gsz); u.pn = (wgid % nig) / gsz; return true;
    }
};
struct DiagOrder {
    int G, c, n;
    __host__ __device__ bool next(int i, Unit& u) const { const int L = i * G + c; if (L >= n) return false; u.pm = L; u.pn = L >> 2; return true; }
};

__device__ __forceinline__ unsigned cvt_pk_bf16(float lo, float hi) { unsigned r; asm volatile("v_cvt_pk_bf16_f32 %0, %1, %2" : "=v"(r) : "v"(lo), "v"(hi)); return r; }
__device__ __forceinline__ float bf_lo(unsigned w) { return __uint_as_float(w << 16); }
__device__ __forceinline__ float bf_hi(unsigned w) { return __uint_as_float(w & 0xffff0000u); }
__device__ __forceinline__ float sigmoidf_(float x) { return __builtin_amdgcn_rcpf(1.0f + __builtin_amdgcn_exp2f(-1.4426950408889634f * x)); }
__device__ __forceinline__ float gelu_tanh(float x) { const float u = 1.5957691216057308f * (x + 0.044715f * x * x * x); return x * sigmoidf_(u); }

constexpr float ATT_C2 = 0.125f * 1.4426950408889634f;

struct EpiBf16P {
    static constexpr bool PERM = true, MIDK = false;
    bf16_t* O; int ldc;
    __device__ __forceinline__ void operator()(const f32x4 (&acc)[2][2][4][2], const Unit& u, int wr, int wc, int fr, int fq) const {
        const int row0 = u.pm * BM + wr * 64 + fr, col0 = u.pn * BM + wc * 32 + 8 * fq;
#pragma unroll
        for (int ai = 0; ai < 2; ++ai)
#pragma unroll
            for (int m = 0; m < 4; ++m) { bf16_t* rowp = O + (size_t)(row0 + ai * HALF + m * 16) * ldc + col0;
#pragma unroll
                for (int bj = 0; bj < 2; ++bj) { const f32x4 v0 = acc[ai][bj][m][0], v1 = acc[ai][bj][m][1];
                    u32x4 w; w.x = cvt_pk_bf16(v0[0], v0[1]); w.y = cvt_pk_bf16(v0[2], v0[3]); w.z = cvt_pk_bf16(v1[0], v1[1]); w.w = cvt_pk_bf16(v1[2], v1[3]);
                    *(u32x4*)(rowp + bj * HALF) = w; } }
    }
};
struct EpiMix {
    static constexpr bool PERM = true, MIDK = true;
    bf16_t* O; int ldc; const PG8_LAS float* ratio; const PG8_LAS float* rsl;
    __device__ __forceinline__ void midk(f32x4 (&acc)[2][2][4][2], const Unit& u, int wr, int fr) const {
#pragma unroll
        for (int ai = 0; ai < 2; ++ai)
#pragma unroll
            for (int m = 0; m < 4; ++m) { const float rt = ratio[wr * 64 + fr + ai * HALF + m * 16];
#pragma unroll
                for (int bj = 0; bj < 2; ++bj)
#pragma unroll
                    for (int n = 0; n < 2; ++n) acc[ai][bj][m][n] *= rt; }
    }
    __device__ __forceinline__ void operator()(const f32x4 (&acc)[2][2][4][2], const Unit& u, int wr, int wc, int fr, int fq) const {
        const int row0 = u.pm * BM + wr * 64 + fr, col0 = u.pn * BM + wc * 32 + 8 * fq;
#pragma unroll
        for (int ai = 0; ai < 2; ++ai)
#pragma unroll
            for (int m = 0; m < 4; ++m) { const int row = row0 + ai * HALF + m * 16; bf16_t* rowp = O + (size_t)row * ldc + col0;
                const float rs = rsl[wr * 64 + fr + ai * HALF + m * 16];
#pragma unroll
                for (int bj = 0; bj < 2; ++bj) { const f32x4 v0 = acc[ai][bj][m][0] * rs, v1 = acc[ai][bj][m][1] * rs;
                    u32x4 w; w.x = cvt_pk_bf16(v0[0], v0[1]); w.y = cvt_pk_bf16(v0[2], v0[3]); w.z = cvt_pk_bf16(v1[0], v1[1]); w.w = cvt_pk_bf16(v1[2], v1[3]);
                    *(u32x4*)(rowp + bj * HALF) = w; } }
    }
};
struct EpiQKU {
    static constexpr bool PERM = true, MIDK = false;
    bf16_t* Q; bf16_t* Kp; bf16_t* A2; const PG8_LAS int* posl;
    __device__ __forceinline__ void operator()(const f32x4 (&acc)[2][2][4][2], const Unit& u, int wr, int wc, int fr, int fq) const {
        const int row0 = u.pm * BM + wr * 64 + fr, cw = wc * 32 + 8 * fq;
        if (u.pn < 5) {
            const bool isq = u.pn < 4; const float sc = isq ? ATT_C2 : 1.0f;
            const int i0 = (cw & 63) >> 1;
            float invf[4];
#pragma unroll
            for (int t = 0; t < 4; ++t) invf[t] = __builtin_amdgcn_exp2f(-(float)(i0 + t) * (13.287712379549449f / 32.0f));
            bf16_t* base = isq ? (Q + u.pn * 256) : Kp; const int ld = isq ? 1024 : 256;
#pragma unroll
            for (int ai = 0; ai < 2; ++ai)
#pragma unroll
                for (int m = 0; m < 4; ++m) { const int row = row0 + ai * HALF + m * 16; const float p = (float)posl[wr * 64 + fr + ai * HALF + m * 16];
                    float cs[4], sn[4];
#pragma unroll
                    for (int t = 0; t < 4; ++t) { const float ang = p * invf[t]; const float fr_ = __builtin_amdgcn_fractf(ang * 0.15915494309189535f); sn[t] = __builtin_amdgcn_sinf(fr_) * sc; cs[t] = __builtin_amdgcn_cosf(fr_) * sc; }
#pragma unroll
                    for (int bj = 0; bj < 2; ++bj) { const f32x4 v0 = acc[ai][bj][m][0], v1 = acc[ai][bj][m][1];
                        u32x4 w;
                        w.x = cvt_pk_bf16(v0[0] * cs[0] - v0[1] * sn[0], v0[1] * cs[0] + v0[0] * sn[0]);
                        w.y = cvt_pk_bf16(v0[2] * cs[1] - v0[3] * sn[1], v0[3] * cs[1] + v0[2] * sn[1]);
                        w.z = cvt_pk_bf16(v1[0] * cs[2] - v1[1] * sn[2], v1[1] * cs[2] + v1[0] * sn[2]);
                        w.w = cvt_pk_bf16(v1[2] * cs[3] - v1[3] * sn[3], v1[3] * cs[3] + v1[2] * sn[3]);
                        *(u32x4*)(base + (size_t)row * ld + bj * HALF + cw) = w; } }
        } else {
#pragma unroll
            for (int ai = 0; ai < 2; ++ai)
#pragma unroll
                for (int m = 0; m < 4; ++m) { const int row = row0 + ai * HALF + m * 16;
#pragma unroll
                    for (int bj = 0; bj < 2; ++bj) { const f32x4 v0 = acc[ai][bj][m][0], v1 = acc[ai][bj][m][1];
                        const int gcol = (u.pn - 5) * 256 + bj * HALF + cw, g = gcol >> 4, q0 = gcol & 15;
                        u32x4 w; w.x = cvt_pk_bf16(v0[0], v0[1]); w.y = cvt_pk_bf16(v0[2], v0[3]); w.z = cvt_pk_bf16(v1[0], v1[1]); w.w = cvt_pk_bf16(v1[2], v1[3]);
                        *(u32x4*)(A2 + (size_t)g * (1024 * 384) + (size_t)(row >> 4) * 384 + (row & 15) * 16 + q0) = w; } }
        }
    }
};
struct EpiZ {
    static constexpr bool PERM = false, MIDK = false;
    float* Z;
    __device__ __forceinline__ void operator()(const f32x4 (&acc)[2][2][4][2], const Unit& u, int wr, int wc, int fr, int fq) const {
        const int row0 = u.pm * BM + wr * 64 + fr, col0 = wc * 32 + 4 * fq;
#pragma unroll
        for (int ai = 0; ai < 2; ++ai)
#pragma unroll
            for (int m = 0; m < 4; ++m) { float* rowp = Z + (size_t)(row0 + ai * HALF + m * 16) * 128 + col0;
#pragma unroll
                for (int n = 0; n < 2; ++n) *(f32x4*)(rowp + n * 16) = acc[ai][0][m][n]; }
    }
};
struct EpiY {
    static constexpr bool PERM = true, MIDK = false;
    bf16_t* Zb;
    __device__ __forceinline__ void operator()(const f32x4 (&acc)[2][2][4][2], const Unit& u, int wr, int wc, int fr, int fq) const {
        const int row0 = u.pm * BM + wr * 64 + fr, g = u.pn;
#pragma unroll
        for (int ai = 0; ai < 2; ++ai)
#pragma unroll
            for (int m = 0; m < 4; ++m) { const int bc = (row0 + ai * HALF + m * 16) & 1023;
#pragma unroll
                for (int bj = 0; bj < 2; ++bj) { const f32x4 v0 = acc[ai][bj][m][0], v1 = acc[ai][bj][m][1];
                    const int j = 8 * bj + 2 * wc + (fq >> 1), p0 = 8 * (fq & 1);
                    u32x4 w; w.x = cvt_pk_bf16(gelu_tanh(v0[0]), gelu_tanh(v0[1])); w.y = cvt_pk_bf16(gelu_tanh(v0[2]), gelu_tanh(v0[3]));
                    w.z = cvt_pk_bf16(gelu_tanh(v1[0]), gelu_tanh(v1[1])); w.w = cvt_pk_bf16(gelu_tanh(v1[2]), gelu_tanh(v1[3]));
                    *(u32x4*)(Zb + (size_t)(bc * 16 + j) * 1024 + g * 16 + p0) = w; asm volatile("" ::: "memory"); } }
    }
};
struct EpiGlu {
    static constexpr bool PERM = true, MIDK = false;
    const bf16_t* Zb; const float* bias; bf16_t* O; int ldo; float* st;
    __device__ __forceinline__ void operator()(const f32x4 (&acc)[2][2][4][2], const Unit& u, int wr, int wc, int fr, int fq) const {
        const int row0 = u.pm * BM + wr * 64 + fr, col0 = u.pn * BM + wc * 32 + 8 * fq;
        float part[2][4];
#pragma unroll
        for (int ai = 0; ai < 2; ++ai)
#pragma unroll
            for (int m = 0; m < 4; ++m) part[ai][m] = 0.f;
#pragma unroll
        for (int bj = 0; bj < 2; ++bj) { const f32x4 b0 = *(const f32x4*)(bias + col0 + bj * HALF), b1 = *(const f32x4*)(bias + col0 + bj * HALF + 4);
#pragma unroll
            for (int ai = 0; ai < 2; ++ai)
#pragma unroll
                for (int m = 0; m < 4; ++m) { const int row = row0 + ai * HALF + m * 16;
                    const u32x4 zi = *(const u32x4*)(Zb + (size_t)row * 1024 + col0 + bj * HALF); const f32x4 v0 = acc[ai][bj][m][0] + b0, v1 = acc[ai][bj][m][1] + b1;
                    float e[8];
                    e[0] = bf_lo(zi.x) * sigmoidf_(v0[0]); e[1] = bf_hi(zi.x) * sigmoidf_(v0[1]); e[2] = bf_lo(zi.y) * sigmoidf_(v0[2]); e[3] = bf_hi(zi.y) * sigmoidf_(v0[3]);
                    e[4] = bf_lo(zi.z) * sigmoidf_(v1[0]); e[5] = bf_hi(zi.z) * sigmoidf_(v1[1]); e[6] = bf_lo(zi.w) * sigmoidf_(v1[2]); e[7] = bf_hi(zi.w) * sigmoidf_(v1[3]);
                    part[ai][m] += (e[0] * e[0] + e[1] * e[1]) + (e[2] * e[2] + e[3] * e[3]) + (e[4] * e[4] + e[5] * e[5]) + (e[6] * e[6] + e[7] * e[7]);
                    u32x4 w; w.x = cvt_pk_bf16(e[0], e[1]); w.y = cvt_pk_bf16(e[2], e[3]); w.z = cvt_pk_bf16(e[4], e[5]); w.w = cvt_pk_bf16(e[6], e[7]);
                    *(u32x4*)(O + (size_t)row * ldo + col0 + bj * HALF) = w; } }
#pragma unroll
        for (int ai = 0; ai < 2; ++ai)
#pragma unroll
            for (int m = 0; m < 4; ++m) { float p = part[ai][m]; p += __shfl_xor(p, 16); p += __shfl_xor(p, 32);
                if (fq == 0) (void)__hip_atomic_fetch_add(st + row0 + ai * HALF + m * 16, p, __ATOMIC_RELAXED, __HIP_MEMORY_SCOPE_AGENT); }
    }
};
struct EpiSwiGLU {
    static constexpr bool PERM = true, MIDK = false;
    bf16_t* O; int ldc; const float* rs;
    __device__ __forceinline__ void operator()(const f32x4 (&acc)[2][2][4][2], const Unit& u, int wr, int wc, int fr, int fq) const {
        const int row0 = u.pm * BM + wr * 64 + fr, col0 = u.pn * HALF + wc * 32 + 8 * fq;
#pragma unroll
        for (int ai = 0; ai < 2; ++ai)
#pragma unroll
            for (int m = 0; m < 4; ++m) {
                const f32x4 g0 = acc[ai][0][m][0], g1 = acc[ai][0][m][1], u0 = acc[ai][1][m][0], u1 = acc[ai][1][m][1];
                u32x4 w;
                w.x = cvt_pk_bf16(g0[0] * sigmoidf_(g0[0]) * u0[0], g0[1] * sigmoidf_(g0[1]) * u0[1]); w.y = cvt_pk_bf16(g0[2] * sigmoidf_(g0[2]) * u0[2], g0[3] * sigmoidf_(g0[3]) * u0[3]);
                w.z = cvt_pk_bf16(g1[0] * sigmoidf_(g1[0]) * u1[0], g1[1] * sigmoidf_(g1[1]) * u1[1]); w.w = cvt_pk_bf16(g1[2] * sigmoidf_(g1[2]) * u1[2], g1[3] * sigmoidf_(g1[3]) * u1[3]);
                *(u32x4*)(O + (size_t)(row0 + ai * HALF + m * 16) * ldc + col0) = w; }
    }
};

template <class Epi, class Sched, bool ALIGN_EPI>
__device__ __forceinline__ void gemm_phase(PG8_LAS unsigned char* lds, const Gemm g, const Sched& S, const Epi& E) {
    int tid_ = threadIdx.x; asm volatile("" : "+v"(tid_));
    const int tid = tid_, wid = __builtin_amdgcn_readfirstlane(tid >> 6), lane = tid & 63, wr = wid >> 2, wc = wid & 3, fr = lane & 15, fq = lane >> 4;
    const int nt = g.K / BK;
    unsigned voffA[2], voffB[2];
#pragma unroll
    for (int i = 0; i < 2; ++i) { int R, C; stage_rc(tid * 16 + i * 8192, R, C); const int Rb = Epi::PERM ? ((R & ~31) + perm32(R & 31)) : R;
        voffA[i] = (unsigned)(R * g.lda + C) * 2u; voffB[i] = (unsigned)(Rb * g.ldb + C) * 2u; }
    const size_t kstep = (size_t)(BK * 2);
    const size_t hstepA = (size_t)HALF * g.lda * 2, hstepB = (size_t)HALF * g.ldb * 2;
    const size_t tstepA = 2 * hstepA, tstepB = 2 * hstepB;
    const unsigned ldsw = (unsigned)wid * 1024u;
    const size_t tailoff = (size_t)(nt - 2) * (size_t)(BK * 2);
    const int aoff = lds_byte(wr * 64 + fr, fq * 8), boff = lds_byte(wc * 32 + fr, fq * 8);
#define PG8_SA(b, h) (((b) * 2 + (h)) * HTB)
#define PG8_SB(b, h) ((4 + (b) * 2 + (h)) * HTB)
#define PG8_STAGE(bufoff, gbase, voff) do { _Pragma("unroll") for (int _i = 0; _i < 2; ++_i) \
        __builtin_amdgcn_global_load_lds((const unsigned*)((const char*)(gbase) + (voff)[_i]), (PG8_LAS unsigned*)(lds + (bufoff) + ldsw + _i * 8192), 16, 0, 0); } while (0)
#define PG8_LDA(dst, b, h) do { _Pragma("unroll") for (int m = 0; m < 4; ++m) _Pragma("unroll") for (int k = 0; k < 2; ++k) dst[m][k] = *(const PG8_LAS bf16x8*)(lds + PG8_SA(b, h) + aoff + m * 2048 + k * 1024); } while (0)
#define PG8_LDB(dst, b, h) do { _Pragma("unroll") for (int n = 0; n < 2; ++n) _Pragma("unroll") for (int k = 0; k < 2; ++k) dst[n][k] = *(const PG8_LAS bf16x8*)(lds + PG8_SB(b, h) + boff + n * 2048 + k * 1024); } while (0)
#define PG8_MMA(ai, bj, At, Bt) do { __builtin_amdgcn_s_setprio(1); _Pragma("unroll") for (int m = 0; m < 4; ++m) _Pragma("unroll") for (int n = 0; n < 2; ++n) _Pragma("unroll") for (int k = 0; k < 2; ++k) \
        acc[ai][bj][m][n] = __builtin_amdgcn_mfma_f32_16x16x32_bf16(Bt[n][k], At[m][k], acc[ai][bj][m][n], 0, 0, 0); __builtin_amdgcn_s_setprio(0); } while (0)
#define PG8_WAIT_V(n) asm volatile("s_waitcnt vmcnt(" #n ")" ::: "memory")
#define PG8_WAIT_L(n) asm volatile("s_waitcnt lgkmcnt(" #n ")" ::: "memory")
#define PG8_BAR __builtin_amdgcn_s_barrier()
#define PG8_SCHED __builtin_amdgcn_sched_barrier(0)
    Unit cur, nxt; int ui = 0;
    if (!S.next(0, cur)) return;
    f32x4 acc[2][2][4][2];
#pragma unroll
    for (int a = 0; a < 2; ++a)
#pragma unroll
        for (int b = 0; b < 2; ++b)
#pragma unroll
            for (int m = 0; m < 4; ++m)
#pragma unroll
                for (int n = 0; n < 2; ++n) acc[a][b][m][n] = (f32x4){0.f, 0.f, 0.f, 0.f};
    bf16x8 At[4][2], B0[2][2], B1[2][2];
    const char* cA = (const char*)g.A + (size_t)cur.pm * tstepA; const char* cB = (const char*)g.Bt + (size_t)cur.pn * tstepB;
    PG8_STAGE(PG8_SB(0, 0), cB, voffB); PG8_STAGE(PG8_SB(0, 1), cB + hstepB, voffB); PG8_STAGE(PG8_SA(0, 0), cA, voffA); PG8_STAGE(PG8_SA(0, 1), cA + hstepA, voffA);
    if (wr == 1) PG8_BAR;
    PG8_WAIT_V(2); PG8_BAR;
    PG8_STAGE(PG8_SB(1, 0), cB + kstep, voffB); PG8_STAGE(PG8_SA(1, 0), cA + kstep, voffA); PG8_STAGE(PG8_SB(1, 1), cB + hstepB + kstep, voffB);
    PG8_WAIT_V(6); PG8_BAR;
    for (;;) {
        const bool has_next = S.next(ui + 1, nxt);
        const size_t tail_ = has_next ? 0 : tailoff; const char* nA = (has_next ? (const char*)g.A + (size_t)nxt.pm * tstepA : cA) + tail_; const char* nB = (has_next ? (const char*)g.Bt + (size_t)nxt.pn * tstepB : cB) + tail_;
        for (int t = 0; t < nt; t += 2) {
            if constexpr (Epi::MIDK) { if (t == (nt >> 1)) E.midk(acc, cur, wr, fr); }
            const bool last = (t == nt - 2);
            const char* a1 = cA + (size_t)(t + 1) * kstep;
            const char* a2 = last ? nA : cA + (size_t)(t + 2) * kstep; const char* b2 = last ? nB : cB + (size_t)(t + 2) * kstep;
            const char* a3 = a2 + kstep; const char* b3 = b2 + kstep;
            PG8_LDB(B0, 0, 0); PG8_LDB(B1, 0, 1); PG8_SCHED; PG8_LDA(At, 0, 0); PG8_STAGE(PG8_SA(1, 1), a1 + hstepA, voffA);
            PG8_WAIT_V(8); PG8_WAIT_L(0); PG8_BAR; PG8_MMA(0, 0, At, B0); PG8_MMA(0, 1, At, B1); PG8_BAR; PG8_SCHED;
            PG8_LDA(At, 0, 1); PG8_STAGE(PG8_SB(0, 0), b2, voffB); PG8_STAGE(PG8_SB(0, 1), b2 + hstepB, voffB); PG8_STAGE(PG8_SA(0, 0), a2, voffA);
            PG8_WAIT_V(8); PG8_WAIT_L(0); PG8_BAR; PG8_MMA(1, 0, At, B0); PG8_MMA(1, 1, At, B1); PG8_BAR; PG8_SCHED;
            PG8_LDB(B0, 1, 0); PG8_LDB(B1, 1, 1); PG8_SCHED; PG8_LDA(At, 1, 0); PG8_STAGE(PG8_SA(0, 1), a2 + hstepA, voffA);
            PG8_WAIT_V(8); PG8_WAIT_L(0); PG8_BAR; PG8_MMA(0, 0, At, B0); PG8_MMA(0, 1, At, B1); PG8_BAR; PG8_SCHED;
            PG8_LDA(At, 1, 1); PG8_STAGE(PG8_SB(1, 0), b3, voffB); PG8_STAGE(PG8_SB(1, 1), b3 + hstepB, voffB); PG8_STAGE(PG8_SA(1, 0), a3, voffA);
            PG8_WAIT_V(8); PG8_WAIT_L(0); PG8_BAR; PG8_MMA(1, 0, At, B0); PG8_MMA(1, 1, At, B1); PG8_BAR; PG8_SCHED;
        }
        if constexpr (ALIGN_EPI) { if (wr == 0) PG8_BAR; }
        E(acc, cur, wr, wc, fr, fq);
        if (!has_next) break;
#pragma unroll
        for (int a = 0; a < 2; ++a)
#pragma unroll
            for (int b = 0; b < 2; ++b)
#pragma unroll
                for (int m = 0; m < 4; ++m)
#pragma unroll
                    for (int n = 0; n < 2; ++n) acc[a][b][m][n] = (f32x4){0.f, 0.f, 0.f, 0.f};
        cur = nxt; cA = nA; cB = nB; ++ui;
        if constexpr (ALIGN_EPI) { if (wr == 1) PG8_BAR; }
    }
    PG8_WAIT_V(0);
    if constexpr (!ALIGN_EPI) { if (wr == 0) PG8_BAR; }
    PG8_BAR;
#undef PG8_SA
#undef PG8_SB
#undef PG8_STAGE
#undef PG8_LDA
#undef PG8_LDB
#undef PG8_MMA
#undef PG8_WAIT_V
#undef PG8_WAIT_L
#undef PG8_BAR
#undef PG8_SCHED
}
}

constexpr int NWAVES = 8;
constexpr int BATCH = 8, SEQ = 2048, DM = 2048, M = BATCH * SEQ;
constexpr int D_ATTN = 1024, D_KV = 256, D_SSM = 1024, D_IN = 2560, D_FF = 5632, NQH = 16, NKVH = 4, HD = 64;
constexpr int NG = 64, NST = 64, PCH = 16, CH = 16, NCH = SEQ / CH;
constexpr int A2LD = 384;
constexpr float RMS_EPS = 1e-6f;

constexpr size_t MiB = 1u << 20;
constexpr size_t WS_CTL = 0, CTL_ZERO_BYTES = 1 * MiB;
constexpr size_t WS_WIN = 2 * MiB, WS_WGLU = 12 * MiB, WS_WO = 14 * MiB, WS_WGU = 22 * MiB, WS_WD = 66 * MiB;
constexpr size_t WS_TC = 88 * MiB, WS_BZ = 100 * MiB, WS_LAM = 108 * MiB, WS_RH = 109 * MiB, WS_RX = 110 * MiB;
constexpr size_t WS_R1 = 112 * MiB;
constexpr size_t WS_R2 = 176 * MiB;
constexpr size_t WS_Q = WS_R2, WS_K = WS_R2 + 32 * MiB, WS_VT = WS_R2 + 40 * MiB;
constexpr size_t WS_A3 = 240 * MiB, WS_Z = 304 * MiB;
constexpr size_t WS_A2 = 336 * MiB;
constexpr size_t WS_ZS = 384 * MiB;
constexpr size_t WS_HID = 336 * MiB;
constexpr size_t WS_END = 512 * MiB;
constexpr int CW_BAR = 4096, CW_TEAM = 16384, CW_STAT_A = 65536, CW_STAT_S = 81920;

constexpr int RING_BYTES = 131072, LDSCTL_OFF = RING_BYTES, MISC_OFF = LDSCTL_OFF + 320, LDS_BYTES = 147456;

#define GAS __attribute__((address_space(1)))
#define LAS __attribute__((address_space(3)))
typedef unsigned short bf16;
typedef unsigned v4u __attribute__((ext_vector_type(4)));
typedef unsigned v2u __attribute__((ext_vector_type(2)));
typedef float f32x4 __attribute__((ext_vector_type(4)));
typedef float f32x16 __attribute__((ext_vector_type(16)));
typedef short bf16x8 __attribute__((ext_vector_type(8)));
#define LDS_WAIT() asm volatile("s_waitcnt lgkmcnt(0)" ::: "memory")
using pg8::cvt_pk_bf16; using pg8::bf_lo; using pg8::bf_hi;

#define XB_TMO      128
#define XB_XCNT(j)  (256  + 64 * (j))
#define XB_XSUB(j)  (1280 + 64 * (j))
#define XB_XGEN(j)  (2304 + 64 * (j))
#define XB_TOP      3328
#define XB_TOPGEN   3392
#define XCD_BAR_WORDS 3456
#define XB_SPIN_CAP (1u << 18)
__device__ __forceinline__ unsigned xb_ld(unsigned* p)              { return __hip_atomic_load(p, __ATOMIC_RELAXED, __HIP_MEMORY_SCOPE_AGENT); }
__device__ __forceinline__ unsigned xb_add(unsigned* p, unsigned v) { return __hip_atomic_fetch_add(p, v, __ATOMIC_RELAXED, __HIP_MEMORY_SCOPE_AGENT); }
__device__ __forceinline__ unsigned xb_xcc_id() { return (unsigned)__builtin_amdgcn_s_getreg((3 << 11) | 20) & 0xFu; }
#define XB_SPIN(cond, bar) do { unsigned _sp = 0; while (cond) { __builtin_amdgcn_s_sleep(1); \
    if ((++_sp & 255u) == 0u) { if (xb_ld(&(bar)[XB_TMO])) break; if (_sp > XB_SPIN_CAP) { atomicAdd(&(bar)[XB_TMO], 1u); break; } } } } while (0)
struct XcdBarrier { unsigned* bar; unsigned x; volatile LAS unsigned* st; };
__device__ __forceinline__ XcdBarrier xcd_barrier_post(unsigned* bar, volatile LAS unsigned* st) {
    XcdBarrier b; b.bar = bar; b.x = xb_xcc_id(); b.st = st;
    if (threadIdx.x == 0) (void)xb_add(&bar[XB_XCNT(b.x)], 1u);
    return b;
}
__device__ __forceinline__ void xcd_barrier_complete(unsigned* bar, unsigned x, unsigned& nloc, unsigned& nx) {
    const unsigned G = gridDim.x * gridDim.y * gridDim.z;
    unsigned sum, cnt, mine, sp = 0u;
    for (;;) {
        sum = 0u; cnt = 0u; mine = 0u;
#pragma unroll
        for (unsigned j = 0; j < 16; ++j) { const unsigned c = xb_ld(&bar[XB_XCNT(j)]); sum += c; cnt += (c > 0u) ? 1u : 0u; mine = (j == x) ? c : mine; }
        if (sum == G) break;
        __builtin_amdgcn_s_sleep(1);
        if ((++sp & 255u) == 0u) { if (xb_ld(&bar[XB_TMO])) break; if (sp > XB_SPIN_CAP) { atomicAdd(&bar[XB_TMO], 1u); break; } }
    }
    nloc = mine > 0u ? mine : 1u; nx = cnt > 0u ? cnt : 1u;
}
__device__ __forceinline__ void xcd_barrier(const XcdBarrier& b) {
    asm volatile("s_waitcnt vmcnt(0)" ::: "memory");
    __syncthreads();
    if (threadIdx.x == 0) {
        unsigned* bar = b.bar;
        __builtin_amdgcn_s_waitcnt(0);
        unsigned nloc = b.st[0], nx = b.st[1];
        if (nloc == 0u) { xcd_barrier_complete(bar, b.x, nloc, nx); b.st[0] = nloc; b.st[1] = nx; }
        const unsigned old = xb_add(&bar[XB_XSUB(b.x)], 1u);
        const unsigned gen = old / nloc;
        if (old + 1u == (gen + 1u) * nloc) {
            __builtin_amdgcn_fence(__ATOMIC_RELEASE, "agent");
            asm volatile("s_waitcnt vmcnt(0)" ::: "memory");
            const unsigned og = xb_add(&bar[XB_TOP], 1u);
            const unsigned tg = og / nx;
            if (og + 1u == (tg + 1u) * nx) xb_add(&bar[XB_TOPGEN], 1u);
            else XB_SPIN(xb_ld(&bar[XB_TOPGEN]) == tg, bar);
            __builtin_amdgcn_fence(__ATOMIC_ACQUIRE, "agent");
            xb_add(&bar[XB_XGEN(b.x)], 1u);
            asm volatile("s_waitcnt vmcnt(0)" ::: "memory");
        } else {
            XB_SPIN(xb_ld(&bar[XB_XGEN(b.x)]) == gen, bar);
            __builtin_amdgcn_fence(__ATOMIC_ACQUIRE, "agent");
            asm volatile("s_waitcnt vmcnt(0)" ::: "memory");
        }
    }
    __syncthreads();
}

__device__ __forceinline__ void team_barrier(unsigned* cnt, unsigned* tmo, unsigned& epoch, volatile LAS unsigned* same_xcd) {
    asm volatile("s_waitcnt vmcnt(0)" ::: "memory");
    __syncthreads();
    if (threadIdx.x == 0) {
        if (*same_xcd != 1u) { __builtin_amdgcn_fence(__ATOMIC_RELEASE, "agent"); }
        asm volatile("s_waitcnt vmcnt(0)" ::: "memory");
        (void)xb_add(cnt, 1u);
        const unsigned want = 4u * epoch; unsigned sp = 0u;
        while (xb_ld(cnt) < want) { __builtin_amdgcn_s_sleep(1); if ((++sp & 255u) == 0u) { if (xb_ld(tmo)) break; if (sp > XB_SPIN_CAP) { atomicAdd(tmo, 1u); break; } } }
        __builtin_amdgcn_fence(__ATOMIC_ACQUIRE, "agent");
        asm volatile("s_waitcnt vmcnt(0)" ::: "memory");
    }
    __syncthreads();
    ++epoch;
}

__device__ __forceinline__ float wave_sum(float v) {
#pragma unroll
    for (int o = 1; o < 64; o <<= 1) v += __shfl_xor(v, o);
    return v;
}
__device__ __forceinline__ void sincos_rev(double rev, float& s, float& c) {
    const double fr = rev - __builtin_rint(rev); const float f = (float)fr;
    s = __builtin_amdgcn_sinf(f); c = __builtin_amdgcn_cosf(f);
}
enum { MAP_PLAIN = 0, MAP_WIN = 1, MAP_GATE = 2, MAP_UP = 3 };
template <int MODE> __device__ __forceinline__ int map_row(int n) {
    if (MODE == MAP_WIN) {
        if (n < 1280) { const int d = n & 63; return (n & ~63) + (d < 32 ? 2 * d : 2 * (d - 32) + 1); }
        if (n < 1536) return 2304 + (n - 1280);
        return 1280 + (n - 1536);
    }
    if (MODE == MAP_GATE) return ((n >> 7) << 8) + (n & 127);
    if (MODE == MAP_UP) return ((n >> 7) << 8) + 128 + (n & 127);
    return n;
}
template <int MODE> __device__ __forceinline__ void transpose_item(const float* W, int K, int N, bf16* WT, const float* gs, LAS float* scr, int item, int lane) {
    const int nblk = N / 32, kb = item / nblk, nb = item % nblk, k0 = 64 * kb, n0 = 32 * nb;
    const float* src = W + (size_t)(k0 + (lane >> 5)) * N + n0 + (lane & 31);
    float v[32];
#pragma unroll
    for (int i = 0; i < 32; ++i) v[i] = src[(size_t)(2 * i) * N];
    const int c = lane & 7;
    f32x4 g0 = (f32x4){1.f, 1.f, 1.f, 1.f}, g1 = g0;
    if (gs) { g0 = *(const f32x4*)(gs + k0 + 8 * c); g1 = *(const f32x4*)(gs + k0 + 8 * c + 4); }
    LAS float* sw = scr + (lane >> 5) * 33 + (lane & 31);
#pragma unroll
    for (int i = 0; i < 32; ++i) sw[(2 * i) * 33] = v[i];
    LDS_WAIT(); asm volatile("" ::: "memory");
#pragma unroll
    for (int j = 0; j < 4; ++j) { const int n = (lane >> 3) + 8 * j; const LAS float* s = scr + (8 * c) * 33 + n;
        v4u o; o.x = cvt_pk_bf16(s[0 * 33] * g0.x, s[1 * 33] * g0.y); o.y = cvt_pk_bf16(s[2 * 33] * g0.z, s[3 * 33] * g0.w); o.z = cvt_pk_bf16(s[4 * 33] * g1.x, s[5 * 33] * g1.y); o.w = cvt_pk_bf16(s[6 * 33] * g1.z, s[7 * 33] * g1.w);
        *(v4u*)(WT + (size_t)map_row<MODE>(n0 + n) * K + k0 + 8 * c) = o; }
    LDS_WAIT(); asm volatile("" ::: "memory");
}

struct TrDesc { const float* W; bf16* WT; const float* gs; int K, N, mode, item; };
struct TrRegs { float v[32]; f32x4 g0, g1; };
__device__ __forceinline__ int map_row_rt(int mode, int n) {
    if (mode == MAP_WIN) return map_row<MAP_WIN>(n);
    if (mode == MAP_GATE) return map_row<MAP_GATE>(n);
    if (mode == MAP_UP) return map_row<MAP_UP>(n);
    return n;
}
__device__ __forceinline__ void tr_load(const TrDesc& d, int lane, TrRegs& t) {
    const int nblk = d.N / 32, kb = d.item / nblk, nb = d.item - kb * nblk, k0 = 64 * kb, n0 = 32 * nb;
    const float* src = d.W + (size_t)(k0 + (lane >> 5)) * d.N + n0 + (lane & 31);
#pragma unroll
    for (int i = 0; i < 32; ++i) t.v[i] = __builtin_nontemporal_load(src + (size_t)(2 * i) * d.N);
    const int c = lane & 7;
    t.g0 = (f32x4){1.f, 1.f, 1.f, 1.f}; t.g1 = t.g0;
    if (d.gs) { t.g0 = *(const f32x4*)(d.gs + k0 + 8 * c); t.g1 = *(const f32x4*)(d.gs + k0 + 8 * c + 4); }
}
__device__ __forceinline__ void tr_finish(const TrDesc& d, const TrRegs& t, LAS float* scr, int lane) {
    const int nblk = d.N / 32, kb = d.item / nblk, nb = d.item - kb * nblk, k0 = 64 * kb, n0 = 32 * nb, c = lane & 7;
    LAS float* sw = scr + (lane >> 5) * 33 + (lane & 31);
#pragma unroll
    for (int i = 0; i < 32; ++i) sw[(2 * i) * 33] = t.v[i];
    LDS_WAIT(); asm volatile("" ::: "memory");
#pragma unroll
    for (int j = 0; j < 4; ++j) { const int n = (lane >> 3) + 8 * j; const LAS float* s = scr + (8 * c) * 33 + n;
        v4u o; o.x = cvt_pk_bf16(s[0 * 33] * t.g0.x, s[1 * 33] * t.g0.y); o.y = cvt_pk_bf16(s[2 * 33] * t.g0.z, s[3 * 33] * t.g0.w); o.z = cvt_pk_bf16(s[4 * 33] * t.g1.x, s[5 * 33] * t.g1.y); o.w = cvt_pk_bf16(s[6 * 33] * t.g1.z, s[7 * 33] * t.g1.w);
        *(v4u*)(d.WT + (size_t)map_row_rt(d.mode, n0 + n) * d.K + k0 + 8 * c) = o; }
    LDS_WAIT(); asm volatile("" ::: "memory");
}

struct Args {
    const float* x; const int* pos; const float* g_pre_mix; const float* w_in; const float* sinks; const float* a_re; const float* a_im; const float* log_dt;
    const float* b_re; const float* b_im; const float* c_re; const float* c_im; const float* d_skip; const float* w_glu; const float* b_glu;
    const float* g_attn_out; const float* g_ssm_out; const float* w_o; const float* g_post_mix; const float* g_pre_ffn; const float* w_gate; const float* w_up;
    const float* w_down; const float* g_post_ffn; float* out; unsigned char* ws;
};

__device__ __forceinline__ void ssm_precompute(const Args& a, int g, LAS unsigned char* lds, int tid) {
    typedef float f32x2v __attribute__((ext_vector_type(2)));
    LAS f32x2v* P = (LAS f32x2v*)lds;
    LAS f32x2v* Bb = (LAS f32x2v*)(lds + 8704);
    LAS f32x2v* Cc = (LAS f32x2v*)(lds + 8704 + 8192);
    LAS float* Kk = (LAS float*)(lds + 8704 + 16384);
    const float dt = __builtin_amdgcn_exp2f(a.log_dt[g] * 1.4426950408889634f);
    for (int e = tid; e < 17 * 64; e += 512) { const int k = e >> 6, n = e & 63; const float ar = a.a_re[g * 64 + n], ai = a.a_im[g * 64 + n];
        const float mag = __builtin_amdgcn_exp2f((float)k * ar * dt * 1.4426950408889634f); float s, c; sincos_rev((double)k * (double)ai * (double)dt * 0.15915494309189535, s, c);
        P[e] = (f32x2v){mag * c, mag * s}; }
    for (int e = tid; e < 1024; e += 512) { const int n = e >> 4; const float ar = a.a_re[g * 64 + n], ai = a.a_im[g * 64 + n];
        const float mag = __builtin_amdgcn_exp2f(ar * dt * 1.4426950408889634f); float s, c; sincos_rev((double)ai * (double)dt * 0.15915494309189535, s, c);
        const float lr = mag * c, li = mag * s, den = ar * ar + ai * ai, nr = lr - 1.0f, ni = li;
        const float fre = (nr * ar + ni * ai) / den, fim = (ni * ar - nr * ai) / den;
        const float br = a.b_re[(size_t)g * 1024 + e], bi = a.b_im[(size_t)g * 1024 + e];
        Bb[e] = (f32x2v){fre * br - fim * bi, fre * bi + fim * br};
        Cc[e] = (f32x2v){a.c_re[(size_t)g * 1024 + e], a.c_im[(size_t)g * 1024 + e]}; }
    LDS_WAIT(); __syncthreads();
    for (int e = tid; e < 4096; e += 512) { const int k = e >> 8, p = (e >> 4) & 15, q = e & 15; float s = 0.f;
        for (int n = 0; n < 64; ++n) { const f32x2v c = Cc[p * 64 + n], l = P[k * 64 + n], b = Bb[n * 16 + q];
            const float tr = c.x * l.x - c.y * l.y, ti = c.x * l.y + c.y * l.x; s += tr * b.x - ti * b.y; }
        Kk[e] = s; }
    LDS_WAIT(); __syncthreads();
    bf16* TC = (bf16*)(a.ws + WS_TC) + (size_t)g * 256 * A2LD;
    bf16* BZ = (bf16*)(a.ws + WS_BZ) + (size_t)g * 256 * 256;
    {
        const int row = tid >> 1, j = row >> 4, p = row & 15; const float dp = a.d_skip[g * 16 + p];
        for (int ci = 0; ci < 16; ++ci) { const int col0 = 128 * (tid & 1) + 8 * ci, i = col0 >> 4, q0 = col0 & 15; float v[8];
#pragma unroll
            for (int e = 0; e < 8; ++e) { float t = 0.f; if (i <= j) { t = Kk[((j - i) * 16 + p) * 16 + q0 + e]; if (i == j && q0 + e == p) t += dp; } v[e] = t; }
            v4u o; o.x = cvt_pk_bf16(v[0], v[1]); o.y = cvt_pk_bf16(v[2], v[3]); o.z = cvt_pk_bf16(v[4], v[5]); o.w = cvt_pk_bf16(v[6], v[7]);
            *(v4u*)(TC + (size_t)row * A2LD + col0) = o; }
        for (int ci = 0; ci < 8; ++ci) { const int n0 = 32 * (tid & 1) + 4 * ci; float v[8];
#pragma unroll
            for (int e = 0; e < 4; ++e) { const f32x2v c = Cc[p * 64 + n0 + e], l = P[(j + 1) * 64 + n0 + e]; v[2 * e] = c.x * l.x - c.y * l.y; v[2 * e + 1] = -(c.x * l.y + c.y * l.x); }
            v4u o; o.x = cvt_pk_bf16(v[0], v[1]); o.y = cvt_pk_bf16(v[2], v[3]); o.z = cvt_pk_bf16(v[4], v[5]); o.w = cvt_pk_bf16(v[6], v[7]);
            *(v4u*)(TC + (size_t)row * A2LD + 256 + 2 * n0) = o; }
    }
    {
        const int row = tid >> 2, n = row >> 1, ri = row & 1;
        for (int ci = 0; ci < 8; ++ci) { const int col0 = 64 * (tid & 3) + 8 * ci, i = col0 >> 4, q0 = col0 & 15; float v[8];
#pragma unroll
            for (int e = 0; e < 8; ++e) { const f32x2v l = P[(15 - i) * 64 + n], b = Bb[n * 16 + q0 + e]; v[e] = ri ? (l.x * b.y + l.y * b.x) : (l.x * b.x - l.y * b.y); }
            v4u o; o.x = cvt_pk_bf16(v[0], v[1]); o.y = cvt_pk_bf16(v[2], v[3]); o.z = cvt_pk_bf16(v[4], v[5]); o.w = cvt_pk_bf16(v[6], v[7]);
            *(v4u*)(BZ + (size_t)row * 256 + col0) = o;
            *(v4u*)(BZ + (size_t)(128 + row) * 256 + col0) = (v4u){0u, 0u, 0u, 0u}; }
    }
    if (tid < 64) { const f32x2v l = P[16 * 64 + tid]; ((float*)(a.ws + WS_LAM))[(g * 64 + tid) * 2] = l.x; ((float*)(a.ws + WS_LAM))[(g * 64 + tid) * 2 + 1] = l.y; }
    LDS_WAIT(); __syncthreads();
}

constexpr int AT_KROW = 144, AT_VROW = 392, AT_V_OFF = 192 * AT_KROW, AT_LDS_BYTES = AT_V_OFF + 64 * AT_VROW;
__device__ __forceinline__ int crow(int r, int hi) { return (r & 3) + 8 * (r >> 2) + 4 * hi; }
__device__ __forceinline__ void attn_phase(LAS unsigned char* lds, int vcu, int G, const bf16* Qp, const bf16* Kp, const bf16* Vt, const float* sinks, bf16* AO, int ldo, float* st) {
    typedef unsigned long long u64;
    int tid = threadIdx.x; asm volatile("" : "+v"(tid));
    const int lane = tid & 63, wave = __builtin_amdgcn_readfirstlane(tid >> 6), r32 = lane & 31, hi = lane >> 5, hq = wave & 3, qsub = wave >> 2;
    const float NEG = -INFINITY;
    float ssq_acc = 0.f;
    for (int it = 0; it < 4; ++it) { const int id = ((vcu >> 5) << 7) | (it << 5) | (vcu & 31);
        const int b = id >> 7, kvh = (id >> 5) & 3, q0 = 64 * (id & 31), h = kvh * 4 + hq;
        const size_t tok0 = (size_t)b * SEQ;
        const int jt0 = (q0 >= 128) ? 0 : (128 - q0) / 32;
        v4u kv[3], vv[3];
#pragma unroll
        for (int i = 0; i < 3; ++i) { const int c = tid + 512 * i, row = c >> 3, ch = c & 7, key = q0 - 128 + row;
            if (key >= 0) kv[i] = *(const v4u*)(Kp + (tok0 + key) * D_KV + kvh * HD + ch * 8); }
#pragma unroll
        for (int i = 0; i < 3; ++i) { const int c = tid + 512 * i, d = c / 24, ch = c - d * 24, key0 = q0 - 128 + 8 * ch;
            if (key0 >= 0) vv[i] = *(const v4u*)(Vt + (size_t)(kvh * HD + d) * M + tok0 + key0); }
        const bf16* qrow = Qp + (tok0 + q0 + 32 * qsub + r32) * D_ATTN + h * HD + 32 * hi;
        bf16x8 qf[4];
#pragma unroll
        for (int kk = 0; kk < 4; ++kk) qf[kk] = *(const bf16x8*)(qrow + 8 * kk);
#pragma unroll
        for (int i = 0; i < 3; ++i) { const int c = tid + 512 * i, row = c >> 3, ch = c & 7, key = q0 - 128 + row;
            if (key >= 0) *(LAS v4u*)(lds + row * AT_KROW + ch * 16) = kv[i]; }
#pragma unroll
        for (int i = 0; i < 3; ++i) { const int c = tid + 512 * i, d = c / 24, ch = c - d * 24, key0 = q0 - 128 + 8 * ch;
            if (key0 >= 0) { LAS u64* p = (LAS u64*)(lds + AT_V_OFF + d * AT_VROW + ch * 16); p[0] = ((u64)vv[i].y << 32) | vv[i].x; p[1] = ((u64)vv[i].w << 32) | vv[i].z; } }
        LDS_WAIT(); __syncthreads();
        f32x16 s[5];
#pragma unroll
        for (int kt = 0; kt < 5; ++kt) {
            if (kt + qsub >= jt0) {
                const LAS unsigned char* kp = lds + (32 * (kt + qsub) + r32) * AT_KROW + 64 * hi;
                f32x16 acc = {0.f, 0.f, 0.f, 0.f, 0.f, 0.f, 0.f, 0.f, 0.f, 0.f, 0.f, 0.f, 0.f, 0.f, 0.f, 0.f};
#pragma unroll
                for (int kk = 0; kk < 4; ++kk) acc = __builtin_amdgcn_mfma_f32_32x32x16_bf16(*(const LAS bf16x8*)(kp + 16 * kk), qf[kk], acc, 0, 0, 0);
                s[kt] = acc;
            } else {
#pragma unroll
                for (int r = 0; r < 16; ++r) s[kt][r] = NEG;
            }
        }
#pragma unroll
        for (int r = 0; r < 16; ++r) { const int cr = crow(r, hi); if (!(cr > r32)) s[0][r] = NEG; if (!(cr <= r32)) s[4][r] = NEG; }
        const float sk = sinks[h] * 1.4426950408889634f;
        float mx = sk;
#pragma unroll
        for (int kt = 0; kt < 5; ++kt)
#pragma unroll
            for (int r = 0; r < 16; ++r) mx = fmaxf(mx, s[kt][r]);
        mx = fmaxf(mx, __shfl_xor(mx, 32));
        float l = 0.f;
#pragma unroll
        for (int kt = 0; kt < 5; ++kt)
#pragma unroll
            for (int r = 0; r < 16; ++r) { const float p = __builtin_amdgcn_exp2f(s[kt][r] - mx); s[kt][r] = p; l += p; }
        l += __shfl_xor(l, 32);
        l += __builtin_amdgcn_exp2f(sk - mx);
        const float inv = 1.0f / l;
        f32x16 o[2];
#pragma unroll
        for (int d = 0; d < 2; ++d)
#pragma unroll
            for (int r = 0; r < 16; ++r) o[d][r] = 0.f;
#pragma unroll
        for (int kt = 0; kt < 5; ++kt) {
            if (kt + qsub >= jt0) {
#pragma unroll
                for (int s2 = 0; s2 < 2; ++s2) {
                    v4u pw; pw.x = cvt_pk_bf16(s[kt][8 * s2 + 0] * inv, s[kt][8 * s2 + 1] * inv); pw.y = cvt_pk_bf16(s[kt][8 * s2 + 2] * inv, s[kt][8 * s2 + 3] * inv);
                    pw.z = cvt_pk_bf16(s[kt][8 * s2 + 4] * inv, s[kt][8 * s2 + 5] * inv); pw.w = cvt_pk_bf16(s[kt][8 * s2 + 6] * inv, s[kt][8 * s2 + 7] * inv);
                    const bf16x8 pf = __builtin_bit_cast(bf16x8, pw);
#pragma unroll
                    for (int dh = 0; dh < 2; ++dh) {
                        const LAS u64* vp = (const LAS u64*)(lds + AT_V_OFF + (dh * 32 + r32) * AT_VROW + (32 * (kt + qsub) + 16 * s2 + 4 * hi) * 2);
                        const u64 lo = vp[0], hi8 = vp[2];
                        const v4u vw = (v4u){(unsigned)lo, (unsigned)(lo >> 32), (unsigned)hi8, (unsigned)(hi8 >> 32)};
                        o[dh] = __builtin_amdgcn_mfma_f32_32x32x16_bf16(__builtin_bit_cast(bf16x8, vw), pf, o[dh], 0, 0, 0);
                    }
                }
            }
        }
        {
            float ssq = 0.f;
#pragma unroll
            for (int dh = 0; dh < 2; ++dh)
#pragma unroll
                for (int r = 0; r < 16; ++r) ssq += o[dh][r] * o[dh][r];
            ssq += __shfl_xor(ssq, 32);
            ssq_acc += ssq;
        }
        bf16* orow = AO + (tok0 + q0 + 32 * qsub + r32) * (size_t)ldo + h * HD + 4 * hi;
#pragma unroll
        for (int dh = 0; dh < 2; ++dh)
#pragma unroll
            for (int g4 = 0; g4 < 4; ++g4) { v2u w; w.x = cvt_pk_bf16(o[dh][4 * g4], o[dh][4 * g4 + 1]); w.y = cvt_pk_bf16(o[dh][4 * g4 + 2], o[dh][4 * g4 + 3]);
                *(v2u*)(orow + dh * 32 + 8 * g4) = w; }
        LDS_WAIT(); __syncthreads();
    }
    {
        LAS float* Xs = (LAS float*)lds;
        if (hi == 0) Xs[(qsub * 4 + hq) * 32 + r32] = ssq_acc;
        LDS_WAIT(); __syncthreads();
        if (hq == 0 && hi == 0) { const float tot = (Xs[(qsub * 4 + 0) * 32 + r32] + Xs[(qsub * 4 + 1) * 32 + r32]) + (Xs[(qsub * 4 + 2) * 32 + r32] + Xs[(qsub * 4 + 3) * 32 + r32]);
            st[(size_t)(vcu >> 5) * SEQ + 64 * (vcu & 31) + 32 * qsub + r32] = tot; }
        LDS_WAIT(); __syncthreads();
    }
}

__global__ void __launch_bounds__(NWAVES * 64, 2) hymba_fwd(Args a) {
    extern __shared__ __attribute__((aligned(16))) unsigned char lds_raw[];
    LAS unsigned char* lds = (LAS unsigned char*)lds_raw;
    volatile LAS unsigned* MISC = (volatile LAS unsigned*)(lds + MISC_OFF);
    const int tid = threadIdx.x;
    const int G = gridDim.x; const int bx = blockIdx.x; const int vcu = (G % 8 == 0) ? (bx % 8) * (G / 8) + bx / 8 : bx;
    unsigned char* ws = a.ws;
    unsigned* ctl = (unsigned*)(ws + WS_CTL);
    for (int u = tid; u < (LDS_BYTES - LDSCTL_OFF) / 4; u += NWAVES * 64) ((LAS unsigned*)(lds + LDSCTL_OFF))[u] = 0u;
    __syncthreads();
    XcdBarrier bar = xcd_barrier_post(ctl + CW_BAR, MISC + 8);
#define GRID_BAR() xcd_barrier(bar)
    const int team_pm = 8 * (bx & 7) + ((bx >> 3) & 7), team_k = bx >> 6;
    unsigned team_epoch = 1u;
#define TEAM_BAR() team_barrier(ctl + CW_TEAM + 64 * team_pm, ctl + CW_BAR + XB_TMO, team_epoch, MISC + 12)
    if (tid == 0) __hip_atomic_store(ctl + CW_TEAM + 64 * team_pm + 8 + team_k, 0x100u | bar.x, __ATOMIC_RELAXED, __HIP_MEMORY_SCOPE_AGENT);
    const int NGW = G * NWAVES;
#define PHASE_IDS() int tid_l = threadIdx.x; asm volatile("" : "+v"(tid_l)); const int lane = tid_l & 63, wave = __builtin_amdgcn_readfirstlane(tid_l >> 6), gw = vcu * NWAVES + wave; (void)lane; (void)gw
    bf16* Win_t = (bf16*)(ws + WS_WIN); bf16* Wglu_t = (bf16*)(ws + WS_WGLU); bf16* Wo_t = (bf16*)(ws + WS_WO); bf16* Wgu_t = (bf16*)(ws + WS_WGU); bf16* Wd_t = (bf16*)(ws + WS_WD);
    bf16* R1 = (bf16*)(ws + WS_R1); bf16* Qp = (bf16*)(ws + WS_Q); bf16* Kp = (bf16*)(ws + WS_K); bf16* Vt = (bf16*)(ws + WS_VT); bf16* MIX = (bf16*)(ws + WS_R2);
    bf16* A2 = (bf16*)(ws + WS_A2); float* Zst = (float*)(ws + WS_ZS); bf16* Zb = (bf16*)(ws + WS_Z); bf16* A3 = (bf16*)(ws + WS_A3); float* stat_a = (float*)(ctl + CW_STAT_A); float* stat_s = (float*)(ctl + CW_STAT_S); bf16* HID = (bf16*)(ws + WS_HID);

    {
        PHASE_IDS();
        if (bx < NG) ssm_precompute(a, bx, lds, tid_l);
        else {
            LAS float* scr = (LAS float*)(lds + wave * 16384);
            constexpr int I_IN = (DM / 64) * (D_IN / 32), I_GLU = (D_SSM / 64) * (D_SSM / 32), I_O = (DM / 64) * (DM / 32);
            constexpr int NITEMS = I_IN;
#define EARLY_DESC(D, IT) do { D = TrDesc{a.w_in, Win_t, a.g_pre_mix, DM, D_IN, MAP_WIN, (IT)}; } while (0)
            TrDesc dc, dn; TrRegs tc, tn;
            const int NCW = (G - NG) * NWAVES; int it = (bx - NG) * NWAVES + wave;
            if (it < NITEMS) { EARLY_DESC(dc, it); tr_load(dc, lane, tc); }
            while (it < NITEMS) {
                const int nx = it + NCW; const bool more = nx < NITEMS;
                if (more) { EARLY_DESC(dn, nx); tr_load(dn, lane, tn); }
                tr_finish(dc, tc, scr, lane);
                if (more) { dc = dn; tc = tn; }
                it = nx;
            }
#undef EARLY_DESC
        }
        const bool isS = bx < NG;
        const int NW2 = isS ? NG * NWAVES : (G - NG) * NWAVES, mEnd = isS ? 1024 : M;
        for (int m = isS ? bx * NWAVES + wave : 1024 + (bx - NG) * NWAVES + wave; m < mEnd; m += 2 * NW2) {
            f32x4 v[2][8]; float s[2];
#pragma unroll
            for (int q = 0; q < 2; ++q) { const int mq = (m + q * NW2 < mEnd) ? m + q * NW2 : m; const f32x4* xr = (const f32x4*)(a.x + (size_t)mq * DM);
#pragma unroll
                for (int j = 0; j < 4; ++j) { v[q][2 * j] = xr[128 * j + 2 * lane]; v[q][2 * j + 1] = xr[128 * j + 2 * lane + 1]; } }
#pragma unroll
            for (int q = 0; q < 2; ++q) { float t = 0.f;
#pragma unroll
                for (int j = 0; j < 8; ++j) t += (v[q][j].x * v[q][j].x + v[q][j].y * v[q][j].y) + (v[q][j].z * v[q][j].z + v[q][j].w * v[q][j].w);
                s[q] = t; }
#pragma unroll
            for (int q = 0; q < 2; ++q) { const int mm = m + q * NW2; if (mm >= mEnd) continue;
                const float ms = wave_sum(s[q]) * (1.0f / DM) + RMS_EPS; const float r = 1.0f / sqrtf(ms);
                if (lane == 0) ((float*)(ws + WS_RX))[mm] = sqrtf(ms);
                v4u* o = (v4u*)(R1 + (size_t)mm * DM);
#pragma unroll
                for (int j = 0; j < 4; ++j) { v4u w; w.x = cvt_pk_bf16(v[q][2 * j].x * r, v[q][2 * j].y * r); w.y = cvt_pk_bf16(v[q][2 * j].z * r, v[q][2 * j].w * r);
                    w.z = cvt_pk_bf16(v[q][2 * j + 1].x * r, v[q][2 * j + 1].y * r); w.w = cvt_pk_bf16(v[q][2 * j + 1].z * r, v[q][2 * j + 1].w * r); o[64 * j + lane] = w; } }
        }
    }
    GRID_BAR();

    {
        PHASE_IDS();
        pg8::Gemm g{R1, Win_t, DM, DM, DM}; pg8::StaticOrder S; S.init(M, 2304, G, bx);
        LAS int* posl = (LAS int*)(lds + LDSCTL_OFF + 1024);
        if (tid_l < 256) posl[tid_l] = a.pos[team_pm * 256 + tid_l];
        LDS_WAIT(); __syncthreads();
        pg8::EpiQKU E{Qp, Kp, A2, posl};
        pg8::gemm_phase<pg8::EpiQKU, pg8::StaticOrder, true>(lds, g, S, E);
        pg8::Gemm g2{Win_t + (size_t)2304 * DM, R1, DM, DM, DM}; pg8::StaticOrder S2; S2.init(256, M, G, (bx + 192) % G);
        pg8::EpiBf16P E2{Vt, M};
        pg8::gemm_phase<pg8::EpiBf16P, pg8::StaticOrder, true>(lds, g2, S2, E2);
        {
            int tid_c = threadIdx.x; asm volatile("" : "+v"(tid_c)); const int lane = tid_c & 63, wave = __builtin_amdgcn_readfirstlane(tid_c >> 6);
            LAS float* scr = (LAS float*)(lds + wave * 16384);
            constexpr int I_G = (DM / 64) * (D_FF / 32), I_D = (D_FF / 64) * (DM / 32);
            const int cw = (bx & (G / 2 - 1)) * NWAVES + wave, NCW = (G / 2) * NWAVES;
            constexpr int I_GLU = (D_SSM / 64) * (D_SSM / 32), I_O = (DM / 64) * (DM / 32);
            constexpr int NIT = I_GLU + I_O + 2 * I_G + I_D;
#define FFN_DESC(D, IT) do { int r_ = (IT); if (r_ < I_GLU) { D = TrDesc{a.w_glu, Wglu_t, nullptr, D_SSM, D_SSM, MAP_PLAIN, r_}; } \
                else if (r_ < I_GLU + I_O) { r_ -= I_GLU; D = TrDesc{a.w_o, Wo_t, (r_ / (DM / 32) < 16) ? a.g_attn_out : (a.g_ssm_out - 1024), DM, DM, MAP_PLAIN, r_}; } \
                else if ((r_ -= I_GLU + I_O) < I_G) { D = TrDesc{a.w_gate, Wgu_t, a.g_pre_ffn, DM, D_FF, MAP_GATE, r_}; } else if (r_ < 2 * I_G) { D = TrDesc{a.w_up, Wgu_t, a.g_pre_ffn, DM, D_FF, MAP_UP, r_ - I_G}; } \
                else { D = TrDesc{a.w_down, Wd_t, nullptr, D_FF, DM, MAP_PLAIN, r_ - 2 * I_G}; } } while (0)
            TrDesc dc, dn; TrRegs tc, tn;
            const int it_hi = (bx >= G / 2) ? NIT : (bx < G / 4 ? 1536 : (I_GLU + I_O));
            int it = (bx >= G / 2) ? (I_GLU + I_O) + cw : (bx < G / 4 ? cw : 1536 + (cw - 512));
            const int NCWx = (bx >= G / 2) ? NCW : 512;
            if (it < it_hi) { FFN_DESC(dc, it); tr_load(dc, lane, tc); }
            while (it < it_hi) {
                const int nx = it + NCWx; const bool more = nx < it_hi;
                if (more) { FFN_DESC(dn, nx); tr_load(dn, lane, tn); }
                tr_finish(dc, tc, scr, lane);
                if (more) { dc = dn; tc = tn; }
                it = nx;
            }
#undef FFN_DESC
        }
    }
    GRID_BAR();

    {
        PHASE_IDS();
        {
            pg8::Gemm g{A2, (const bf16*)(ws + WS_BZ), A2LD, 256, 256}; pg8::DiagOrder S{G, bx, 256};
            pg8::EpiZ E{Zst};
            pg8::gemm_phase<pg8::EpiZ, pg8::DiagOrder, true>(lds, g, S, E);
        }
        asm volatile("s_waitcnt vmcnt(0)" ::: "memory"); __syncthreads();
        {
            typedef float f32x2v __attribute__((ext_vector_type(2)));
            const int seq = wave >> 2, seg = wave & 3, g = bx >> 2, b = 2 * (bx & 3) + seq;
            const float lr = ((const float*)(ws + WS_LAM))[(g * 64 + lane) * 2], li = ((const float*)(ws + WS_LAM))[(g * 64 + lane) * 2 + 1];
            const size_t row0 = (size_t)g * 1024 + b * 128 + 32 * seg;
            const f32x2v* zp = (const f32x2v*)Zst + row0 * 64 + lane;
            f32x2v zz[32];
#pragma unroll
            for (int i = 0; i < 32; ++i) zz[i] = zp[(size_t)i * 64];
            float tr = 0.f, ti = 0.f;
#pragma unroll
            for (int i = 0; i < 32; ++i) { const float nr = lr * tr - li * ti + zz[i].x, ni = lr * ti + li * tr + zz[i].y; tr = nr; ti = ni; }
            float pr = lr, pi = li;
#pragma unroll
            for (int q = 0; q < 5; ++q) { const float nr = pr * pr - pi * pi, ni = 2.f * pr * pi; pr = nr; pi = ni; }
            LAS f32x2v* X = (LAS f32x2v*)lds;
            X[wave * 64 + lane] = (f32x2v){tr, ti};
            LDS_WAIT(); __syncthreads();
            float sr = 0.f, si = 0.f;
            for (int s = 0; s < seg; ++s) { const f32x2v t = X[(seq * 4 + s) * 64 + lane]; const float nr = pr * sr - pi * si + t.x, ni = pr * si + pi * sr + t.y; sr = nr; si = ni; }
            unsigned* sp = (unsigned*)(A2 + row0 * A2LD + 256) + lane;
#pragma unroll
            for (int i = 0; i < 32; ++i) {
                sp[(size_t)i * (A2LD / 2)] = cvt_pk_bf16(sr, si);
                const float nr = lr * sr - li * si + zz[i].x, ni = lr * si + li * sr + zz[i].y; sr = nr; si = ni;
            }
        }
        asm volatile("s_waitcnt vmcnt(0)" ::: "memory"); __syncthreads();
        {
            pg8::Gemm g{A2, (const bf16*)(ws + WS_TC), A2LD, A2LD, A2LD}; pg8::DiagOrder S{G, bx, 256};
            pg8::EpiY E{Zb};
            pg8::gemm_phase<pg8::EpiY, pg8::DiagOrder, true>(lds, g, S, E);
        }
        attn_phase(lds, vcu, G, Qp, Kp, Vt, a.sinks, A3, DM, stat_a);
    }
    GRID_BAR();

    if (tid == 0) { unsigned same = 1u; const unsigned me = 0x100u | bar.x;
        for (int k = 0; k < 4; ++k) same &= (xb_ld(ctl + CW_TEAM + 64 * team_pm + 8 + k) == me) ? 1u : 0u;
        MISC[12] = same; }
    __syncthreads();
    {
        PHASE_IDS();
        pg8::Gemm g{Zb, Wglu_t, D_SSM, D_SSM, D_SSM}; pg8::StaticOrder S; S.init(M, D_SSM, G, bx);
        pg8::EpiGlu E{Zb, a.b_glu, A3 + D_ATTN, DM, stat_s};
        pg8::gemm_phase<pg8::EpiGlu, pg8::StaticOrder, true>(lds, g, S, E);
    }
    TEAM_BAR();

    {
        PHASE_IDS();
        pg8::Gemm g{A3, Wo_t, DM, DM, DM}; pg8::StaticOrder S; S.init(M, DM, G, bx);
        LAS float* ratl = (LAS float*)(lds + LDSCTL_OFF + 2048); LAS float* rsl = ratl + 256;
        if (tid_l < 256) { const int row = team_pm * 256 + tid_l;
            const float sa = __uint_as_float(__hip_atomic_load((const unsigned*)(stat_a + row), __ATOMIC_RELAXED, __HIP_MEMORY_SCOPE_AGENT)), ss = __uint_as_float(__hip_atomic_load((const unsigned*)(stat_s + row), __ATOMIC_RELAXED, __HIP_MEMORY_SCOPE_AGENT));
            const float ra = 1.0f / sqrtf(sa * (1.0f / 1024.0f) + RMS_EPS), rsi = sqrtf(ss * (1.0f / 1024.0f) + RMS_EPS);
            ratl[tid_l] = ra * rsi; rsl[tid_l] = 1.0f / rsi; }
        LDS_WAIT(); __syncthreads();
        pg8::EpiMix E{MIX, DM, ratl, rsl};
        pg8::gemm_phase<pg8::EpiMix, pg8::StaticOrder, true>(lds, g, S, E);
    }
    TEAM_BAR();

    {
        PHASE_IDS();
        float* RH = (float*)(ws + WS_RH); const float* RX = (const float*)(ws + WS_RX);
        f32x4 gq[8];
#pragma unroll
        for (int j = 0; j < 4; ++j) { gq[2 * j] = ((const f32x4*)a.g_post_mix)[128 * j + 2 * lane]; gq[2 * j + 1] = ((const f32x4*)a.g_post_mix)[128 * j + 2 * lane + 1]; }
        for (int it = 0; it < 4; ++it) { const int mb = team_pm * 256 + team_k * 64 + wave * 8 + it * 2;
            v4u mv[2][4], xv[2][4]; float rxi[2], sm[2];
#pragma unroll
            for (int q = 0; q < 2; ++q) { const v4u* mr = (const v4u*)(MIX + (size_t)(mb + q) * DM); const v4u* xr = (const v4u*)(R1 + (size_t)(mb + q) * DM); rxi[q] = RX[mb + q];
#pragma unroll
                for (int j = 0; j < 4; ++j) { mv[q][j] = mr[64 * j + lane]; xv[q][j] = xr[64 * j + lane]; } }
#pragma unroll
            for (int q = 0; q < 2; ++q) { float t = 0.f;
#pragma unroll
                for (int j = 0; j < 4; ++j)
#pragma unroll
                    for (int e = 0; e < 4; ++e) { const float m0 = bf_lo(mv[q][j][e]), m1 = bf_hi(mv[q][j][e]); t += m0 * m0 + m1 * m1; }
                sm[q] = t; }
#pragma unroll
            for (int q = 0; q < 2; ++q) {
                const float rm = 1.0f / sqrtf(wave_sum(sm[q]) * (1.0f / DM) + RMS_EPS), rx = rxi[q];
                float sh = 0.f; v4u* xo = (v4u*)(R1 + (size_t)(mb + q) * DM); f32x4 hq[8];
#pragma unroll
                for (int j = 0; j < 4; ++j) {
                    const f32x4 g0 = gq[2 * j], g1 = gq[2 * j + 1]; const v4u mj = mv[q][j], xj = xv[q][j];
                    f32x4 h0, h1;
                    h0.x = bf_lo(xj.x) * rx + bf_lo(mj.x) * rm * g0.x; h0.y = bf_hi(xj.x) * rx + bf_hi(mj.x) * rm * g0.y; h0.z = bf_lo(xj.y) * rx + bf_lo(mj.y) * rm * g0.z; h0.w = bf_hi(xj.y) * rx + bf_hi(mj.y) * rm * g0.w;
                    h1.x = bf_lo(xj.z) * rx + bf_lo(mj.z) * rm * g1.x; h1.y = bf_hi(xj.z) * rx + bf_hi(mj.z) * rm * g1.y; h1.z = bf_lo(xj.w) * rx + bf_lo(mj.w) * rm * g1.z; h1.w = bf_hi(xj.w) * rx + bf_hi(mj.w) * rm * g1.w;
                    sh += (h0.x * h0.x + h0.y * h0.y) + (h0.z * h0.z + h0.w * h0.w) + (h1.x * h1.x + h1.y * h1.y) + (h1.z * h1.z + h1.w * h1.w);
                    hq[2 * j] = h0; hq[2 * j + 1] = h1;
                }
                const float msh = wave_sum(sh) * (1.0f / DM) + RMS_EPS, rh = 1.0f / sqrtf(msh);
                if (lane == 0) RH[mb + q] = sqrtf(msh);
#pragma unroll
                for (int j = 0; j < 4; ++j) { const f32x4 h0 = hq[2 * j] * rh, h1 = hq[2 * j + 1] * rh;
                    v4u w; w.x = cvt_pk_bf16(h0.x, h0.y); w.y = cvt_pk_bf16(h0.z, h0.w); w.z = cvt_pk_bf16(h1.x, h1.y); w.w = cvt_pk_bf16(h1.z, h1.w); xo[64 * j + lane] = w; }
            }
        }
    }
    TEAM_BAR();

    {
        PHASE_IDS();
        pg8::Gemm g{R1, Wgu_t, DM, DM, DM}; pg8::StaticOrder S; S.init(M, 2 * D_FF, G, bx);
        pg8::EpiSwiGLU E{HID, D_FF, (const float*)(ws + WS_RH)};
        pg8::gemm_phase<pg8::EpiSwiGLU, pg8::StaticOrder, true>(lds, g, S, E);
    }
    TEAM_BAR();

    {
        PHASE_IDS();
        pg8::Gemm g{HID, Wd_t, D_FF, D_FF, D_FF}; pg8::StaticOrder S; S.init(M, DM, G, bx);
        pg8::EpiBf16P E{MIX, DM};
        pg8::gemm_phase<pg8::EpiBf16P, pg8::StaticOrder, true>(lds, g, S, E);
    }
    TEAM_BAR();

    {
        PHASE_IDS();
        f32x4 gq[8];
#pragma unroll
        for (int j = 0; j < 4; ++j) { gq[2 * j] = ((const f32x4*)a.g_post_ffn)[128 * j + 2 * lane]; gq[2 * j + 1] = ((const f32x4*)a.g_post_ffn)[128 * j + 2 * lane + 1]; }
        for (int it = 0; it < 4; ++it) { const int mb = team_pm * 256 + team_k * 64 + wave * 8 + it * 2;
            v4u fv[2][4], hv[2][4]; float sf[2], rhi[2];
#pragma unroll
            for (int q = 0; q < 2; ++q) { const v4u* fr = (const v4u*)(MIX + (size_t)(mb + q) * DM); const v4u* hr = (const v4u*)(R1 + (size_t)(mb + q) * DM); rhi[q] = ((const float*)(ws + WS_RH))[mb + q];
#pragma unroll
                for (int j = 0; j < 4; ++j) { fv[q][j] = fr[64 * j + lane]; hv[q][j] = hr[64 * j + lane]; } }
#pragma unroll
            for (int q = 0; q < 2; ++q) { float t = 0.f;
#pragma unroll
                for (int j = 0; j < 4; ++j)
#pragma unroll
                    for (int e = 0; e < 4; ++e) { const float f0 = bf_lo(fv[q][j][e]), f1 = bf_hi(fv[q][j][e]); t += f0 * f0 + f1 * f1; }
                sf[q] = t; }
#pragma unroll
            for (int q = 0; q < 2; ++q) {
                const float rf = 1.0f / sqrtf(wave_sum(sf[q]) * (1.0f / DM) + RMS_EPS), rx = rhi[q]; f32x4* ho = (f32x4*)(a.out + (size_t)(mb + q) * DM);
#pragma unroll
                for (int j = 0; j < 4; ++j) {
                    const f32x4 g0 = gq[2 * j], g1 = gq[2 * j + 1]; const v4u fj = fv[q][j], hj = hv[q][j]; f32x4 h0, h1;
                    h0.x = bf_lo(hj.x) * rx + bf_lo(fj.x) * rf * g0.x; h0.y = bf_hi(hj.x) * rx + bf_hi(fj.x) * rf * g0.y; h0.z = bf_lo(hj.y) * rx + bf_lo(fj.y) * rf * g0.z; h0.w = bf_hi(hj.y) * rx + bf_hi(fj.y) * rf * g0.w;
                    h1.x = bf_lo(hj.z) * rx + bf_lo(fj.z) * rf * g1.x; h1.y = bf_hi(hj.z) * rx + bf_hi(fj.z) * rf * g1.y; h1.z = bf_lo(hj.w) * rx + bf_lo(fj.w) * rf * g1.z; h1.w = bf_hi(hj.w) * rx + bf_hi(fj.w) * rf * g1.w;
                    ho[128 * j + 2 * lane] = h0; ho[128 * j + 2 * lane + 1] = h1;
                }
            }
        }
    }
}

extern "C" void kernel_launch(void* const* d_in, const int* in_sizes, int n_in, void* d_out, int out_size, void* d_ws, size_t ws_size, hipStream_t stream) {
    static int grid = 0;
    if (grid == 0) {
        if (n_in != 24 || in_sizes[0] != M * DM || out_size != M * DM || ws_size < WS_END) { fprintf(stderr, "kernel_launch: unexpected shapes (n_in %d, in0 %d, out %d, ws %zu)\n", n_in, n_in > 0 ? in_sizes[0] : -1, out_size, ws_size); grid = -1; return; }
        int dev = 0, cus = 0;
        if (hipGetDevice(&dev) != hipSuccess || hipDeviceGetAttribute(&cus, hipDeviceAttributeMultiprocessorCount, dev) != hipSuccess) { grid = -1; return; }
        if (hipFuncSetAttribute((const void*)hymba_fwd, hipFuncAttributeMaxDynamicSharedMemorySize, LDS_BYTES) != hipSuccess) { fprintf(stderr, "kernel_launch: hipFuncSetAttribute failed\n"); grid = -1; return; }
        int per_cu = 0;
        (void)hipOccupancyMaxActiveBlocksPerMultiprocessor(&per_cu, (const void*)hymba_fwd, NWAVES * 64, LDS_BYTES);
        (void)hipGetLastError();
        grid = cus;
        if (grid != 256) { fprintf(stderr, "kernel_launch: built for a 256-CU device (team structure, SSM unit map); found %d CUs\n", cus); grid = -1; return; }
    }
    if (grid < 0) return;
    (void)hipMemsetAsync((char*)d_ws + WS_CTL, 0, CTL_ZERO_BYTES, stream);
    Args a{};
    a.x = (const float*)d_in[0]; a.pos = (const int*)d_in[1]; a.g_pre_mix = (const float*)d_in[2]; a.w_in = (const float*)d_in[3]; a.sinks = (const float*)d_in[4];
    a.a_re = (const float*)d_in[5]; a.a_im = (const float*)d_in[6]; a.log_dt = (const float*)d_in[7]; a.b_re = (const float*)d_in[8]; a.b_im = (const float*)d_in[9];
    a.c_re = (const float*)d_in[10]; a.c_im = (const float*)d_in[11]; a.d_skip = (const float*)d_in[12]; a.w_glu = (const float*)d_in[13]; a.b_glu = (const float*)d_in[14];
    a.g_attn_out = (const float*)d_in[15]; a.g_ssm_out = (const float*)d_in[16]; a.w_o = (const float*)d_in[17]; a.g_post_mix = (const float*)d_in[18]; a.g_pre_ffn = (const float*)d_in[19];
    a.w_gate = (const float*)d_in[20]; a.w_up = (const float*)d_in[21]; a.w_down = (const float*)d_in[22]; a.g_post_ffn = (const float*)d_in[23];
    a.out = (float*)d_out; a.ws = (unsigned char*)d_ws;
    hipLaunchKernelGGL(hymba_fwd, dim3(grid), dim3(NWAVES * 64), LDS_BYTES, stream, a);
}
```

```cpp
#include <hip/hip_runtime.h>
#include <cstdio>
#include <cstdint>

namespace pg8 {
#define PG8_LAS __attribute__((address_space(3)))
typedef unsigned short bf16_t;
typedef short bf16x8 __attribute__((ext_vector_type(8)));
typedef float f32x4 __attribute__((ext_vector_type(4)));
typedef unsigned u32x4 __attribute__((ext_vector_type(4)));
constexpr int BM = 256, BK = 64, HALF = 128, HTB = HALF * BK * 2, STAGE_BYTES = 8 * HTB, NXCD = 8, WGM = 8;

__host__ __device__ __forceinline__ int lds_byte(int r, int c) { const int st = (r >> 4) * 2 + (c >> 5), rr = r & 15, cc = c & 31, ob = rr * 64 + cc * 2; return st * 1024 + (ob ^ (((ob >> 9) & 1) << 5)); }
__host__ __device__ __forceinline__ void stage_rc(int b, int& R, int& C) { const int st = b / 1024, sb = b % 1024, swz = sb ^ (((sb >> 9) & 1) << 5); R = (st >> 1) * 16 + swz / 64; C = (st & 1) * 32 + (swz % 64) / 2; }
__host__ __device__ __forceinline__ int perm32(int rho) { const int n = rho >> 4, i = rho & 15; return 8 * (i >> 2) + 4 * n + (i & 3); }

struct Unit { int pm, pn; };
struct Gemm { const bf16_t* A; const bf16_t* Bt; int lda, ldb, K; int ablk; };

struct StaticOrder {
    int nM, nN, nwg, G, c;
    __host__ __device__ void init(int M, int N, int G_, int c_) { nM = M / BM; nN = N / BM; nwg = nM * nN; G = G_; c = c_; }
    __host__ __device__ bool next(int i, Unit& u) const {
        const long L = (long)i * G + c; if (L >= nwg) return false;
        int wgid = (int)L; { const int q = nwg / NXCD, r = nwg % NXCD, xcd = wgid % NXCD, off = wgid / NXCD; wgid = (xcd < r ? xcd * (q + 1) : r * (q + 1) + (xcd - r) * q) + off; }
        const int nig = WGM * nN, gid = wgid / nig, fm = gid * WGM, gsz = (nM - fm) < WGM ? (nM - fm) : WGM;
        u.pm = fm + ((wgid % nig) % gsz); u.pn = (wgid % nig) / gsz; return true;
    }
};
struct DiagOrder {
    int G, c, n;
    __host__ __device__ bool next(int i, Unit& u) const { const int L = i * G + c; if (L >= n) return false; u.pm = L; u.pn = L >> 2; return true; }
};

__device__ __forceinline__ unsigned cvt_pk_bf16(float lo, float hi) { unsigned r; asm volatile("v_cvt_pk_bf16_f32 %0, %1, %2" : "=v"(r) : "v"(lo), "v"(hi)); return r; }
__device__ __forceinline__ float bf_lo(unsigned w) { return __uint_as_float(w << 16); }
__device__ __forceinline__ float bf_hi(unsigned w) { return __uint_as_float(w & 0xffff0000u); }
__device__ __forceinline__ float sigmoidf_(float x) { return __builtin_amdgcn_rcpf(1.0f + __builtin_amdgcn_exp2f(-1.4426950408889634f * x)); }
__device__ __forceinline__ float gelu_tanh(float x) { const float u = 1.5957691216057308f * (x + 0.044715f * x * x * x); return x * sigmoidf_(u); }

constexpr float ATT_C2 = 0.125f * 1.4426950408889634f;

struct EpiBf16P {
    static constexpr bool PERM = true, MIDK = false;
    bf16_t* O; int ldc;
    __device__ __forceinline__ void operator()(const f32x4 (&acc)[2][2][4][2], const Unit& u, int wr, int wc, int fr, int fq) const {
        const int row0 = u.pm * BM + wr * 64 + fr, col0 = u.pn * BM + wc * 32 + 8 * fq;
#pragma unroll
        for (int ai = 0; ai < 2; ++ai)
#pragma unroll
            for (int m = 0; m < 4; ++m) { bf16_t* rowp = O + (size_t)(row0 + ai * HALF + m * 16) * ldc + col0;
#pragma unroll
                for (int bj = 0; bj < 2; ++bj) { const f32x4 v0 = acc[ai][bj][m][0], v1 = acc[ai][bj][m][1];
                    u32x4 w; w.x = cvt_pk_bf16(v0[0], v0[1]); w.y = cvt_pk_bf16(v0[2], v0[3]); w.z = cvt_pk_bf16(v1[0], v1[1]); w.w = cvt_pk_bf16(v1[2], v1[3]);
                    *(u32x4*)(rowp + bj * HALF) = w; } }
    }
};
struct EpiMix {
    static constexpr bool PERM = true, MIDK = true;
    bf16_t* O; int ldc; const PG8_LAS float* ratio; const PG8_LAS float* rsl;
    __device__ __forceinline__ void midk(f32x4 (&acc)[2][2][4][2], const Unit& u, int wr, int fr) const {
#pragma unroll
        for (int ai = 0; ai < 2; ++ai)
#pragma unroll
            for (int m = 0; m < 4; ++m) { const float rt = ratio[wr * 64 + fr + ai * HALF + m * 16];
#pragma unroll
                for (int bj = 0; bj < 2; ++bj)
#pragma unroll
                    for (int n = 0; n < 2; ++n) acc[ai][bj][m][n] *= rt; }
    }
    __device__ __forceinline__ void operator()(const f32x4 (&acc)[2][2][4][2], const Unit& u, int wr, int wc, int fr, int fq) const {
        const int row0 = u.pm * BM + wr * 64 + fr, col0 = u.pn * BM + wc * 32 + 8 * fq;
#pragma unroll
        for (int ai = 0; ai < 2; ++ai)
#pragma unroll
            for (int m = 0; m < 4; ++m) { const int row = row0 + ai * HALF + m * 16; bf16_t* rowp = O + (size_t)row * ldc + col0;
                const float rs = rsl[wr * 64 + fr + ai * HALF + m * 16];
#pragma unroll
                for (int bj = 0; bj < 2; ++bj) { const f32x4 v0 = acc[ai][bj][m][0] * rs, v1 = acc[ai][bj][m][1] * rs;
                    u32x4 w; w.x = cvt_pk_bf16(v0[0], v0[1]); w.y = cvt_pk_bf16(v0[2], v0[3]); w.z = cvt_pk_bf16(v1[0], v1[1]); w.w = cvt_pk_bf16(v1[2], v1[3]);
                    *(u32x4*)(rowp + bj * HALF) = w; } }
    }
};
struct EpiQKU {
    static constexpr bool PERM = true, MIDK = false;
    bf16_t* Q; bf16_t* Kp; bf16_t* A2; const PG8_LAS int* posl;
    __device__ __forceinline__ void operator()(const f32x4 (&acc)[2][2][4][2], const Unit& u, int wr, int wc, int fr, int fq) const {
        const int row0 = u.pm * BM + wr * 64 + fr, cw = wc * 32 + 8 * fq;
        if (u.pn < 5) {
            const bool isq = u.pn < 4; const float sc = isq ? ATT_C2 : 1.0f;
            const int i0 = (cw & 63) >> 1;
            float invf[4];
#pragma unroll
            for (int t = 0; t < 4; ++t) invf[t] = __builtin_amdgcn_exp2f(-(float)(i0 + t) * (13.287712379549449f / 32.0f));
            bf16_t* base = isq ? (Q + u.pn * 256) : Kp; const int ld = isq ? 1024 : 256;
#pragma unroll
            for (int ai = 0; ai < 2; ++ai)
#pragma unroll
                for (int m = 0; m < 4; ++m) { const int row = row0 + ai * HALF + m * 16; const float p = (float)posl[wr * 64 + fr + ai * HALF + m * 16];
                    float cs[4], sn[4];
#pragma unroll
                    for (int t = 0; t < 4; ++t) { const float ang = p * invf[t]; const float fr_ = __builtin_amdgcn_fractf(ang * 0.15915494309189535f); sn[t] = __builtin_amdgcn_sinf(fr_) * sc; cs[t] = __builtin_amdgcn_cosf(fr_) * sc; }
#pragma unroll
                    for (int bj = 0; bj < 2; ++bj) { const f32x4 v0 = acc[ai][bj][m][0], v1 = acc[ai][bj][m][1];
                        u32x4 w;
                        w.x = cvt_pk_bf16(v0[0] * cs[0] - v0[1] * sn[0], v0[1] * cs[0] + v0[0] * sn[0]);
                        w.y = cvt_pk_bf16(v0[2] * cs[1] - v0[3] * sn[1], v0[3] * cs[1] + v0[2] * sn[1]);
                        w.z = cvt_pk_bf16(v1[0] * cs[2] - v1[1] * sn[2], v1[1] * cs[2] + v1[0] * sn[2]);
                        w.w = cvt_pk_bf16(v1[2] * cs[3] - v1[3] * sn[3], v1[3] * cs[3] + v1[2] * sn[3]);
                        *(u32x4*)(base + (size_t)row * ld + bj * HALF + cw) = w; } }
        } else {
#pragma unroll
            for (int ai = 0; ai < 2; ++ai)
#pragma unroll
                for (int m = 0; m < 4; ++m) { const int row = row0 + ai * HALF + m * 16;
#pragma unroll
                    for (int bj = 0; bj < 2; ++bj) { const f32x4 v0 = acc[ai][bj][m][0], v1 = acc[ai][bj][m][1];
                        const int gcol = (u.pn - 5) * 256 + bj * HALF + cw, g = gcol >> 4, q0 = gcol & 15;
                        u32x4 w; w.x = cvt_pk_bf16(v0[0], v0[1]); w.y = cvt_pk_bf16(v0[2], v0[3]); w.z = cvt_pk_bf16(v1[0], v1[1]); w.w = cvt_pk_bf16(v1[2], v1[3]);
                        *(u32x4*)(A2 + (size_t)g * (1024 * 384) + (size_t)(row >> 4) * 384 + (row & 15) * 16 + q0) = w; } }
        }
    }
};
struct EpiZ {
    static constexpr bool PERM = false, MIDK = false;
    float* Z;
    __device__ __forceinline__ void operator()(const f32x4 (&acc)[2][2][4][2], const Unit& u, int wr, int wc, int fr, int fq) const {
        const int row0 = u.pm * BM + wr * 64 + fr, col0 = wc * 32 + 4 * fq;
#pragma unroll
        for (int ai = 0; ai < 2; ++ai)
#pragma unroll
            for (int m = 0; m < 4; ++m) { float* rowp = Z + (size_t)(row0 + ai * HALF + m * 16) * 128 + col0;
#pragma unroll
                for (int n = 0; n < 2; ++n) *(f32x4*)(rowp + n * 16) = acc[ai][0][m][n]; }
    }
};
struct EpiY {
    static constexpr bool PERM = true, MIDK = false;
    bf16_t* Zb;
    __device__ __forceinline__ void operator()(const f32x4 (&acc)[2][2][4][2], const Unit& u, int wr, int wc, int fr, int fq) const {
        const int row0 = u.pm * BM + wr * 64 + fr, g = u.pn;
#pragma unroll
        for (int ai = 0; ai < 2; ++ai)
#pragma unroll
            for (int m = 0; m < 4; ++m) { const int bc = (row0 + ai * HALF + m * 16) & 1023;
#pragma unroll
                for (int bj = 0; bj < 2; ++bj) { const f32x4 v0 = acc[ai][bj][m][0], v1 = acc[ai][bj][m][1];
                    const int j = 8 * bj + 2 * wc + (fq >> 1), p0 = 8 * (fq & 1);
                    u32x4 w; w.x = cvt_pk_bf16(gelu_tanh(v0[0]), gelu_tanh(v0[1])); w.y = cvt_pk_bf16(gelu_tanh(v0[2]), gelu_tanh(v0[3]));
                    w.z = cvt_pk_bf16(gelu_tanh(v1[0]), gelu_tanh(v1[1])); w.w = cvt_pk_bf16(gelu_tanh(v1[2]), gelu_tanh(v1[3]));
                    *(u32x4*)(Zb + (size_t)g * (16384 * 16) + (size_t)(bc * 16 + j) * 16 + p0) = w; asm volatile("" ::: "memory"); } }
    }
};
struct EpiGlu {
    static constexpr bool PERM = true, MIDK = false;
    const bf16_t* Zb; const float* bias; bf16_t* O; int ldo; float* st;
    __device__ __forceinline__ void operator()(const f32x4 (&acc)[2][2][4][2], const Unit& u, int wr, int wc, int fr, int fq) const {
        const int row0 = u.pm * BM + wr * 64 + fr, col0 = u.pn * BM + wc * 32 + 8 * fq;
        float part[2][4];
#pragma unroll
        for (int ai = 0; ai < 2; ++ai)
#pragma unroll
            for (int m = 0; m < 4; ++m) part[ai][m] = 0.f;
#pragma unroll
        for (int bj = 0; bj < 2; ++bj) { const f32x4 b0 = *(const f32x4*)(bias + col0 + bj * HALF), b1 = *(const f32x4*)(bias + col0 + bj * HALF + 4);
#pragma unroll
            for (int ai = 0; ai < 2; ++ai)
#pragma unroll
                for (int m = 0; m < 4; ++m) { const int row = row0 + ai * HALF + m * 16;
                    const int zc = col0 + bj * HALF; const u32x4 zi = *(const u32x4*)(Zb + (size_t)(zc >> 4) * (16384 * 16) + (size_t)row * 16 + (zc & 15)); const f32x4 v0 = acc[ai][bj][m][0] + b0, v1 = acc[ai][bj][m][1] + b1;
                    float e[8];
                    e[0] = bf_lo(zi.x) * sigmoidf_(v0[0]); e[1] = bf_hi(zi.x) * sigmoidf_(v0[1]); e[2] = bf_lo(zi.y) * sigmoidf_(v0[2]); e[3] = bf_hi(zi.y) * sigmoidf_(v0[3]);
                    e[4] = bf_lo(zi.z) * sigmoidf_(v1[0]); e[5] = bf_hi(zi.z) * sigmoidf_(v1[1]); e[6] = bf_lo(zi.w) * sigmoidf_(v1[2]); e[7] = bf_hi(zi.w) * sigmoidf_(v1[3]);
                    part[ai][m] += (e[0] * e[0] + e[1] * e[1]) + (e[2] * e[2] + e[3] * e[3]) + (e[4] * e[4] + e[5] * e[5]) + (e[6] * e[6] + e[7] * e[7]);
                    u32x4 w; w.x = cvt_pk_bf16(e[0], e[1]); w.y = cvt_pk_bf16(e[2], e[3]); w.z = cvt_pk_bf16(e[4], e[5]); w.w = cvt_pk_bf16(e[6], e[7]);
                    *(u32x4*)(O + (size_t)row * ldo + col0 + bj * HALF) = w; } }
#pragma unroll
        for (int ai = 0; ai < 2; ++ai)
#pragma unroll
            for (int m = 0; m < 4; ++m) { float p = part[ai][m]; p += __shfl_xor(p, 16); p += __shfl_xor(p, 32);
                if (fq == 0) (void)__hip_atomic_fetch_add(st + row0 + ai * HALF + m * 16, p, __ATOMIC_RELAXED, __HIP_MEMORY_SCOPE_AGENT); }
    }
};
struct EpiSwiGLU {
    static constexpr bool PERM = true, MIDK = false;
    bf16_t* O; int ldc; const float* rs;
    __device__ __forceinline__ void operator()(const f32x4 (&acc)[2][2][4][2], const Unit& u, int wr, int wc, int fr, int fq) const {
        const int row0 = u.pm * BM + wr * 64 + fr, col0 = u.pn * HALF + wc * 32 + 8 * fq;
#pragma unroll
        for (int ai = 0; ai < 2; ++ai)
#pragma unroll
            for (int m = 0; m < 4; ++m) {
                const f32x4 g0 = acc[ai][0][m][0], g1 = acc[ai][0][m][1], u0 = acc[ai][1][m][0], u1 = acc[ai][1][m][1];
                u32x4 w;
                w.x = cvt_pk_bf16(g0[0] * sigmoidf_(g0[0]) * u0[0], g0[1] * sigmoidf_(g0[1]) * u0[1]); w.y = cvt_pk_bf16(g0[2] * sigmoidf_(g0[2]) * u0[2], g0[3] * sigmoidf_(g0[3]) * u0[3]);
                w.z = cvt_pk_bf16(g1[0] * sigmoidf_(g1[0]) * u1[0], g1[1] * sigmoidf_(g1[1]) * u1[1]); w.w = cvt_pk_bf16(g1[2] * sigmoidf_(g1[2]) * u1[2], g1[3] * sigmoidf_(g1[3]) * u1[3]);
                *(u32x4*)(O + (size_t)(row0 + ai * HALF + m * 16) * ldc + col0) = w; }
    }
};

template <class Epi, class Sched, bool ALIGN_EPI>
__device__ __forceinline__ void gemm_phase(PG8_LAS unsigned char* lds, const Gemm g, const Sched& S, const Epi& E) {
    int tid_ = threadIdx.x; asm volatile("" : "+v"(tid_));
    const int tid = tid_, wid = __builtin_amdgcn_readfirstlane(tid >> 6), lane = tid & 63, wr = wid >> 2, wc = wid & 3, fr = lane & 15, fq = lane >> 4;
    const int nt = g.K / BK;
    unsigned voffA[2], voffB[2];
#pragma unroll
    for (int i = 0; i < 2; ++i) { int R, C; stage_rc(tid * 16 + i * 8192, R, C); const int Rb = Epi::PERM ? ((R & ~31) + perm32(R & 31)) : R;
        voffA[i] = g.ablk ? (unsigned)((C >> 4) * g.ablk + R * 16 + (C & 15)) * 2u : (unsigned)(R * g.lda + C) * 2u; voffB[i] = (unsigned)(Rb * g.ldb + C) * 2u; }
    const size_t kstep = (size_t)(BK * 2), kstepA = g.ablk ? (size_t)4 * g.ablk * 2 : kstep;
    const size_t hstepA = g.ablk ? (size_t)HALF * 16 * 2 : (size_t)HALF * g.lda * 2, hstepB = (size_t)HALF * g.ldb * 2;
    const size_t tstepA = 2 * hstepA, tstepB = 2 * hstepB;
    const unsigned ldsw = (unsigned)wid * 1024u;
    const size_t tailoff = (size_t)(nt - 2) * (size_t)(BK * 2), tailoffA = (size_t)(nt - 2) * kstepA;
    const int aoff = lds_byte(wr * 64 + fr, fq * 8), boff = lds_byte(wc * 32 + fr, fq * 8);
#define PG8_SA(b, h) (((b) * 2 + (h)) * HTB)
#define PG8_SB(b, h) ((4 + (b) * 2 + (h)) * HTB)
#define PG8_STAGE(bufoff, gbase, voff) do { _Pragma("unroll") for (int _i = 0; _i < 2; ++_i) \
        __builtin_amdgcn_global_load_lds((const unsigned*)((const char*)(gbase) + (voff)[_i]), (PG8_LAS unsigned*)(lds + (bufoff) + ldsw + _i * 8192), 16, 0, 0); } while (0)
#define PG8_LDA(dst, b, h) do { _Pragma("unroll") for (int m = 0; m < 4; ++m) _Pragma("unroll") for (int k = 0; k < 2; ++k) dst[m][k] = *(const PG8_LAS bf16x8*)(lds + PG8_SA(b, h) + aoff + m * 2048 + k * 1024); } while (0)
#define PG8_LDB(dst, b, h) do { _Pragma("unroll") for (int n = 0; n < 2; ++n) _Pragma("unroll") for (int k = 0; k < 2; ++k) dst[n][k] = *(const PG8_LAS bf16x8*)(lds + PG8_SB(b, h) + boff + n * 2048 + k * 1024); } while (0)
#define PG8_MMA(ai, bj, At, Bt) do { __builtin_amdgcn_s_setprio(1); _Pragma("unroll") for (int m = 0; m < 4; ++m) _Pragma("unroll") for (int n = 0; n < 2; ++n) _Pragma("unroll") for (int k = 0; k < 2; ++k) \
        acc[ai][bj][m][n] = __builtin_amdgcn_mfma_f32_16x16x32_bf16(Bt[n][k], At[m][k], acc[ai][bj][m][n], 0, 0, 0); __builtin_amdgcn_s_setprio(0); } while (0)
#define PG8_WAIT_V(n) asm volatile("s_waitcnt vmcnt(" #n ")" ::: "memory")
#define PG8_WAIT_L(n) asm volatile("s_waitcnt lgkmcnt(" #n ")" ::: "memory")
#define PG8_BAR __builtin_amdgcn_s_barrier()
#define PG8_SCHED __builtin_amdgcn_sched_barrier(0)
    Unit cur, nxt; int ui = 0;
    if (!S.next(0, cur)) return;
    f32x4 acc[2][2][4][2];
#pragma unroll
    for (int a = 0; a < 2; ++a)
#pragma unroll
        for (int b = 0; b < 2; ++b)
#pragma unroll
            for (int m = 0; m < 4; ++m)
#pragma unroll
                for (int n = 0; n < 2; ++n) acc[a][b][m][n] = (f32x4){0.f, 0.f, 0.f, 0.f};
    bf16x8 At[4][2], B0[2][2], B1[2][2];
    const char* cA = (const char*)g.A + (size_t)cur.pm * tstepA; const char* cB = (const char*)g.Bt + (size_t)cur.pn * tstepB;
    PG8_STAGE(PG8_SB(0, 0), cB, voffB); PG8_STAGE(PG8_SB(0, 1), cB + hstepB, voffB); PG8_STAGE(PG8_SA(0, 0), cA, voffA); PG8_STAGE(PG8_SA(0, 1), cA + hstepA, voffA);
    if (wr == 1) PG8_BAR;
    PG8_WAIT_V(2); PG8_BAR;
    PG8_STAGE(PG8_SB(1, 0), cB + kstep, voffB); PG8_STAGE(PG8_SA(1, 0), cA + kstepA, voffA); PG8_STAGE(PG8_SB(1, 1), cB + hstepB + kstep, voffB);
    PG8_WAIT_V(6); PG8_BAR;
    for (;;) {
        const bool has_next = S.next(ui + 1, nxt);
        const size_t tail_ = has_next ? 0 : tailoff; const char* nA = (has_next ? (const char*)g.A + (size_t)nxt.pm * tstepA : cA) + (has_next ? 0 : tailoffA); const char* nB = (has_next ? (const char*)g.Bt + (size_t)nxt.pn * tstepB : cB) + tail_;
        for (int t = 0; t < nt; t += 2) {
            if constexpr (Epi::MIDK) { if (t == (nt >> 1)) E.midk(acc, cur, wr, fr); }
            const bool last = (t == nt - 2);
            const char* a1 = cA + (size_t)(t + 1) * kstepA;
            const char* a2 = last ? nA : cA + (size_t)(t + 2) * kstepA; const char* b2 = last ? nB : cB + (size_t)(t + 2) * kstep;
            const char* a3 = a2 + kstepA; const char* b3 = b2 + kstep;
            PG8_LDB(B0, 0, 0); PG8_LDB(B1, 0, 1); PG8_SCHED; PG8_LDA(At, 0, 0); PG8_STAGE(PG8_SA(1, 1), a1 + hstepA, voffA);
            PG8_WAIT_V(8); PG8_WAIT_L(0); PG8_BAR; PG8_MMA(0, 0, At, B0); PG8_MMA(0, 1, At, B1); PG8_BAR; PG8_SCHED;
            PG8_LDA(At, 0, 1); PG8_STAGE(PG8_SB(0, 0), b2, voffB); PG8_STAGE(PG8_SB(0, 1), b2 + hstepB, voffB); PG8_STAGE(PG8_SA(0, 0), a2, voffA);
            PG8_WAIT_V(8); PG8_WAIT_L(0); PG8_BAR; PG8_MMA(1, 0, At, B0); PG8_MMA(1, 1, At, B1); PG8_BAR; PG8_SCHED;
            PG8_LDB(B0, 1, 0); PG8_LDB(B1, 1, 1); PG8_SCHED; PG8_LDA(At, 1, 0); PG8_STAGE(PG8_SA(0, 1), a2 + hstepA, voffA);
            PG8_WAIT_V(8); PG8_WAIT_L(0); PG8_BAR; PG8_MMA(0, 0, At, B0); PG8_MMA(0, 1, At, B1); PG8_BAR; PG8_SCHED;
            PG8_LDA(At, 1, 1); PG8_STAGE(PG8_SB(1, 0), b3, voffB); PG8_STAGE(PG8_SB(1, 1), b3 + hstepB, voffB); PG8_STAGE(PG8_SA(1, 0), a3, voffA);
            PG8_WAIT_V(8); PG8_WAIT_L(0); PG8_BAR; PG8_MMA(1, 0, At, B0); PG8_MMA(1, 1, At, B1); PG8_BAR; PG8_SCHED;
        }
        if constexpr (ALIGN_EPI) { if (wr == 0) PG8_BAR; }
        E(acc, cur, wr, wc, fr, fq);
        if (!has_next) break;
#pragma unroll
        for (int a = 0; a < 2; ++a)
#pragma unroll
            for (int b = 0; b < 2; ++b)
#pragma unroll
                for (int m = 0; m < 4; ++m)
#pragma unroll
                    for (int n = 0; n < 2; ++n) acc[a][b][m][n] = (f32x4){0.f, 0.f, 0.f, 0.f};
        cur = nxt; cA = nA; cB = nB; ++ui;
        if constexpr (ALIGN_EPI) { if (wr == 1) PG8_BAR; }
    }
    PG8_WAIT_V(0);
    if constexpr (!ALIGN_EPI) { if (wr == 0) PG8_BAR; }
    PG8_BAR;
#undef PG8_SA
#undef PG8_SB
#undef PG8_STAGE
#undef PG8_LDA
#undef PG8_LDB
#undef PG8_MMA
#undef PG8_WAIT_V
#undef PG8_WAIT_L
#undef PG8_BAR
#undef PG8_SCHED
}
}

constexpr int NWAVES = 8;
constexpr int BATCH = 8, SEQ = 2048, DM = 2048, M = BATCH * SEQ;
constexpr int D_ATTN = 1024, D_KV = 256, D_SSM = 1024, D_IN = 2560, D_FF = 5632, NQH = 16, NKVH = 4, HD = 64;
constexpr int NG = 64, NST = 64, PCH = 16, CH = 16, NCH = SEQ / CH;
constexpr int A2LD = 384;
constexpr float RMS_EPS = 1e-6f;

constexpr size_t MiB = 1u << 20;
constexpr size_t WS_CTL = 0, CTL_ZERO_BYTES = 1 * MiB;
constexpr size_t WS_WIN = 2 * MiB, WS_WGLU = 12 * MiB, WS_WO = 14 * MiB, WS_WGU = 22 * MiB, WS_WD = 66 * MiB;
constexpr size_t WS_TC = 88 * MiB, WS_BZ = 100 * MiB, WS_LAM = 108 * MiB, WS_RH = 109 * MiB, WS_RX = 110 * MiB;
constexpr size_t WS_R1 = 112 * MiB;
constexpr size_t WS_R2 = 176 * MiB;
constexpr size_t WS_Q = WS_R2, WS_K = WS_R2 + 32 * MiB, WS_VT = WS_R2 + 40 * MiB;
constexpr size_t WS_A3 = 240 * MiB, WS_Z = 304 * MiB;
constexpr size_t WS_A2 = 336 * MiB;
constexpr size_t WS_ZS = 384 * MiB;
constexpr size_t WS_HID = 336 * MiB;
constexpr size_t WS_END = 512 * MiB;
constexpr int CW_BAR = 4096, CW_TEAM = 16384, CW_STAT_A = 65536, CW_STAT_S = 81920;

constexpr int RING_BYTES = 131072, LDSCTL_OFF = RING_BYTES, MISC_OFF = LDSCTL_OFF + 320, LDS_BYTES = 147456;

#define GAS __attribute__((address_space(1)))
#define LAS __attribute__((address_space(3)))
typedef unsigned short bf16;
typedef unsigned v4u __attribute__((ext_vector_type(4)));
typedef unsigned v2u __attribute__((ext_vector_type(2)));
typedef float f32x4 __attribute__((ext_vector_type(4)));
typedef float f32x16 __attribute__((ext_vector_type(16)));
typedef short bf16x8 __attribute__((ext_vector_type(8)));
#define LDS_WAIT() asm volatile("s_waitcnt lgkmcnt(0)" ::: "memory")
using pg8::cvt_pk_bf16; using pg8::bf_lo; using pg8::bf_hi;

#define XB_TMO      128
#define XB_XCNT(j)  (256  + 64 * (j))
#define XB_XSUB(j)  (1280 + 64 * (j))
#define XB_XGEN(j)  (2304 + 64 * (j))
#define XB_TOP      3328
#define XB_TOPGEN   3392
#define XCD_BAR_WORDS 3456
#define XB_SPIN_CAP (1u << 18)
__device__ __forceinline__ unsigned xb_ld(unsigned* p)              { return __hip_atomic_load(p, __ATOMIC_RELAXED, __HIP_MEMORY_SCOPE_AGENT); }
__device__ __forceinline__ unsigned xb_add(unsigned* p, unsigned v) { return __hip_atomic_fetch_add(p, v, __ATOMIC_RELAXED, __HIP_MEMORY_SCOPE_AGENT); }
__device__ __forceinline__ unsigned xb_xcc_id() { return (unsigned)__builtin_amdgcn_s_getreg((3 << 11) | 20) & 0xFu; }
#define XB_SPIN(cond, bar) do { unsigned _sp = 0; while (cond) { __builtin_amdgcn_s_sleep(1); \
    if ((++_sp & 255u) == 0u) { if (xb_ld(&(bar)[XB_TMO])) break; if (_sp > XB_SPIN_CAP) { atomicAdd(&(bar)[XB_TMO], 1u); break; } } } } while (0)
struct XcdBarrier { unsigned* bar; unsigned x; volatile LAS unsigned* st; };
__device__ __forceinline__ XcdBarrier xcd_barrier_post(unsigned* bar, volatile LAS unsigned* st) {
    XcdBarrier b; b.bar = bar; b.x = xb_xcc_id(); b.st = st;
    if (threadIdx.x == 0) (void)xb_add(&bar[XB_XCNT(b.x)], 1u);
    return b;
}
__device__ __forceinline__ void xcd_barrier_complete(unsigned* bar, unsigned x, unsigned& nloc, unsigned& nx) {
    const unsigned G = gridDim.x * gridDim.y * gridDim.z;
    unsigned sum, cnt, mine, sp = 0u;
    for (;;) {
        sum = 0u; cnt = 0u; mine = 0u;
#pragma unroll
        for (unsigned j = 0; j < 16; ++j) { const unsigned c = xb_ld(&bar[XB_XCNT(j)]); sum += c; cnt += (c > 0u) ? 1u : 0u; mine = (j == x) ? c : mine; }
        if (sum == G) break;
        __builtin_amdgcn_s_sleep(1);
        if ((++sp & 255u) == 0u) { if (xb_ld(&bar[XB_TMO])) break; if (sp > XB_SPIN_CAP) { atomicAdd(&bar[XB_TMO], 1u); break; } }
    }
    nloc = mine > 0u ? mine : 1u; nx = cnt > 0u ? cnt : 1u;
}
__device__ __forceinline__ void xcd_barrier(const XcdBarrier& b) {
    asm volatile("s_waitcnt vmcnt(0)" ::: "memory");
    __syncthreads();
    if (threadIdx.x == 0) {
        unsigned* bar = b.bar;
        __builtin_amdgcn_s_waitcnt(0);
        unsigned nloc = b.st[0], nx = b.st[1];
        if (nloc == 0u) { xcd_barrier_complete(bar, b.x, nloc, nx); b.st[0] = nloc; b.st[1] = nx; }
        const unsigned old = xb_add(&bar[XB_XSUB(b.x)], 1u);
        const unsigned gen = old / nloc;
        if (old + 1u == (gen + 1u) * nloc) {
            __builtin_amdgcn_fence(__ATOMIC_RELEASE, "agent");
            asm volatile("s_waitcnt vmcnt(0)" ::: "memory");
            const unsigned og = xb_add(&bar[XB_TOP], 1u);
            const unsigned tg = og / nx;
            if (og + 1u == (tg + 1u) * nx) xb_add(&bar[XB_TOPGEN], 1u);
            else XB_SPIN(xb_ld(&bar[XB_TOPGEN]) == tg, bar);
            __builtin_amdgcn_fence(__ATOMIC_ACQUIRE, "agent");
            xb_add(&bar[XB_XGEN(b.x)], 1u);
            asm volatile("s_waitcnt vmcnt(0)" ::: "memory");
        } else {
            XB_SPIN(xb_ld(&bar[XB_XGEN(b.x)]) == gen, bar);
            __builtin_amdgcn_fence(__ATOMIC_ACQUIRE, "agent");
            asm volatile("s_waitcnt vmcnt(0)" ::: "memory");
        }
    }
    __syncthreads();
}

__device__ __forceinline__ void team_barrier(unsigned* cnt, unsigned* tmo, unsigned& epoch, volatile LAS unsigned* same_xcd) {
    asm volatile("s_waitcnt vmcnt(0)" ::: "memory");
    __syncthreads();
    if (threadIdx.x == 0) {
        if (*same_xcd != 1u) { __builtin_amdgcn_fence(__ATOMIC_RELEASE, "agent"); }
        asm volatile("s_waitcnt vmcnt(0)" ::: "memory");
        (void)xb_add(cnt, 1u);
        const unsigned want = 4u * epoch; unsigned sp = 0u;
        while (xb_ld(cnt) < want) { __builtin_amdgcn_s_sleep(1); if ((++sp & 255u) == 0u) { if (xb_ld(tmo)) break; if (sp > XB_SPIN_CAP) { atomicAdd(tmo, 1u); break; } } }
        __builtin_amdgcn_fence(__ATOMIC_ACQUIRE, "agent");
        asm volatile("s_waitcnt vmcnt(0)" ::: "memory");
    }
    __syncthreads();
    ++epoch;
}

__device__ __forceinline__ float wave_sum(float v) {
#pragma unroll
    for (int o = 1; o < 64; o <<= 1) v += __shfl_xor(v, o);
    return v;
}
__device__ __forceinline__ void sincos_rev(double rev, float& s, float& c) {
    const double fr = rev - __builtin_rint(rev); const float f = (float)fr;
    s = __builtin_amdgcn_sinf(f); c = __builtin_amdgcn_cosf(f);
}
enum { MAP_PLAIN = 0, MAP_WIN = 1, MAP_GATE = 2, MAP_UP = 3 };
template <int MODE> __device__ __forceinline__ int map_row(int n) {
    if (MODE == MAP_WIN) {
        if (n < 1280) { const int d = n & 63; return (n & ~63) + (d < 32 ? 2 * d : 2 * (d - 32) + 1); }
        if (n < 1536) return 2304 + (n - 1280);
        return 1280 + (n - 1536);
    }
    if (MODE == MAP_GATE) return ((n >> 7) << 8) + (n & 127);
    if (MODE == MAP_UP) return ((n >> 7) << 8) + 128 + (n & 127);
    return n;
}
template <int MODE> __device__ __forceinline__ void transpose_item(const float* W, int K, int N, bf16* WT, const float* gs, LAS float* scr, int item, int lane) {
    const int nblk = N / 32, kb = item / nblk, nb = item % nblk, k0 = 64 * kb, n0 = 32 * nb;
    const float* src = W + (size_t)(k0 + (lane >> 5)) * N + n0 + (lane & 31);
    float v[32];
#pragma unroll
    for (int i = 0; i < 32; ++i) v[i] = src[(size_t)(2 * i) * N];
    const int c = lane & 7;
    f32x4 g0 = (f32x4){1.f, 1.f, 1.f, 1.f}, g1 = g0;
    if (gs) { g0 = *(const f32x4*)(gs + k0 + 8 * c); g1 = *(const f32x4*)(gs + k0 + 8 * c + 4); }
    LAS float* sw = scr + (lane >> 5) * 33 + (lane & 31);
#pragma unroll
    for (int i = 0; i < 32; ++i) sw[(2 * i) * 33] = v[i];
    LDS_WAIT(); asm volatile("" ::: "memory");
#pragma unroll
    for (int j = 0; j < 4; ++j) { const int n = (lane >> 3) + 8 * j; const LAS float* s = scr + (8 * c) * 33 + n;
        v4u o; o.x = cvt_pk_bf16(s[0 * 33] * g0.x, s[1 * 33] * g0.y); o.y = cvt_pk_bf16(s[2 * 33] * g0.z, s[3 * 33] * g0.w); o.z = cvt_pk_bf16(s[4 * 33] * g1.x, s[5 * 33] * g1.y); o.w = cvt_pk_bf16(s[6 * 33] * g1.z, s[7 * 33] * g1.w);
        *(v4u*)(WT + (size_t)map_row<MODE>(n0 + n) * K + k0 + 8 * c) = o; }
    LDS_WAIT(); asm volatile("" ::: "memory");
}

struct TrDesc { const float* W; bf16* WT; const float* gs; int K, N, mode, item; };
struct TrRegs { float v[32]; f32x4 g0, g1; };
__device__ __forceinline__ int map_row_rt(int mode, int n) {
    if (mode == MAP_WIN) return map_row<MAP_WIN>(n);
    if (mode == MAP_GATE) return map_row<MAP_GATE>(n);
    if (mode == MAP_UP) return map_row<MAP_UP>(n);
    return n;
}
__device__ __forceinline__ void tr_load(const TrDesc& d, int lane, TrRegs& t) {
    const int nblk = d.N / 32, kb = d.item / nblk, nb = d.item - kb * nblk, k0 = 64 * kb, n0 = 32 * nb;
    const float* src = d.W + (size_t)(k0 + (lane >> 5)) * d.N + n0 + (lane & 31);
#pragma unroll
    for (int i = 0; i < 32; ++i) t.v[i] = __builtin_nontemporal_load(src + (size_t)(2 * i) * d.N);
    const int c = lane & 7;
    t.g0 = (f32x4){1.f, 1.f, 1.f, 1.f}; t.g1 = t.g0;
    if (d.gs) { t.g0 = *(const f32x4*)(d.gs + k0 + 8 * c); t.g1 = *(const f32x4*)(d.gs + k0 + 8 * c + 4); }
}
__device__ __forceinline__ void tr_finish(const TrDesc& d, const TrRegs& t, LAS float* scr, int lane) {
    const int nblk = d.N / 32, kb = d.item / nblk, nb = d.item - kb * nblk, k0 = 64 * kb, n0 = 32 * nb, c = lane & 7;
    LAS float* sw = scr + (lane >> 5) * 33 + (lane & 31);
#pragma unroll
    for (int i = 0; i < 32; ++i) sw[(2 * i) * 33] = t.v[i];
    LDS_WAIT(); asm volatile("" ::: "memory");
#pragma unroll
    for (int j = 0; j < 4; ++j) { const int n = (lane >> 3) + 8 * j; const LAS float* s = scr + (8 * c) * 33 + n;
        v4u o; o.x = cvt_pk_bf16(s[0 * 33] * t.g0.x, s[1 * 33] * t.g0.y); o.y = cvt_pk_bf16(s[2 * 33] * t.g0.z, s[3 * 33] * t.g0.w); o.z = cvt_pk_bf16(s[4 * 33] * t.g1.x, s[5 * 33] * t.g1.y); o.w = cvt_pk_bf16(s[6 * 33] * t.g1.z, s[7 * 33] * t.g1.w);
        *(v4u*)(d.WT + (size_t)map_row_rt(d.mode, n0 + n) * d.K + k0 + 8 * c) = o; }
    LDS_WAIT(); asm volatile("" ::: "memory");
}

struct Args {
    const float* x; const int* pos; const float* g_pre_mix; const float* w_in; const float* sinks; const float* a_re; const float* a_im; const float* log_dt;
    const float* b_re; const float* b_im; const float* c_re; const float* c_im; const float* d_skip; const float* w_glu; const float* b_glu;
    const float* g_attn_out; const float* g_ssm_out; const float* w_o; const float* g_post_mix; const float* g_pre_ffn; const float* w_gate; const float* w_up;
    const float* w_down; const float* g_post_ffn; float* out; unsigned char* ws;
};

__device__ __forceinline__ void ssm_precompute(const Args& a, int g, LAS unsigned char* lds, int tid) {
    typedef float f32x2v __attribute__((ext_vector_type(2)));
    LAS f32x2v* P = (LAS f32x2v*)lds;
    LAS f32x2v* Bb = (LAS f32x2v*)(lds + 8704);
    LAS f32x2v* Cc = (LAS f32x2v*)(lds + 8704 + 8192);
    LAS float* Kk = (LAS float*)(lds + 8704 + 16384);
    const float dt = __builtin_amdgcn_exp2f(a.log_dt[g] * 1.4426950408889634f);
    for (int e = tid; e < 17 * 64; e += 512) { const int k = e >> 6, n = e & 63; const float ar = a.a_re[g * 64 + n], ai = a.a_im[g * 64 + n];
        const float mag = __builtin_amdgcn_exp2f((float)k * ar * dt * 1.4426950408889634f); float s, c; sincos_rev((double)k * (double)ai * (double)dt * 0.15915494309189535, s, c);
        P[e] = (f32x2v){mag * c, mag * s}; }
    for (int e = tid; e < 1024; e += 512) { const int n = e >> 4; const float ar = a.a_re[g * 64 + n], ai = a.a_im[g * 64 + n];
        const float mag = __builtin_amdgcn_exp2f(ar * dt * 1.4426950408889634f); float s, c; sincos_rev((double)ai * (double)dt * 0.15915494309189535, s, c);
        const float lr = mag * c, li = mag * s, den = ar * ar + ai * ai, nr = lr - 1.0f, ni = li;
        const float fre = (nr * ar + ni * ai) / den, fim = (ni * ar - nr * ai) / den;
        const float br = a.b_re[(size_t)g * 1024 + e], bi = a.b_im[(size_t)g * 1024 + e];
        Bb[e] = (f32x2v){fre * br - fim * bi, fre * bi + fim * br};
        Cc[e] = (f32x2v){a.c_re[(size_t)g * 1024 + e], a.c_im[(size_t)g * 1024 + e]}; }
    LDS_WAIT(); __syncthreads();
    for (int e = tid; e < 4096; e += 512) { const int k = e >> 8, p = (e >> 4) & 15, q = e & 15; float s = 0.f;
        for (int n = 0; n < 64; ++n) { const f32x2v c = Cc[p * 64 + n], l = P[k * 64 + n], b = Bb[n * 16 + q];
            const float tr = c.x * l.x - c.y * l.y, ti = c.x * l.y + c.y * l.x; s += tr * b.x - ti * b.y; }
        Kk[e] = s; }
    LDS_WAIT(); __syncthreads();
    bf16* TC = (bf16*)(a.ws + WS_TC) + (size_t)g * 256 * A2LD;
    bf16* BZ = (bf16*)(a.ws + WS_BZ) + (size_t)g * 256 * 256;
    {
        const int row = tid >> 1, j = row >> 4, p = row & 15; const float dp = a.d_skip[g * 16 + p];
        for (int ci = 0; ci < 16; ++ci) { const int col0 = 128 * (tid & 1) + 8 * ci, i = col0 >> 4, q0 = col0 & 15; float v[8];
#pragma unroll
            for (int e = 0; e < 8; ++e) { float t = 0.f; if (i <= j) { t = Kk[((j - i) * 16 + p) * 16 + q0 + e]; if (i == j && q0 + e == p) t += dp; } v[e] = t; }
            v4u o; o.x = cvt_pk_bf16(v[0], v[1]); o.y = cvt_pk_bf16(v[2], v[3]); o.z = cvt_pk_bf16(v[4], v[5]); o.w = cvt_pk_bf16(v[6], v[7]);
            *(v4u*)(TC + (size_t)row * A2LD + col0) = o; }
        for (int ci = 0; ci < 8; ++ci) { const int n0 = 32 * (tid & 1) + 4 * ci; float v[8];
#pragma unroll
            for (int e = 0; e < 4; ++e) { const f32x2v c = Cc[p * 64 + n0 + e], l = P[(j + 1) * 64 + n0 + e]; v[2 * e] = c.x * l.x - c.y * l.y; v[2 * e + 1] = -(c.x * l.y + c.y * l.x); }
            v4u o; o.x = cvt_pk_bf16(v[0], v[1]); o.y = cvt_pk_bf16(v[2], v[3]); o.z = cvt_pk_bf16(v[4], v[5]); o.w = cvt_pk_bf16(v[6], v[7]);
            *(v4u*)(TC + (size_t)row * A2LD + 256 + 2 * n0) = o; }
    }
    {
        const int row = tid >> 2, n = row >> 1, ri = row & 1;
        for (int ci = 0; ci < 8; ++ci) { const int col0 = 64 * (tid & 3) + 8 * ci, i = col0 >> 4, q0 = col0 & 15; float v[8];
#pragma unroll
            for (int e = 0; e < 8; ++e) { const f32x2v l = P[(15 - i) * 64 + n], b = Bb[n * 16 + q0 + e]; v[e] = ri ? (l.x * b.y + l.y * b.x) : (l.x * b.x - l.y * b.y); }
            v4u o; o.x = cvt_pk_bf16(v[0], v[1]); o.y = cvt_pk_bf16(v[2], v[3]); o.z = cvt_pk_bf16(v[4], v[5]); o.w = cvt_pk_bf16(v[6], v[7]);
            *(v4u*)(BZ + (size_t)row * 256 + col0) = o;
            *(v4u*)(BZ + (size_t)(128 + row) * 256 + col0) = (v4u){0u, 0u, 0u, 0u}; }
    }
    if (tid < 64) { const f32x2v l = P[16 * 64 + tid]; ((float*)(a.ws + WS_LAM))[(g * 64 + tid) * 2] = l.x; ((float*)(a.ws + WS_LAM))[(g * 64 + tid) * 2 + 1] = l.y; }
    LDS_WAIT(); __syncthreads();
}

constexpr int AT_KROW = 144, AT_VROW = 392, AT_V_OFF = 192 * AT_KROW, AT_LDS_BYTES = AT_V_OFF + 64 * AT_VROW;
__device__ __forceinline__ int crow(int r, int hi) { return (r & 3) + 8 * (r >> 2) + 4 * hi; }
__device__ __forceinline__ void attn_phase(LAS unsigned char* lds, int vcu, int G, const bf16* Qp, const bf16* Kp, const bf16* Vt, const float* sinks, bf16* AO, int ldo, float* st) {
    typedef unsigned long long u64;
    int tid = threadIdx.x; asm volatile("" : "+v"(tid));
    const int lane = tid & 63, wave = __builtin_amdgcn_readfirstlane(tid >> 6), r32 = lane & 31, hi = lane >> 5, hq = wave & 3, qsub = wave >> 2;
    const float NEG = -INFINITY;
    float ssq_acc = 0.f;
    for (int it = 0; it < 4; ++it) { const int id = ((vcu >> 5) << 7) | (it << 5) | (vcu & 31);
        const int b = id >> 7, kvh = (id >> 5) & 3, q0 = 64 * (id & 31), h = kvh * 4 + hq;
        const size_t tok0 = (size_t)b * SEQ;
        const int jt0 = (q0 >= 128) ? 0 : (128 - q0) / 32;
        v4u kv[3], vv[3];
#pragma unroll
        for (int i = 0; i < 3; ++i) { const int c = tid + 512 * i, row = c >> 3, ch = c & 7, key = q0 - 128 + row;
            if (key >= 0) kv[i] = *(const v4u*)(Kp + (tok0 + key) * D_KV + kvh * HD + ch * 8); }
#pragma unroll
        for (int i = 0; i < 3; ++i) { const int c = tid + 512 * i, d = c / 24, ch = c - d * 24, key0 = q0 - 128 + 8 * ch;
            if (key0 >= 0) vv[i] = *(const v4u*)(Vt + (size_t)(kvh * HD + d) * M + tok0 + key0); }
        const bf16* qrow = Qp + (tok0 + q0 + 32 * qsub + r32) * D_ATTN + h * HD + 32 * hi;
        bf16x8 qf[4];
#pragma unroll
        for (int kk = 0; kk < 4; ++kk) qf[kk] = *(const bf16x8*)(qrow + 8 * kk);
#pragma unroll
        for (int i = 0; i < 3; ++i) { const int c = tid + 512 * i, row = c >> 3, ch = c & 7, key = q0 - 128 + row;
            if (key >= 0) *(LAS v4u*)(lds + row * AT_KROW + ch * 16) = kv[i]; }
#pragma unroll
        for (int i = 0; i < 3; ++i) { const int c = tid + 512 * i, d = c / 24, ch = c - d * 24, key0 = q0 - 128 + 8 * ch;
            if (key0 >= 0) { LAS u64* p = (LAS u64*)(lds + AT_V_OFF + d * AT_VROW + ch * 16); p[0] = ((u64)vv[i].y << 32) | vv[i].x; p[1] = ((u64)vv[i].w << 32) | vv[i].z; } }
        LDS_WAIT(); __syncthreads();
        f32x16 s[5];
#pragma unroll
        for (int kt = 0; kt < 5; ++kt) {
            if (kt + qsub >= jt0) {
                const LAS unsigned char* kp = lds + (32 * (kt + qsub) + r32) * AT_KROW + 64 * hi;
                f32x16 acc = {0.f, 0.f, 0.f, 0.f, 0.f, 0.f, 0.f, 0.f, 0.f, 0.f, 0.f, 0.f, 0.f, 0.f, 0.f, 0.f};
#pragma unroll
                for (int kk = 0; kk < 4; ++kk) acc = __builtin_amdgcn_mfma_f32_32x32x16_bf16(*(const LAS bf16x8*)(kp + 16 * kk), qf[kk], acc, 0, 0, 0);
                s[kt] = acc;
            } else {
#pragma unroll
                for (int r = 0; r < 16; ++r) s[kt][r] = NEG;
            }
        }
#pragma unroll
        for (int r = 0; r < 16; ++r) { const int cr = crow(r, hi); if (!(cr > r32)) s[0][r] = NEG; if (!(cr <= r32)) s[4][r] = NEG; }
        const float sk = sinks[h] * 1.4426950408889634f;
        float mx = sk;
#pragma unroll
        for (int kt = 0; kt < 5; ++kt)
#pragma unroll
            for (int r = 0; r < 16; ++r) mx = fmaxf(mx, s[kt][r]);
        mx = fmaxf(mx, __shfl_xor(mx, 32));
        float l = 0.f;
#pragma unroll
        for (int kt = 0; kt < 5; ++kt)
#pragma unroll
            for (int r = 0; r < 16; ++r) { const float p = __builtin_amdgcn_exp2f(s[kt][r] - mx); s[kt][r] = p; l += p; }
        l += __shfl_xor(l, 32);
        l += __builtin_amdgcn_exp2f(sk - mx);
        const float inv = 1.0f / l;
        f32x16 o[2];
#pragma unroll
        for (int d = 0; d < 2; ++d)
#pragma unroll
            for (int r = 0; r < 16; ++r) o[d][r] = 0.f;
#pragma unroll
        for (int kt = 0; kt < 5; ++kt) {
            if (kt + qsub >= jt0) {
#pragma unroll
                for (int s2 = 0; s2 < 2; ++s2) {
                    v4u pw; pw.x = cvt_pk_bf16(s[kt][8 * s2 + 0] * inv, s[kt][8 * s2 + 1] * inv); pw.y = cvt_pk_bf16(s[kt][8 * s2 + 2] * inv, s[kt][8 * s2 + 3] * inv);
                    pw.z = cvt_pk_bf16(s[kt][8 * s2 + 4] * inv, s[kt][8 * s2 + 5] * inv); pw.w = cvt_pk_bf16(s[kt][8 * s2 + 6] * inv, s[kt][8 * s2 + 7] * inv);
                    const bf16x8 pf = __builtin_bit_cast(bf16x8, pw);
#pragma unroll
                    for (int dh = 0; dh < 2; ++dh) {
                        const LAS u64* vp = (const LAS u64*)(lds + AT_V_OFF + (dh * 32 + r32) * AT_VROW + (32 * (kt + qsub) + 16 * s2 + 4 * hi) * 2);
                        const u64 lo = vp[0], hi8 = vp[2];
                        const v4u vw = (v4u){(unsigned)lo, (unsigned)(lo >> 32), (unsigned)hi8, (unsigned)(hi8 >> 32)};
                        o[dh] = __builtin_amdgcn_mfma_f32_32x32x16_bf16(__builtin_bit_cast(bf16x8, vw), pf, o[dh], 0, 0, 0);
                    }
                }
            }
        }
        {
            float ssq = 0.f;
#pragma unroll
            for (int dh = 0; dh < 2; ++dh)
#pragma unroll
                for (int r = 0; r < 16; ++r) ssq += o[dh][r] * o[dh][r];
            ssq += __shfl_xor(ssq, 32);
            ssq_acc += ssq;
        }
        bf16* orow = AO + (tok0 + q0 + 32 * qsub + r32) * (size_t)ldo + h * HD + 4 * hi;
#pragma unroll
        for (int dh = 0; dh < 2; ++dh)
#pragma unroll
            for (int g4 = 0; g4 < 4; ++g4) { v2u w; w.x = cvt_pk_bf16(o[dh][4 * g4], o[dh][4 * g4 + 1]); w.y = cvt_pk_bf16(o[dh][4 * g4 + 2], o[dh][4 * g4 + 3]);
                *(v2u*)(orow + dh * 32 + 8 * g4) = w; }
        LDS_WAIT(); __syncthreads();
    }
    {
        LAS float* Xs = (LAS float*)lds;
        if (hi == 0) Xs[(qsub * 4 + hq) * 32 + r32] = ssq_acc;
        LDS_WAIT(); __syncthreads();
        if (hq == 0 && hi == 0) { const float tot = (Xs[(qsub * 4 + 0) * 32 + r32] + Xs[(qsub * 4 + 1) * 32 + r32]) + (Xs[(qsub * 4 + 2) * 32 + r32] + Xs[(qsub * 4 + 3) * 32 + r32]);
            st[(size_t)(vcu >> 5) * SEQ + 64 * (vcu & 31) + 32 * qsub + r32] = tot; }
        LDS_WAIT(); __syncthreads();
    }
}

__global__ void __launch_bounds__(NWAVES * 64, 2) hymba_fwd(Args a) {
    extern __shared__ __attribute__((aligned(16))) unsigned char lds_raw[];
    LAS unsigned char* lds = (LAS unsigned char*)lds_raw;
    volatile LAS unsigned* MISC = (volatile LAS unsigned*)(lds + MISC_OFF);
    const int tid = threadIdx.x;
    const int G = gridDim.x; const int bx = blockIdx.x; const int vcu = (G % 8 == 0) ? (bx % 8) * (G / 8) + bx / 8 : bx;
    unsigned char* ws = a.ws;
    unsigned* ctl = (unsigned*)(ws + WS_CTL);
    for (int u = tid; u < (LDS_BYTES - LDSCTL_OFF) / 4; u += NWAVES * 64) ((LAS unsigned*)(lds + LDSCTL_OFF))[u] = 0u;
    __syncthreads();
    XcdBarrier bar = xcd_barrier_post(ctl + CW_BAR, MISC + 8);
#define GRID_BAR() xcd_barrier(bar)
    const int team_pm = 8 * (bx & 7) + ((bx >> 3) & 7), team_k = bx >> 6;
    unsigned team_epoch = 1u;
#define TEAM_BAR() team_barrier(ctl + CW_TEAM + 64 * team_pm, ctl + CW_BAR + XB_TMO, team_epoch, MISC + 12)
    if (tid == 0) __hip_atomic_store(ctl + CW_TEAM + 64 * team_pm + 8 + team_k, 0x100u | bar.x, __ATOMIC_RELAXED, __HIP_MEMORY_SCOPE_AGENT);
    const int NGW = G * NWAVES;
#define PHASE_IDS() int tid_l = threadIdx.x; asm volatile("" : "+v"(tid_l)); const int lane = tid_l & 63, wave = __builtin_amdgcn_readfirstlane(tid_l >> 6), gw = vcu * NWAVES + wave; (void)lane; (void)gw
    bf16* Win_t = (bf16*)(ws + WS_WIN); bf16* Wglu_t = (bf16*)(ws + WS_WGLU); bf16* Wo_t = (bf16*)(ws + WS_WO); bf16* Wgu_t = (bf16*)(ws + WS_WGU); bf16* Wd_t = (bf16*)(ws + WS_WD);
    bf16* R1 = (bf16*)(ws + WS_R1); bf16* Qp = (bf16*)(ws + WS_Q); bf16* Kp = (bf16*)(ws + WS_K); bf16* Vt = (bf16*)(ws + WS_VT); bf16* MIX = (bf16*)(ws + WS_R2);
    bf16* A2 = (bf16*)(ws + WS_A2); float* Zst = (float*)(ws + WS_ZS); bf16* Zb = (bf16*)(ws + WS_Z); bf16* A3 = (bf16*)(ws + WS_A3); float* stat_a = (float*)(ctl + CW_STAT_A); float* stat_s = (float*)(ctl + CW_STAT_S); bf16* HID = (bf16*)(ws + WS_HID);

    {
        PHASE_IDS();
        if (bx < NG) ssm_precompute(a, bx, lds, tid_l);
        else {
            LAS float* scr = (LAS float*)(lds + wave * 16384);
            constexpr int I_IN = (DM / 64) * (D_IN / 32), I_GLU = (D_SSM / 64) * (D_SSM / 32), I_O = (DM / 64) * (DM / 32);
            constexpr int NITEMS = I_IN;
#define EARLY_DESC(D, IT) do { D = TrDesc{a.w_in, Win_t, a.g_pre_mix, DM, D_IN, MAP_WIN, (IT)}; } while (0)
            TrDesc dc, dn; TrRegs tc, tn;
            const int NCW = (G - NG) * NWAVES; int it = (bx - NG) * NWAVES + wave;
            if (it < NITEMS) { EARLY_DESC(dc, it); tr_load(dc, lane, tc); }
            while (it < NITEMS) {
                const int nx = it + NCW; const bool more = nx < NITEMS;
                if (more) { EARLY_DESC(dn, nx); tr_load(dn, lane, tn); }
                tr_finish(dc, tc, scr, lane);
                if (more) { dc = dn; tc = tn; }
                it = nx;
            }
#undef EARLY_DESC
        }
        const bool isS = bx < NG;
        const int NW2 = isS ? NG * NWAVES : (G - NG) * NWAVES, mEnd = isS ? 1024 : M;
        for (int m = isS ? bx * NWAVES + wave : 1024 + (bx - NG) * NWAVES + wave; m < mEnd; m += 2 * NW2) {
            f32x4 v[2][8]; float s[2];
#pragma unroll
            for (int q = 0; q < 2; ++q) { const int mq = (m + q * NW2 < mEnd) ? m + q * NW2 : m; const f32x4* xr = (const f32x4*)(a.x + (size_t)mq * DM);
#pragma unroll
                for (int j = 0; j < 4; ++j) { v[q][2 * j] = xr[128 * j + 2 * lane]; v[q][2 * j + 1] = xr[128 * j + 2 * lane + 1]; } }
#pragma unroll
            for (int q = 0; q < 2; ++q) { float t = 0.f;
#pragma unroll
                for (int j = 0; j < 8; ++j) t += (v[q][j].x * v[q][j].x + v[q][j].y * v[q][j].y) + (v[q][j].z * v[q][j].z + v[q][j].w * v[q][j].w);
                s[q] = t; }
#pragma unroll
            for (int q = 0; q < 2; ++q) { const int mm = m + q * NW2; if (mm >= mEnd) continue;
                const float ms = wave_sum(s[q]) * (1.0f / DM) + RMS_EPS; const float r = 1.0f / sqrtf(ms);
                if (lane == 0) ((float*)(ws + WS_RX))[mm] = sqrtf(ms);
                v4u* o = (v4u*)(R1 + (size_t)mm * DM);
#pragma unroll
                for (int j = 0; j < 4; ++j) { v4u w; w.x = cvt_pk_bf16(v[q][2 * j].x * r, v[q][2 * j].y * r); w.y = cvt_pk_bf16(v[q][2 * j].z * r, v[q][2 * j].w * r);
                    w.z = cvt_pk_bf16(v[q][2 * j + 1].x * r, v[q][2 * j + 1].y * r); w.w = cvt_pk_bf16(v[q][2 * j + 1].z * r, v[q][2 * j + 1].w * r); o[64 * j + lane] = w; } }
        }
    }
    GRID_BAR();

    {
        PHASE_IDS();
        pg8::Gemm g{R1, Win_t, DM, DM, DM}; pg8::StaticOrder S; S.init(M, 2304, G, bx);
        LAS int* posl = (LAS int*)(lds + LDSCTL_OFF + 1024);
        if (tid_l < 256) posl[tid_l] = a.pos[team_pm * 256 + tid_l];
        LDS_WAIT(); __syncthreads();
        pg8::EpiQKU E{Qp, Kp, A2, posl};
        pg8::gemm_phase<pg8::EpiQKU, pg8::StaticOrder, true>(lds, g, S, E);
        pg8::Gemm g2{Win_t + (size_t)2304 * DM, R1, DM, DM, DM}; pg8::StaticOrder S2; S2.init(256, M, G, (bx + 192) % G);
        pg8::EpiBf16P E2{Vt, M};
        pg8::gemm_phase<pg8::EpiBf16P, pg8::StaticOrder, true>(lds, g2, S2, E2);
        {
            int tid_c = threadIdx.x; asm volatile("" : "+v"(tid_c)); const int lane = tid_c & 63, wave = __builtin_amdgcn_readfirstlane(tid_c >> 6);
            LAS float* scr = (LAS float*)(lds + wave * 16384);
            constexpr int I_G = (DM / 64) * (D_FF / 32), I_D = (D_FF / 64) * (DM / 32);
            const int cw = (bx & (G / 2 - 1)) * NWAVES + wave, NCW = (G / 2) * NWAVES;
            constexpr int I_GLU = (D_SSM / 64) * (D_SSM / 32), I_O = (DM / 64) * (DM / 32);
            constexpr int NIT = I_GLU + I_O + 2 * I_G + I_D;
#define FFN_DESC(D, IT) do { int r_ = (IT); if (r_ < I_GLU) { D = TrDesc{a.w_glu, Wglu_t, nullptr, D_SSM, D_SSM, MAP_PLAIN, r_}; } \
                else if (r_ < I_GLU + I_O) { r_ -= I_GLU; D = TrDesc{a.w_o, Wo_t, (r_ / (DM / 32) < 16) ? a.g_attn_out : (a.g_ssm_out - 1024), DM, DM, MAP_PLAIN, r_}; } \
                else if ((r_ -= I_GLU + I_O) < I_G) { D = TrDesc{a.w_gate, Wgu_t, a.g_pre_ffn, DM, D_FF, MAP_GATE, r_}; } else if (r_ < 2 * I_G) { D = TrDesc{a.w_up, Wgu_t, a.g_pre_ffn, DM, D_FF, MAP_UP, r_ - I_G}; } \
                else { D = TrDesc{a.w_down, Wd_t, nullptr, D_FF, DM, MAP_PLAIN, r_ - 2 * I_G}; } } while (0)
            TrDesc dc, dn; TrRegs tc, tn;
            const int it_hi = (bx >= G / 2) ? NIT : (bx < G / 4 ? 1536 : (I_GLU + I_O));
            int it = (bx >= G / 2) ? (I_GLU + I_O) + cw : (bx < G / 4 ? cw : 1536 + (cw - 512));
            const int NCWx = (bx >= G / 2) ? NCW : 512;
            if (it < it_hi) { FFN_DESC(dc, it); tr_load(dc, lane, tc); }
            while (it < it_hi) {
                const int nx = it + NCWx; const bool more = nx < it_hi;
                if (more) { FFN_DESC(dn, nx); tr_load(dn, lane, tn); }
                tr_finish(dc, tc, scr, lane);
                if (more) { dc = dn; tc = tn; }
                it = nx;
            }
#undef FFN_DESC
        }
    }
    GRID_BAR();

    {
        PHASE_IDS();
        {
            pg8::Gemm g{A2, (const bf16*)(ws + WS_BZ), A2LD, 256, 256}; pg8::DiagOrder S{G, bx, 256};
            pg8::EpiZ E{Zst};
            pg8::gemm_phase<pg8::EpiZ, pg8::DiagOrder, true>(lds, g, S, E);
        }
        asm volatile("s_waitcnt vmcnt(0)" ::: "memory"); __syncthreads();
        {
            typedef float f32x2v __attribute__((ext_vector_type(2)));
            const int seq = wave >> 2, seg = wave & 3, g = bx >> 2, b = 2 * (bx & 3) + seq;
            const float lr = ((const float*)(ws + WS_LAM))[(g * 64 + lane) * 2], li = ((const float*)(ws + WS_LAM))[(g * 64 + lane) * 2 + 1];
            const size_t row0 = (size_t)g * 1024 + b * 128 + 32 * seg;
            const f32x2v* zp = (const f32x2v*)Zst + row0 * 64 + lane;
            f32x2v zz[32];
#pragma unroll
            for (int i = 0; i < 32; ++i) zz[i] = zp[(size_t)i * 64];
            float tr = 0.f, ti = 0.f;
#pragma unroll
            for (int i = 0; i < 32; ++i) { const float nr = lr * tr - li * ti + zz[i].x, ni = lr * ti + li * tr + zz[i].y; tr = nr; ti = ni; }
            float pr = lr, pi = li;
#pragma unroll
            for (int q = 0; q < 5; ++q) { const float nr = pr * pr - pi * pi, ni = 2.f * pr * pi; pr = nr; pi = ni; }
            LAS f32x2v* X = (LAS f32x2v*)lds;
            X[wave * 64 + lane] = (f32x2v){tr, ti};
            LDS_WAIT(); __syncthreads();
            float sr = 0.f, si = 0.f;
            for (int s = 0; s < seg; ++s) { const f32x2v t = X[(seq * 4 + s) * 64 + lane]; const float nr = pr * sr - pi * si + t.x, ni = pr * si + pi * sr + t.y; sr = nr; si = ni; }
            unsigned* sp = (unsigned*)(A2 + row0 * A2LD + 256) + lane;
#pragma unroll
            for (int i = 0; i < 32; ++i) {
                sp[(size_t)i * (A2LD / 2)] = cvt_pk_bf16(sr, si);
                const float nr = lr * sr - li * si + zz[i].x, ni = lr * si + li * sr + zz[i].y; sr = nr; si = ni;
            }
        }
        asm volatile("s_waitcnt vmcnt(0)" ::: "memory"); __syncthreads();
        {
            pg8::Gemm g{A2, (const bf16*)(ws + WS_TC), A2LD, A2LD, A2LD}; pg8::DiagOrder S{G, bx, 256};
            pg8::EpiY E{Zb};
            pg8::gemm_phase<pg8::EpiY, pg8::DiagOrder, true>(lds, g, S, E);
        }
        attn_phase(lds, vcu, G, Qp, Kp, Vt, a.sinks, A3, DM, stat_a);
    }
    GRID_BAR();

    if (tid == 0) { unsigned same = 1u; const unsigned me = 0x100u | bar.x;
        for (int k = 0; k < 4; ++k) same &= (xb_ld(ctl + CW_TEAM + 64 * team_pm + 8 + k) == me) ? 1u : 0u;
        MISC[12] = same; }
    __syncthreads();
    {
        PHASE_IDS();
        pg8::Gemm g{Zb, Wglu_t, D_SSM, D_SSM, D_SSM, M * 16}; pg8::StaticOrder S; S.init(M, D_SSM, G, bx);
        pg8::EpiGlu E{Zb, a.b_glu, A3 + D_ATTN, DM, stat_s};
        pg8::gemm_phase<pg8::EpiGlu, pg8::StaticOrder, true>(lds, g, S, E);
    }
    TEAM_BAR();

    {
        PHASE_IDS();
        pg8::Gemm g{A3, Wo_t, DM, DM, DM}; pg8::StaticOrder S; S.init(M, DM, G, bx);
        LAS float* ratl = (LAS float*)(lds + LDSCTL_OFF + 2048); LAS float* rsl = ratl + 256;
        if (tid_l < 256) { const int row = team_pm * 256 + tid_l;
            const float sa = __uint_as_float(__hip_atomic_load((const unsigned*)(stat_a + row), __ATOMIC_RELAXED, __HIP_MEMORY_SCOPE_AGENT)), ss = __uint_as_float(__hip_atomic_load((const unsigned*)(stat_s + row), __ATOMIC_RELAXED, __HIP_MEMORY_SCOPE_AGENT));
            const float ra = 1.0f / sqrtf(sa * (1.0f / 1024.0f) + RMS_EPS), rsi = sqrtf(ss * (1.0f / 1024.0f) + RMS_EPS);
            ratl[tid_l] = ra * rsi; rsl[tid_l] = 1.0f / rsi; }
        LDS_WAIT(); __syncthreads();
        pg8::EpiMix E{MIX, DM, ratl, rsl};
        pg8::gemm_phase<pg8::EpiMix, pg8::StaticOrder, true>(lds, g, S, E);
    }
    TEAM_BAR();

    {
        PHASE_IDS();
        float* RH = (float*)(ws + WS_RH); const float* RX = (const float*)(ws + WS_RX);
        f32x4 gq[8];
#pragma unroll
        for (int j = 0; j < 4; ++j) { gq[2 * j] = ((const f32x4*)a.g_post_mix)[128 * j + 2 * lane]; gq[2 * j + 1] = ((const f32x4*)a.g_post_mix)[128 * j + 2 * lane + 1]; }
        for (int it = 0; it < 4; ++it) { const int mb = team_pm * 256 + team_k * 64 + wave * 8 + it * 2;
            v4u mv[2][4], xv[2][4]; float rxi[2], sm[2];
#pragma unroll
            for (int q = 0; q < 2; ++q) { const v4u* mr = (const v4u*)(MIX + (size_t)(mb + q) * DM); const v4u* xr = (const v4u*)(R1 + (size_t)(mb + q) * DM); rxi[q] = RX[mb + q];
#pragma unroll
                for (int j = 0; j < 4; ++j) { mv[q][j] = mr[64 * j + lane]; xv[q][j] = xr[64 * j + lane]; } }
#pragma unroll
            for (int q = 0; q < 2; ++q) { float t = 0.f;
#pragma unroll
                for (int j = 0; j < 4; ++j)
#pragma unroll
                    for (int e = 0; e < 4; ++e) { const float m0 = bf_lo(mv[q][j][e]), m1 = bf_hi(mv[q][j][e]); t += m0 * m0 + m1 * m1; }
                sm[q] = t; }
#pragma unroll
            for (int q = 0; q < 2; ++q) {
                const float rm = 1.0f / sqrtf(wave_sum(sm[q]) * (1.0f / DM) + RMS_EPS), rx = rxi[q];
                float sh = 0.f; v4u* xo = (v4u*)(R1 + (size_t)(mb + q) * DM); f32x4 hq[8];
#pragma unroll
                for (int j = 0; j < 4; ++j) {
                    const f32x4 g0 = gq[2 * j], g1 = gq[2 * j + 1]; const v4u mj = mv[q][j], xj = xv[q][j];
                    f32x4 h0, h1;
                    h0.x = bf_lo(xj.x) * rx + bf_lo(mj.x) * rm * g0.x; h0.y = bf_hi(xj.x) * rx + bf_hi(mj.x) * rm * g0.y; h0.z = bf_lo(xj.y) * rx + bf_lo(mj.y) * rm * g0.z; h0.w = bf_hi(xj.y) * rx + bf_hi(mj.y) * rm * g0.w;
                    h1.x = bf_lo(xj.z) * rx + bf_lo(mj.z) * rm * g1.x; h1.y = bf_hi(xj.z) * rx + bf_hi(mj.z) * rm * g1.y; h1.z = bf_lo(xj.w) * rx + bf_lo(mj.w) * rm * g1.z; h1.w = bf_hi(xj.w) * rx + bf_hi(mj.w) * rm * g1.w;
                    sh += (h0.x * h0.x + h0.y * h0.y) + (h0.z * h0.z + h0.w * h0.w) + (h1.x * h1.x + h1.y * h1.y) + (h1.z * h1.z + h1.w * h1.w);
                    hq[2 * j] = h0; hq[2 * j + 1] = h1;
                }
                const float msh = wave_sum(sh) * (1.0f / DM) + RMS_EPS, rh = 1.0f / sqrtf(msh);
                if (lane == 0) RH[mb + q] = sqrtf(msh);
#pragma unroll
                for (int j = 0; j < 4; ++j) { const f32x4 h0 = hq[2 * j] * rh, h1 = hq[2 * j + 1] * rh;
                    v4u w; w.x = cvt_pk_bf16(h0.x, h0.y); w.y = cvt_pk_bf16(h0.z, h0.w); w.z = cvt_pk_bf16(h1.x, h1.y); w.w = cvt_pk_bf16(h1.z, h1.w); xo[64 * j + lane] = w; }
            }
        }
    }
    TEAM_BAR();

    {
        PHASE_IDS();
        pg8::Gemm g{R1, Wgu_t, DM, DM, DM}; pg8::StaticOrder S; S.init(M, 2 * D_FF, G, bx);
        pg8::EpiSwiGLU E{HID, D_FF, (const float*)(ws + WS_RH)};
        pg8::gemm_phase<pg8::EpiSwiGLU, pg8::StaticOrder, true>(lds, g, S, E);
    }
    TEAM_BAR();

    {
        PHASE_IDS();
        pg8::Gemm g{HID, Wd_t, D_FF, D_FF, D_FF}; pg8::StaticOrder S; S.init(M, DM, G, bx);
        pg8::EpiBf16P E{MIX, DM};
        pg8::gemm_phase<pg8::EpiBf16P, pg8::StaticOrder, true>(lds, g, S, E);
    }
    TEAM_BAR();

    {
        PHASE_IDS();
        f32x4 gq[8];
#pragma unroll
        for (int j = 0; j < 4; ++j) { gq[2 * j] = ((const f32x4*)a.g_post_ffn)[128 * j + 2 * lane]; gq[2 * j + 1] = ((const f32x4*)a.g_post_ffn)[128 * j + 2 * lane + 1]; }
        for (int it = 0; it < 4; ++it) { const int mb = team_pm * 256 + team_k * 64 + wave * 8 + it * 2;
            v4u fv[2][4], hv[2][4]; float sf[2], rhi[2];
#pragma unroll
            for (int q = 0; q < 2; ++q) { const v4u* fr = (const v4u*)(MIX + (size_t)(mb + q) * DM); const v4u* hr = (const v4u*)(R1 + (size_t)(mb + q) * DM); rhi[q] = ((const float*)(ws + WS_RH))[mb + q];
#pragma unroll
                for (int j = 0; j < 4; ++j) { fv[q][j] = fr[64 * j + lane]; hv[q][j] = hr[64 * j + lane]; } }
#pragma unroll
            for (int q = 0; q < 2; ++q) { float t = 0.f;
#pragma unroll
                for (int j = 0; j < 4; ++j)
#pragma unroll
                    for (int e = 0; e < 4; ++e) { const float f0 = bf_lo(fv[q][j][e]), f1 = bf_hi(fv[q][j][e]); t += f0 * f0 + f1 * f1; }
                sf[q] = t; }
#pragma unroll
            for (int q = 0; q < 2; ++q) {
                const float rf = 1.0f / sqrtf(wave_sum(sf[q]) * (1.0f / DM) + RMS_EPS), rx = rhi[q]; f32x4* ho = (f32x4*)(a.out + (size_t)(mb + q) * DM);
#pragma unroll
                for (int j = 0; j < 4; ++j) {
                    const f32x4 g0 = gq[2 * j], g1 = gq[2 * j + 1]; const v4u fj = fv[q][j], hj = hv[q][j]; f32x4 h0, h1;
                    h0.x = bf_lo(hj.x) * rx + bf_lo(fj.x) * rf * g0.x; h0.y = bf_hi(hj.x) * rx + bf_hi(fj.x) * rf * g0.y; h0.z = bf_lo(hj.y) * rx + bf_lo(fj.y) * rf * g0.z; h0.w = bf_hi(hj.y) * rx + bf_hi(fj.y) * rf * g0.w;
                    h1.x = bf_lo(hj.z) * rx + bf_lo(fj.z) * rf * g1.x; h1.y = bf_hi(hj.z) * rx + bf_hi(fj.z) * rf * g1.y; h1.z = bf_lo(hj.w) * rx + bf_lo(fj.w) * rf * g1.z; h1.w = bf_hi(hj.w) * rx + bf_hi(fj.w) * rf * g1.w;
                    ho[128 * j + 2 * lane] = h0; ho[128 * j + 2 * lane + 1] = h1;
                }
            }
        }
    }
}

extern "C" void kernel_launch(void* const* d_in, const int* in_sizes, int n_in, void* d_out, int out_size, void* d_ws, size_t ws_size, hipStream_t stream) {
    static int grid = 0;
    if (grid == 0) {
        if (n_in != 24 || in_sizes[0] != M * DM || out_size != M * DM || ws_size < WS_END) { fprintf(stderr, "kernel_launch: unexpected shapes (n_in %d, in0 %d, out %d, ws %zu)\n", n_in, n_in > 0 ? in_sizes[0] : -1, out_size, ws_size); grid = -1; return; }
        int dev = 0, cus = 0;
        if (hipGetDevice(&dev) != hipSuccess || hipDeviceGetAttribute(&cus, hipDeviceAttributeMultiprocessorCount, dev) != hipSuccess) { grid = -1; return; }
        if (hipFuncSetAttribute((const void*)hymba_fwd, hipFuncAttributeMaxDynamicSharedMemorySize, LDS_BYTES) != hipSuccess) { fprintf(stderr, "kernel_launch: hipFuncSetAttribute failed\n"); grid = -1; return; }
        int per_cu = 0;
        (void)hipOccupancyMaxActiveBlocksPerMultiprocessor(&per_cu, (const void*)hymba_fwd, NWAVES * 64, LDS_BYTES);
        (void)hipGetLastError();
        grid = cus;
        if (grid != 256) { fprintf(stderr, "kernel_launch: built for a 256-CU device (team structure, SSM unit map); found %d CUs\n", cus); grid = -1; return; }
    }
    if (grid < 0) return;
    (void)hipMemsetAsync((char*)d_ws + WS_CTL, 0, CTL_ZERO_BYTES, stream);
    Args a{};
    a.x = (const float*)d_in[0]; a.pos = (const int*)d_in[1]; a.g_pre_mix = (const float*)d_in[2]; a.w_in = (const float*)d_in[3]; a.sinks = (const float*)d_in[4];
    a.a_re = (const float*)d_in[5]; a.a_im = (const float*)d_in[6]; a.log_dt = (const float*)d_in[7]; a.b_re = (const float*)d_in[8]; a.b_im = (const float*)d_in[9];
    a.c_re = (const float*)d_in[10]; a.c_im = (const float*)d_in[11]; a.d_skip = (const float*)d_in[12]; a.w_glu = (const float*)d_in[13]; a.b_glu = (const float*)d_in[14];
    a.g_attn_out = (const float*)d_in[15]; a.g_ssm_out = (const float*)d_in[16]; a.w_o = (const float*)d_in[17]; a.g_post_mix = (const float*)d_in[18]; a.g_pre_ffn = (const float*)d_in[19];
    a.w_gate = (const float*)d_in[20]; a.w_up = (const float*)d_in[21]; a.w_down = (const float*)d_in[22]; a.g_post_ffn = (const float*)d_in[23];
    a.out = (float*)d_out; a.ws = (unsigned char*)d_ws;
    hipLaunchKernelGGL(hymba_fwd, dim3(grid), dim3(NWAVES * 64), LDS_BYTES, stream, a);
}
```
